# Optimizing an MI355X kernel written in HIP

```python
import math
import jax
import jax.numpy as jnp
from jax import lax
import numpy as np

D_MODEL = 1024
BATCH = 8
SEQ = 4096
DEPTH = 4

CTX_LEN = 256
GRID_W = 64
Q_BLOCK = 128
ROPE_THETA = 10000.0
NORM_EPS = 1e-6

HY_WIDTH = D_MODEL // 4
HY_SHORT = 3
HY_EMB = 33
HY_FILTER_HIDDEN = 64
HY_FAST_DECAY = 0.3
HY_SLOW_DECAY = 1.5
HY_DECAY_TARGET = 1e-2

DIFF_HEADS = 4
DIFF_WIDTH = D_MODEL // 4
DIFF_V_DIM = DIFF_WIDTH // DIFF_HEADS
DIFF_QK_DIM = DIFF_V_DIM // 2

GQA_HEAD_DIM = 64
GQA_WIDTH = D_MODEL // 2
GQA_HEADS = GQA_WIDTH // GQA_HEAD_DIM
GQA_KV_HEADS = GQA_HEADS // 4
GQA_REP = GQA_HEADS // GQA_KV_HEADS

MIX_WIDTH = HY_WIDTH + DIFF_WIDTH + GQA_WIDTH

OFF_DQ = 3 * HY_WIDTH
OFF_DK = OFF_DQ + 2 * DIFF_HEADS * DIFF_QK_DIM
OFF_DV = OFF_DK + 2 * DIFF_HEADS * DIFF_QK_DIM
OFF_GQ = OFF_DV + DIFF_WIDTH
OFF_GK = OFF_GQ + GQA_WIDTH
OFF_GV = OFF_GK + GQA_KV_HEADS * GQA_HEAD_DIM
IN_COLS = OFF_GV + GQA_KV_HEADS * GQA_HEAD_DIM
IN_SPLITS = [OFF_DQ, OFF_DK, OFF_DV, OFF_GQ, OFF_GK, OFF_GV]

D_FF = 256 * math.ceil(8 * D_MODEL / 3 / 256)
N_EXPERTS = 8
TOP_K = 2
D_FF_EXPERT = 7 * D_MODEL // 2

kernel_name = 'hybrid_diffusion_trunk'


def rms_norm(x, g):
    xf = x.astype(jnp.float32)
    y = xf * lax.rsqrt(jnp.mean(xf * xf, axis=-1, keepdims=True) + NORM_EPS)
    return y.astype(x.dtype) * g


def axial_rope_tables(length, head_dim, dtype):
    rows = length // GRID_W
    t = jnp.arange(rows * GRID_W)
    row = (t // GRID_W).astype(jnp.float32)
    col = (t % GRID_W).astype(jnp.float32)
    n = head_dim // 4
    inv = ROPE_THETA ** (-jnp.arange(n, dtype=jnp.float32) / n)
    ang = jnp.concatenate([row[:, None] * inv, col[:, None] * inv], axis=-1)
    return jnp.cos(ang).astype(dtype), jnp.sin(ang).astype(dtype)


def apply_rope(x, cos, sin):
    shape = (1, cos.shape[0]) + (1,) * (x.ndim - 3) + (cos.shape[1],)
    cos = cos.reshape(shape)
    sin = sin.reshape(shape)
    x1, x2 = jnp.split(x, 2, axis=-1)
    return jnp.concatenate([x1 * cos - x2 * sin, x1 * sin + x2 * cos], axis=-1)


def sweep_query_blocks(fn, q):
    b, l = q.shape[:2]
    nb = l // Q_BLOCK
    qb = jnp.moveaxis(q.reshape((b, nb, Q_BLOCK) + q.shape[2:]), 1, 0)
    ob = lax.map(fn, qb)
    return jnp.moveaxis(ob, 0, 1).reshape((b, l) + ob.shape[3:])


def diff_attention(q, k, v, lam):
    scale = DIFF_QK_DIM ** -0.5

    def block(qb):
        s = jnp.einsum('bqhmd,bkhmd->bhmqk', qb, k) * scale
        p = jax.nn.softmax(s.astype(jnp.float32), axis=-1)
        a = (p[:, :, 0] - lam * p[:, :, 1]).astype(v.dtype)
        return jnp.einsum('bhqk,bkhd->bqhd', a, v)

    return sweep_query_blocks(block, q)


def gqa_attention(q, k, v):
    scale = GQA_HEAD_DIM ** -0.5

    def block(qb):
        s = jnp.einsum('bqgrd,bkgd->bgrqk', qb, k) * scale
        p = jax.nn.softmax(s.astype(jnp.float32), axis=-1).astype(v.dtype)
        return jnp.einsum('bgrqk,bkgd->bqgrd', p, v)

    return sweep_query_blocks(block, q)


def short_conv(z, w, b):
    l = z.shape[1]
    pad = HY_SHORT // 2
    zp = jnp.pad(z, ((0, 0), (pad, HY_SHORT - 1 - pad), (0, 0)))
    y = b
    for j in range(HY_SHORT):
        y = y + zp[:, j:j + l] * w[j]
    return y


def hyena_filter(length, w1, b1, w2, b2, w3, freq):
    t = jnp.linspace(0.0, 1.0, length, dtype=jnp.float32)[:, None]
    bands = (HY_EMB - 1) // 2
    ang = (2.0 * math.pi / length) * jnp.arange(length, dtype=jnp.float32)[:, None] \
        * jnp.linspace(1e-4, bands - 1, bands, dtype=jnp.float32)
    feats = jnp.concatenate([t, jnp.cos(ang), -jnp.sin(ang)], axis=-1)
    a = jnp.sin(freq * (feats @ w1 + b1))
    a = jnp.sin(freq * (a @ w2 + b2))
    hfilt = (a @ w3).astype(jnp.float32)
    max_decay = math.log(HY_DECAY_TARGET) / HY_FAST_DECAY
    min_decay = math.log(HY_DECAY_TARGET) / HY_SLOW_DECAY
    deltas = jnp.abs(jnp.linspace(min_decay, max_decay, HY_WIDTH, dtype=jnp.float32))
    decay = jnp.exp(-t * deltas)
    h_fwd = hfilt[:, :HY_WIDTH] * decay
    h_bwd = hfilt[:, HY_WIDTH:] * decay
    zero = jnp.zeros((1, HY_WIDTH), jnp.float32)
    return jnp.concatenate([h_fwd, zero, h_bwd[1:][::-1]], axis=0)


def bidir_long_conv(v, h_circ):
    l = v.shape[1]
    vf = jnp.fft.rfft(v.astype(jnp.float32), n=2 * l, axis=1)
    hf = jnp.fft.rfft(h_circ, n=2 * l, axis=0)
    y = jnp.fft.irfft(vf * hf[None], n=2 * l, axis=1)[:, :l]
    return y.astype(v.dtype)


def hyena_mixer(z, conv_w, conv_b, w1, b1, w2, b2, w3, freq, skip):
    z = short_conv(z, conv_w, conv_b)
    x0, x1, v = jnp.split(z, 3, axis=-1)
    h_circ = hyena_filter(z.shape[1], w1, b1, w2, b2, w3, freq)
    v = v * x1
    v = bidir_long_conv(v, h_circ) + v * skip
    return v * x0


def merge_head_groups(y_hy, o_diff, o_gqa, subln_g, lam_init):
    b, l = y_hy.shape[:2]
    o_diff = rms_norm(o_diff, subln_g) * (1.0 - lam_init)
    return jnp.concatenate([y_hy, o_diff.reshape(b, l, -1), o_gqa.reshape(b, l, -1)], axis=-1)


def swiglu(t, wg, wu, wd):
    return (jax.nn.silu(t @ wg) * (t @ wu)) @ wd


def moe_swiglu(t, router, wg, wu, wd):
    logits = (t @ router).astype(jnp.float32)
    top_val, top_idx = lax.top_k(logits, TOP_K)
    top_w = jax.nn.softmax(top_val, axis=-1)
    gates = jnp.sum(jax.nn.one_hot(top_idx, N_EXPERTS, dtype=jnp.float32) * top_w[..., None],
                    axis=1).astype(t.dtype)
    out = jnp.zeros_like(t)
    for e in range(N_EXPERTS):
        out = out + gates[:, e:e + 1] * swiglu(t, wg[e], wu[e], wd[e])
    return out


def setup_inputs(seed: int = 0) -> dict:
    key = jax.random.key(seed)
    keys = jax.random.split(key, 48)
    count = [0]

    def normal(shape, scale):
        k = keys[count[0]]
        count[0] += 1
        return jax.random.normal(k, shape, jnp.float32) * scale

    def gain(shape):
        return 1.0 + normal(shape, 0.05)

    d = D_MODEL
    n_dense = (DEPTH + 1) // 2
    n_moe = DEPTH // 2
    return {
        'x': normal((BATCH, SEQ, d), 1.0),
        'c': normal((BATCH, d), 1.0),
        'ctx': normal((BATCH, CTX_LEN, d), 1.0),
        'c_ctx': normal((d,), 1.0),
        'w_ada': normal((DEPTH, d, 6 * d), 0.5 * d ** -0.5),
        'b_ada': normal((DEPTH, 6 * d), 0.02),
        'g_mix': gain((DEPTH, d)),
        'g_ffn': gain((DEPTH, d)),
        'w_in': normal((DEPTH, d, IN_COLS), d ** -0.5),
        'w_out': normal((DEPTH, MIX_WIDTH, d), MIX_WIDTH ** -0.5),
        'hy_conv_w': normal((DEPTH, HY_SHORT, 3 * HY_WIDTH), HY_SHORT ** -0.5),
        'hy_conv_b': normal((DEPTH, 3 * HY_WIDTH), 0.02),
        'hy_w1': normal((DEPTH, HY_EMB, HY_FILTER_HIDDEN), HY_EMB ** -0.5),
        'hy_b1': normal((DEPTH, HY_FILTER_HIDDEN), 0.1),
        'hy_w2': normal((DEPTH, HY_FILTER_HIDDEN, HY_FILTER_HIDDEN), HY_FILTER_HIDDEN ** -0.5),
        'hy_b2': normal((DEPTH, HY_FILTER_HIDDEN), 0.1),
        'hy_w3': normal((DEPTH, HY_FILTER_HIDDEN, 2 * HY_WIDTH), 0.005),
        'hy_freq': gain((DEPTH, HY_FILTER_HIDDEN)),
        'hy_skip': normal((DEPTH, HY_WIDTH), 1.0),
        'diff_lq1': normal((DEPTH, DIFF_QK_DIM), 0.1),
        'diff_lk1': normal((DEPTH, DIFF_QK_DIM), 0.1),
        'diff_lq2': normal((DEPTH, DIFF_QK_DIM), 0.1),
        'diff_lk2': normal((DEPTH, DIFF_QK_DIM), 0.1),
        'diff_subln': gain((DEPTH, DIFF_V_DIM)),
        'gqa_qnorm': gain((DEPTH, GQA_HEAD_DIM)),
        'gqa_knorm': gain((DEPTH, GQA_HEAD_DIM)),
        'ffn_wg': normal((n_dense, d, D_FF), d ** -0.5),
        'ffn_wu': normal((n_dense, d, D_FF), d ** -0.5),
        'ffn_wd': normal((n_dense, D_FF, d), D_FF ** -0.5),
        'moe_router': normal((n_moe, d, N_EXPERTS), d ** -0.5),
        'moe_wg': normal((n_moe, N_EXPERTS, d, D_FF_EXPERT), d ** -0.5),
        'moe_wu': normal((n_moe, N_EXPERTS, d, D_FF_EXPERT), d ** -0.5),
        'moe_wd': normal((n_moe, N_EXPERTS, D_FF_EXPERT, d), D_FF_EXPERT ** -0.5),
        'g_final': gain((d,)),
    }


def reference(x, c, ctx, c_ctx, w_ada, b_ada, g_mix, g_ffn, w_in, w_out,
              hy_conv_w, hy_conv_b, hy_w1, hy_b1, hy_w2, hy_b2, hy_w3, hy_freq, hy_skip,
              diff_lq1, diff_lk1, diff_lq2, diff_lk2, diff_subln, gqa_qnorm, gqa_knorm,
              ffn_wg, ffn_wu, ffn_wd, moe_router, moe_wg, moe_wu, moe_wd, g_final):
    b, seq, d = x.shape
    n_ctx = ctx.shape[1]
    cos_d, sin_d = axial_rope_tables(seq, DIFF_QK_DIM, x.dtype)
    cos_g, sin_g = axial_rope_tables(seq, GQA_HEAD_DIM, x.dtype)
    silu_c = jax.nn.silu(c)
    silu_cc = jax.nn.silu(c_ctx)
    h, hc = x, ctx
    for i in range(DEPTH):
        last = i == DEPTH - 1
        lam_init = 0.8 - 0.6 * math.exp(-0.3 * i)
        lam = (jnp.exp(jnp.sum(diff_lq1[i].astype(jnp.float32) * diff_lk1[i].astype(jnp.float32)))
               - jnp.exp(jnp.sum(diff_lq2[i].astype(jnp.float32) * diff_lk2[i].astype(jnp.float32)))
               + lam_init)
        hy_params = (hy_conv_w[i], hy_conv_b[i], hy_w1[i], hy_b1[i], hy_w2[i], hy_b2[i],
                     hy_w3[i], hy_freq[i], hy_skip[i])

        sh_m, sc_m, gt_m, sh_f, sc_f, gt_f = jnp.split(
            (silu_c @ w_ada[i] + b_ada[i])[:, None, :], 6, axis=-1)
        csh_m, csc_m, cgt_m, csh_f, csc_f, cgt_f = jnp.split(
            silu_cc @ w_ada[i] + b_ada[i], 6, axis=-1)

        u = rms_norm(h, g_mix[i]) * (1.0 + sc_m) + sh_m
        uc = rms_norm(hc, g_mix[i]) * (1.0 + csc_m) + csh_m
        z_hy, z_dq, z_dk, z_dv, z_gq, z_gk, z_gv = jnp.split(u @ w_in[i], IN_SPLITS, axis=-1)
        if last:
            zc_dk, zc_dv = jnp.split(uc @ w_in[i][:, OFF_DK:OFF_GQ], 2, axis=-1)
            zc_gk, zc_gv = jnp.split(uc @ w_in[i][:, OFF_GK:], 2, axis=-1)
        else:
            zc_hy, zc_dq, zc_dk, zc_dv, zc_gq, zc_gk, zc_gv = jnp.split(
                uc @ w_in[i], IN_SPLITS, axis=-1)

        kc_d = zc_dk.reshape(b, n_ctx, DIFF_HEADS, 2, DIFF_QK_DIM)
        vc_d = zc_dv.reshape(b, n_ctx, DIFF_HEADS, DIFF_V_DIM)
        kc_g = rms_norm(zc_gk.reshape(b, n_ctx, GQA_KV_HEADS, GQA_HEAD_DIM), gqa_knorm[i])
        vc_g = zc_gv.reshape(b, n_ctx, GQA_KV_HEADS, GQA_HEAD_DIM)

        q_d = apply_rope(z_dq.reshape(b, seq, DIFF_HEADS, 2, DIFF_QK_DIM), cos_d, sin_d)
        k_d = apply_rope(z_dk.reshape(b, seq, DIFF_HEADS, 2, DIFF_QK_DIM), cos_d, sin_d)
        v_d = z_dv.reshape(b, seq, DIFF_HEADS, DIFF_V_DIM)
        q_g = apply_rope(rms_norm(z_gq.reshape(b, seq, GQA_KV_HEADS, GQA_REP, GQA_HEAD_DIM),
                                  gqa_qnorm[i]), cos_g, sin_g)
        k_g = apply_rope(rms_norm(z_gk.reshape(b, seq, GQA_KV_HEADS, GQA_HEAD_DIM),
                                  gqa_knorm[i]), cos_g, sin_g)
        v_g = z_gv.reshape(b, seq, GQA_KV_HEADS, GQA_HEAD_DIM)

        y_hy = hyena_mixer(z_hy, *hy_params)
        o_d = diff_attention(q_d, jnp.concatenate([k_d, kc_d], axis=1),
                             jnp.concatenate([v_d, vc_d], axis=1), lam)
        o_g = gqa_attention(q_g, jnp.concatenate([k_g, kc_g], axis=1),
                            jnp.concatenate([v_g, vc_g], axis=1))
        y = merge_head_groups(y_hy, o_d, o_g, diff_subln[i], lam_init) @ w_out[i]
        h = h + gt_m * y
        if not last:
            qc_d = zc_dq.reshape(b, n_ctx, DIFF_HEADS, 2, DIFF_QK_DIM)
            qc_g = rms_norm(zc_gq.reshape(b, n_ctx, GQA_KV_HEADS, GQA_REP, GQA_HEAD_DIM),
                            gqa_qnorm[i])
            yc = merge_head_groups(hyena_mixer(zc_hy, *hy_params),
                                   diff_attention(qc_d, kc_d, vc_d, lam),
                                   gqa_attention(qc_g, kc_g, vc_g),
                                   diff_subln[i], lam_init) @ w_out[i]
            hc = hc + cgt_m * yc

        u = rms_norm(h, g_ffn[i]) * (1.0 + sc_f) + sh_f
        tokens = u.reshape(-1, d)
        n_c = 0
        if not last:
            uc = rms_norm(hc, g_ffn[i]) * (1.0 + csc_f) + csh_f
            tokens = jnp.concatenate([uc.reshape(-1, d), tokens], axis=0)
            n_c = b * n_ctx
        if i % 2 == 0:
            out = swiglu(tokens, ffn_wg[i // 2], ffn_wu[i // 2], ffn_wd[i // 2])
        else:
            out = moe_swiglu(tokens, moe_router[i // 2], moe_wg[i // 2], moe_wu[i // 2],
                             moe_wd[i // 2])
        h = h + gt_f * out[n_c:].reshape(h.shape)
        if not last:
            hc = hc + cgt_f * out[:n_c].reshape(hc.shape)
    return rms_norm(h, g_final)
```

```cpp
#include <hip/hip_runtime.h>
#include <hip/hip_bf16.h>
#include <cstdio>
#include <cstdint>
#include <cmath>
namespace pg8 {
#define PG8_LAS __attribute__((address_space(3)))
typedef unsigned short bf16_t;
typedef short bf16x8 __attribute__((ext_vector_type(8)));
typedef float f32x4 __attribute__((ext_vector_type(4)));
typedef unsigned u32x4 __attribute__((ext_vector_type(4)));
constexpr int BM = 256, BK = 64, HALF = 128, HTB = HALF * BK * 2  , STAGE_BYTES = 8 * HTB, NXCD = 8, WGM = 8;

__host__ __device__ __forceinline__ int lds_byte(int r, int c) { const int st = (r >> 4) * 2 + (c >> 5), rr = r & 15, cc = c & 31, ob = rr * 64 + cc * 2; return st * 1024 + (ob ^ (((ob >> 9) & 1) << 5)); }
__host__ __device__ __forceinline__ void stage_rc(int b, int& R, int& C) { const int st = b / 1024, sb = b % 1024, swz = sb ^ (((sb >> 9) & 1) << 5); R = (st >> 1) * 16 + swz / 64; C = (st & 1) * 32 + (swz % 64) / 2; }
__host__ __device__ __forceinline__ int perm32(int rho) { const int n = rho >> 4, i = rho & 15; return 8 * (i >> 2) + 4 * n + (i & 3); }

struct Unit { int pm, pn, pnl, e; };
struct Gemm { const bf16_t* A; const bf16_t* Bt; int M, N, K; };

__device__ __forceinline__ unsigned cvt_pk_bf16(float lo, float hi) { unsigned r; asm volatile("v_cvt_pk_bf16_f32 %0, %1, %2" : "=v"(r) : "v"(lo), "v"(hi)); return r; }
constexpr int P_ML = 32768, P_ZP = 2304, P_D = 1024, P_MODS = 6144;
constexpr float P_EPS = 1e-6f;
constexpr float C2D = 0.17677669529663687f * 1.4426950408889634f;
constexpr float C2G = 0.125f * 1.4426950408889634f;

struct Sched2 {
    int nM, nN, nwg, G, c, moe; int tb[9];
    __device__ __forceinline__ void init(int nM_, int nN_, int G_, int c_) { nM = nM_; nN = nN_; nwg = nM * nN; G = G_; c = c_; moe = 0; }
    __device__ __forceinline__ bool next(int i, Unit& u) const {
        const long L = (long)i * G + c; if (L >= nwg) return false;
        int wgid = (int)L; { const int q = nwg / NXCD, r = nwg % NXCD, xcd = wgid % NXCD, off = wgid / NXCD; wgid = (xcd < r ? xcd * (q + 1) : r * (q + 1) + (xcd - r) * q) + off; }
        const int nig = WGM * nN, gid = wgid / nig, fm = gid * WGM, gsz = (nM - fm) < WGM ? (nM - fm) : WGM;
        u.pm = fm + ((wgid % nig) % gsz); u.pnl = (wgid % nig) / gsz;
        int e = 0;
        if (moe) {
#pragma unroll
            for (int k = 1; k < 8; ++k) e += (u.pm >= tb[k]) ? 1 : 0;
        }
        u.e = e; u.pn = e * nN + u.pnl; return true;
    }
    __device__ __forceinline__ void a_ready(const Unit&) const {}
    __device__ __forceinline__ void done(const Unit&) const {}
};

struct EpiWin {
    static constexpr bool PERM = true, AFTER_DRAIN = false;
    bf16_t* Z; const float* rope;
    const float* qn; const float* kn;
    __device__ __forceinline__ void operator()(const f32x4 (&acc)[2][2][4][2], const Unit& u, int wr, int wc, int fr, int fq) const {
        const int pn = u.pnl, pm = u.pm; const bool lat = pm < 128;
        int kind;
        if (pn == 3 || pn == 4) kind = 1; else if (pn == 6 || pn == 7) kind = 2; else if (pn == 8) kind = (wc < 2) ? 2 : 3; else kind = 0;
        const float* Cd = rope; const float* Sd = rope + 512; const float* Cg = rope + 1024; const float* Sg = rope + 2048;
        float gn0[8], gn1[8];
        if (kind == 2) { const float* gp = (pn == 8) ? kn : qn;
#pragma unroll
            for (int j = 0; j < 8; ++j) { gn0[j] = gp[8 * fq + j]; gn1[j] = gp[32 + 8 * fq + j]; } }
#pragma unroll
        for (int ai = 0; ai < 2; ++ai)
#pragma unroll
            for (int m = 0; m < 4; ++m) {
                const int row = pm * BM + ai * HALF + wr * 64 + m * 16 + fr;
                const int grow = (4 * pm + 2 * ai + wr) & 63, gcol = 16 * m + fr;
                float x0[8], x1[8];
#pragma unroll
                for (int j = 0; j < 8; ++j) { x0[j] = acc[ai][0][m][j >> 2][j & 3]; x1[j] = acc[ai][1][m][j >> 2][j & 3]; }
                bf16_t* zr = Z + (size_t)row * P_ZP;
                int col0, col1;
                if (kind == 0) { col0 = pn * 256 + wc * 32 + 8 * fq; col1 = col0 + 128; }
                else if (kind == 3) { col0 = pn * 256 + wc * 64 + 8 * fq; col1 = col0 + 32; }
                else if (kind == 1) {
                    col0 = pn * 256 + wc * 64 + 32 * (fq >> 1) + 8 * (fq & 1); col1 = col0 + 16;
                    const float sc = (pn == 3) ? C2D : 1.0f;
                    if (lat) { const int pos = (fq & 1) ? gcol : grow;
                        const f32x4 c0 = *(const f32x4*)(Cd + pos * 8), c1 = *(const f32x4*)(Cd + pos * 8 + 4), s0 = *(const f32x4*)(Sd + pos * 8), s1 = *(const f32x4*)(Sd + pos * 8 + 4);
#pragma unroll
                        for (int j = 0; j < 8; ++j) { const float c = j < 4 ? c0[j & 3] : c1[j & 3], s = j < 4 ? s0[j & 3] : s1[j & 3]; const float a = x0[j], b = x1[j]; x0[j] = (a * c - b * s) * sc; x1[j] = (a * s + b * c) * sc; }
                    } else {
#pragma unroll
                        for (int j = 0; j < 8; ++j) { x0[j] *= sc; x1[j] *= sc; }
                    }
                } else {
                    col0 = pn * 256 + wc * 64 + 8 * fq; col1 = col0 + 32;
                    float ss = 0.f;
#pragma unroll
                    for (int j = 0; j < 8; ++j) ss += x0[j] * x0[j] + x1[j] * x1[j];
                    ss += __shfl_xor(ss, 16); ss += __shfl_xor(ss, 32);
                    const float rn = __builtin_amdgcn_rsqf(ss * (1.0f / 64.0f) + P_EPS);
                    const float sc = (pn == 8) ? 1.0f : C2G;
#pragma unroll
                    for (int j = 0; j < 8; ++j) { x0[j] = x0[j] * rn * gn0[j]; x1[j] = x1[j] * rn * gn1[j]; }
                    if (lat) { const int pos = (fq < 2) ? grow : gcol; const int fo = pos * 16 + 8 * (fq & 1);
                        const f32x4 c0 = *(const f32x4*)(Cg + fo), c1 = *(const f32x4*)(Cg + fo + 4), s0 = *(const f32x4*)(Sg + fo), s1 = *(const f32x4*)(Sg + fo + 4);
#pragma unroll
                        for (int j = 0; j < 8; ++j) { const float c = j < 4 ? c0[j & 3] : c1[j & 3], s = j < 4 ? s0[j & 3] : s1[j & 3]; const float a = x0[j], b = x1[j]; x0[j] = (a * c - b * s) * sc; x1[j] = (a * s + b * c) * sc; }
                    } else {
#pragma unroll
                        for (int j = 0; j < 8; ++j) { x0[j] *= sc; x1[j] *= sc; }
                    }
                }
                u32x4 w0, w1;
                w0.x = cvt_pk_bf16(x0[0], x0[1]); w0.y = cvt_pk_bf16(x0[2], x0[3]); w0.z = cvt_pk_bf16(x0[4], x0[5]); w0.w = cvt_pk_bf16(x0[6], x0[7]);
                w1.x = cvt_pk_bf16(x1[0], x1[1]); w1.y = cvt_pk_bf16(x1[2], x1[3]); w1.z = cvt_pk_bf16(x1[4], x1[5]); w1.w = cvt_pk_bf16(x1[6], x1[7]);
                *(u32x4*)(zr + col0) = w0; *(u32x4*)(zr + col1) = w1;
            }
    }
};

struct EpiRes {
    static constexpr bool PERM = false, AFTER_DRAIN = false;
    const float* base_l; const float* base_c; float* out_l; float* out_c; const float* gate;
    __device__ __forceinline__ void operator()(const f32x4 (&acc)[2][2][4][2], const Unit& u, int wr, int wc, int fr, int fq) const {
        const bool lat = u.pm < 128; const int mi = lat ? (u.pm >> 4) : 8;
        const int row0 = (lat ? u.pm : (u.pm - 128)) * BM + wr * 64 + fr, col0 = u.pnl * BM + wc * 32 + 4 * fq;
        const float* bp = lat ? base_l : base_c; float* op = lat ? out_l : out_c;
        f32x4 gv[2][2];
#pragma unroll
        for (int bj = 0; bj < 2; ++bj)
#pragma unroll
            for (int n = 0; n < 2; ++n) gv[bj][n] = *(const f32x4*)(gate + mi * P_MODS + col0 + bj * HALF + n * 16);
#pragma unroll
        for (int ai = 0; ai < 2; ++ai)
#pragma unroll
            for (int m = 0; m < 4; ++m) { const size_t off = (size_t)(row0 + ai * HALF + m * 16) * P_D + col0;
#pragma unroll
                for (int bj = 0; bj < 2; ++bj)
#pragma unroll
                    for (int n = 0; n < 2; ++n) { const f32x4 b = *(const f32x4*)(bp + off + bj * HALF + n * 16); *(f32x4*)(op + off + bj * HALF + n * 16) = b + gv[bj][n] * acc[ai][bj][m][n]; } }
    }
};

struct EpiSwiGLU {
    static constexpr bool PERM = true, AFTER_DRAIN = false;
    bf16_t* H; int ldh;
    __device__ __forceinline__ void operator()(const f32x4 (&acc)[2][2][4][2], const Unit& u, int wr, int wc, int fr, int fq) const {
        const int row0 = u.pm * BM + wr * 64 + fr, col0 = u.pnl * HALF + wc * 32 + 8 * fq;
#pragma unroll
        for (int ai = 0; ai < 2; ++ai)
#pragma unroll
            for (int m = 0; m < 4; ++m) {
                float v[8];
#pragma unroll
                for (int j = 0; j < 8; ++j) { const float g = acc[ai][0][m][j >> 2][j & 3], up = acc[ai][1][m][j >> 2][j & 3];
                    v[j] = g * __builtin_amdgcn_rcpf(1.0f + __builtin_amdgcn_exp2f(-1.4426950408889634f * g)) * up; }
                u32x4 w; w.x = cvt_pk_bf16(v[0], v[1]); w.y = cvt_pk_bf16(v[2], v[3]); w.z = cvt_pk_bf16(v[4], v[5]); w.w = cvt_pk_bf16(v[6], v[7]);
                *(u32x4*)(H + (size_t)(row0 + ai * HALF + m * 16) * ldh + col0) = w;
            }
    }
};

struct EpiBf {
    static constexpr bool PERM = true, AFTER_DRAIN = false;
    bf16_t* O; int ldc;
    __device__ __forceinline__ void operator()(const f32x4 (&acc)[2][2][4][2], const Unit& u, int wr, int wc, int fr, int fq) const {
        const int row0 = u.pm * BM + wr * 64 + fr, col0 = u.pnl * BM + wc * 32 + 8 * fq;
#pragma unroll
        for (int ai = 0; ai < 2; ++ai)
#pragma unroll
            for (int m = 0; m < 4; ++m) { bf16_t* rowp = O + (size_t)(row0 + ai * HALF + m * 16) * ldc + col0;
#pragma unroll
                for (int bj = 0; bj < 2; ++bj) { const f32x4 v0 = acc[ai][bj][m][0], v1 = acc[ai][bj][m][1];
                    u32x4 w; w.x = cvt_pk_bf16(v0[0], v0[1]); w.y = cvt_pk_bf16(v0[2], v0[3]); w.z = cvt_pk_bf16(v1[0], v1[1]); w.w = cvt_pk_bf16(v1[2], v1[3]);
                    *(u32x4*)(rowp + bj * HALF) = w; } }
    }
};
template <class Epi, class Sched, bool ALIGN_EPI = false, bool SP2 = false>
__device__ __forceinline__ void gemm_phase(PG8_LAS unsigned char* lds, const Gemm g, const Sched& S, const Epi& E) {
    int tid_ = threadIdx.x; asm volatile("" : "+v"(tid_));
    const int tid = tid_, wid = __builtin_amdgcn_readfirstlane(tid >> 6), lane = tid & 63, wr = wid >> 2, wc = wid & 3, fr = lane & 15, fq = lane >> 4;
    const int K = g.K, nt = K / BK;
    unsigned voffA[2], voffB[2];
#pragma unroll
    for (int i = 0; i < 2; ++i) { int R, C; stage_rc(tid * 16 + i * 8192, R, C); const int Rb = Epi::PERM ? ((R & ~31) + perm32(R & 31)) : R;
        voffA[i] = (unsigned)(R * K + C) * 2u; voffB[i] = (unsigned)(Rb * K + C) * 2u; }
    const size_t kstep = (size_t)(BK * 2);
    const size_t hstep = (size_t)HALF * K * 2;
    const size_t tstep = 2 * hstep;
    const unsigned ldsw = (unsigned)wid * 1024u;
    const int aoff = lds_byte(wr * 64 + fr, fq * 8), boff = lds_byte(wc * 32 + fr, fq * 8);
#define PG8_SA(b, h) (((b) * 2 + (h)) * HTB)
#define PG8_SB(b, h) ((4 + (b) * 2 + (h)) * HTB)
#define PG8_STAGE(bufoff, gbase, voff) do { _Pragma("unroll") for (int _i = 0; _i < 2; ++_i) \
        __builtin_amdgcn_global_load_lds((const unsigned*)((const char*)(gbase) + (voff)[_i]), (PG8_LAS unsigned*)(lds + (bufoff) + ldsw + _i * 8192), 16, 0, 0); } while (0)
#define PG8_LDA(dst, b, h) do { _Pragma("unroll") for (int m = 0; m < 4; ++m) _Pragma("unroll") for (int k = 0; k < 2; ++k) dst[m][k] = *(const PG8_LAS bf16x8*)(lds + PG8_SA(b, h) + aoff + m * 2048 + k * 1024); } while (0)
#define PG8_LDB(dst, b, h) do { _Pragma("unroll") for (int n = 0; n < 2; ++n) _Pragma("unroll") for (int k = 0; k < 2; ++k) dst[n][k] = *(const PG8_LAS bf16x8*)(lds + PG8_SB(b, h) + boff + n * 2048 + k * 1024); } while (0)
#define PG8_MMA(ai, bj, At, Bt) do { __builtin_amdgcn_s_setprio(1); _Pragma("unroll") for (int m = 0; m < 4; ++m) _Pragma("unroll") for (int n = 0; n < 2; ++n) _Pragma("unroll") for (int k = 0; k < 2; ++k) \
        acc[ai][bj][m][n] = __builtin_amdgcn_mfma_f32_16x16x32_bf16(Bt[n][k], At[m][k], acc[ai][bj][m][n], 0, 0, 0); __builtin_amdgcn_s_setprio(0); } while (0)
#define PG8_WAIT_V(n) asm volatile("s_waitcnt vmcnt(" #n ")" ::: "memory")
#define PG8_WAIT_L(n) asm volatile("s_waitcnt lgkmcnt(" #n ")" ::: "memory")
#define PG8_BAR __builtin_amdgcn_s_barrier()
#define PG8_SCHED __builtin_amdgcn_sched_barrier(0)
    Unit cur, nxt; int ui = 0;
    if (!S.next(0, cur)) return;
    f32x4 acc[2][2][4][2];
#pragma unroll
    for (int a = 0; a < 2; ++a)
#pragma unroll
        for (int b = 0; b < 2; ++b)
#pragma unroll
            for (int m = 0; m < 4; ++m)
#pragma unroll
                for (int n = 0; n < 2; ++n) acc[a][b][m][n] = (f32x4){0.f, 0.f, 0.f, 0.f};
    bf16x8 At[4][2], B0[2][2], B1[2][2];
    const char* cA = (const char*)g.A + (size_t)cur.pm * tstep; const char* cB = (const char*)g.Bt + (size_t)cur.pn * tstep;
    S.a_ready(cur);
    if constexpr (SP2) {
        PG8_STAGE(PG8_SB(0, 0), cB, voffB); PG8_STAGE(PG8_SB(0, 1), cB + hstep, voffB); PG8_STAGE(PG8_SA(0, 0), cA, voffA); PG8_STAGE(PG8_SA(0, 1), cA + hstep, voffA);
        if (wr == 1) PG8_BAR;
        PG8_WAIT_V(2); PG8_BAR;
        PG8_STAGE(PG8_SB(1, 0), cB + kstep, voffB); PG8_STAGE(PG8_SA(1, 0), cA + kstep, voffA); PG8_STAGE(PG8_SB(1, 1), cB + hstep + kstep, voffB);
        PG8_WAIT_V(6); PG8_BAR;
    } else {
        PG8_STAGE(PG8_SB(0, 0), cB, voffB); PG8_STAGE(PG8_SA(0, 0), cA, voffA); PG8_STAGE(PG8_SB(0, 1), cB + hstep, voffB); PG8_STAGE(PG8_SA(0, 1), cA + hstep, voffA);
        if (wr == 1) PG8_BAR;
        PG8_WAIT_V(4); PG8_BAR;
        PG8_STAGE(PG8_SB(1, 0), cB + kstep, voffB); PG8_STAGE(PG8_SA(1, 0), cA + kstep, voffA); PG8_STAGE(PG8_SB(1, 1), cB + hstep + kstep, voffB);
        PG8_WAIT_V(6); PG8_BAR;
    }
    for (;;) {
        const bool has_next = S.next(ui + 1, nxt);
        const char* nA = has_next ? (const char*)g.A + (size_t)nxt.pm * tstep : cA; const char* nB = has_next ? (const char*)g.Bt + (size_t)nxt.pn * tstep : cB;
        for (int t = 0; t < nt; t += 2) {
            const bool last = (t == nt - 2);
            const char* a1 = cA + (size_t)(t + 1) * kstep;
            const char* a2 = last ? nA : cA + (size_t)(t + 2) * kstep; const char* b2 = last ? nB : cB + (size_t)(t + 2) * kstep;
            const char* a3 = a2 + kstep; const char* b3 = b2 + kstep;
            if (last && has_next) S.a_ready(nxt);
            if constexpr (SP2) {
            PG8_LDB(B0, 0, 0); PG8_LDB(B1, 0, 1); PG8_SCHED; PG8_LDA(At, 0, 0); PG8_STAGE(PG8_SA(1, 1), a1 + hstep, voffA);
            PG8_WAIT_V(8); PG8_WAIT_L(0); PG8_BAR; PG8_MMA(0, 0, At, B0); PG8_MMA(0, 1, At, B1); PG8_BAR; PG8_SCHED;
            PG8_LDA(At, 0, 1); PG8_STAGE(PG8_SB(0, 0), b2, voffB); PG8_STAGE(PG8_SB(0, 1), b2 + hstep, voffB); PG8_STAGE(PG8_SA(0, 0), a2, voffA);
            PG8_WAIT_V(8); PG8_WAIT_L(0); PG8_BAR; PG8_MMA(1, 0, At, B0); PG8_MMA(1, 1, At, B1); PG8_BAR; PG8_SCHED;
            PG8_LDB(B0, 1, 0); PG8_LDB(B1, 1, 1); PG8_SCHED; PG8_LDA(At, 1, 0); PG8_STAGE(PG8_SA(0, 1), a2 + hstep, voffA);
            PG8_WAIT_V(8); PG8_WAIT_L(0); PG8_BAR; PG8_MMA(0, 0, At, B0); PG8_MMA(0, 1, At, B1); PG8_BAR; PG8_SCHED;
            PG8_LDA(At, 1, 1); PG8_STAGE(PG8_SB(1, 0), b3, voffB); PG8_STAGE(PG8_SB(1, 1), b3 + hstep, voffB); PG8_STAGE(PG8_SA(1, 0), a3, voffA);
            PG8_WAIT_V(8); PG8_WAIT_L(0); PG8_BAR; PG8_MMA(1, 0, At, B0); PG8_MMA(1, 1, At, B1); PG8_BAR; PG8_SCHED;
            } else {
            PG8_LDB(B0, 0, 0); PG8_SCHED; PG8_LDA(At, 0, 0); PG8_STAGE(PG8_SA(1, 1), a1 + hstep, voffA);
            PG8_WAIT_L(8); PG8_BAR; PG8_WAIT_L(0); PG8_MMA(0, 0, At, B0); PG8_BAR; PG8_SCHED;
            PG8_LDB(B1, 0, 1); PG8_STAGE(PG8_SB(0, 0), b2, voffB);
            PG8_BAR; PG8_WAIT_L(0); PG8_MMA(0, 1, At, B1); PG8_BAR;
            PG8_LDA(At, 0, 1); PG8_STAGE(PG8_SA(0, 0), a2, voffA);
            PG8_BAR; PG8_WAIT_L(0); PG8_MMA(1, 0, At, B0); PG8_BAR; PG8_SCHED;
            PG8_STAGE(PG8_SB(0, 1), b2 + hstep, voffB);
            PG8_WAIT_V(6); PG8_BAR; PG8_MMA(1, 1, At, B1); PG8_BAR;
            PG8_LDB(B0, 1, 0); PG8_SCHED; PG8_LDA(At, 1, 0); PG8_STAGE(PG8_SA(0, 1), a2 + hstep, voffA);
            PG8_WAIT_L(8); PG8_BAR; PG8_WAIT_L(0); PG8_MMA(0, 0, At, B0); PG8_BAR; PG8_SCHED;
            PG8_LDB(B1, 1, 1); PG8_STAGE(PG8_SB(1, 0), b3, voffB);
            PG8_BAR; PG8_WAIT_L(0); PG8_MMA(0, 1, At, B1); PG8_BAR;
            PG8_LDA(At, 1, 1); PG8_STAGE(PG8_SA(1, 0), a3, voffA);
            PG8_BAR; PG8_WAIT_L(0); PG8_MMA(1, 0, At, B0); PG8_BAR; PG8_SCHED;
            PG8_STAGE(PG8_SB(1, 1), b3 + hstep, voffB);
            PG8_WAIT_V(6); PG8_BAR; PG8_MMA(1, 1, At, B1); PG8_BAR;
            }
        }
        if constexpr (ALIGN_EPI) { if (wr == 0) PG8_BAR; }
        if constexpr (!Epi::AFTER_DRAIN) { E(acc, cur, wr, wc, fr, fq); S.done(cur); }
        if (!has_next) break;
#pragma unroll
        for (int a = 0; a < 2; ++a)
#pragma unroll
            for (int b = 0; b < 2; ++b)
#pragma unroll
                for (int m = 0; m < 4; ++m)
#pragma unroll
                    for (int n = 0; n < 2; ++n) acc[a][b][m][n] = (f32x4){0.f, 0.f, 0.f, 0.f};
        cur = nxt; cA = nA; cB = nB; ++ui;
        if constexpr (ALIGN_EPI) { if (wr == 1) PG8_BAR; }
    }
    PG8_WAIT_V(0);
    if constexpr (!ALIGN_EPI) { if (wr == 0) PG8_BAR; }
    PG8_BAR;
    if constexpr (Epi::AFTER_DRAIN) { E.fused(acc, cur, wr, wc, fr, fq, lds, wid, lane); S.done(cur); }
#undef PG8_SA
#undef PG8_SB
#undef PG8_STAGE
#undef PG8_LDA
#undef PG8_LDB
#undef PG8_MMA
#undef PG8_WAIT_V
#undef PG8_WAIT_L
#undef PG8_BAR
#undef PG8_SCHED
}
}
#ifndef ATTN_STORE16
#define ATTN_STORE16(p,v) (*(u32x4*)(p)=(v))
#endif
namespace attn_body {
using bf16=__hip_bfloat16;
using bf16x8=__attribute__((ext_vector_type(8)))short;
using s16x4=__attribute__((ext_vector_type(4)))short;
using f32x16=__attribute__((ext_vector_type(16)))float;
using u32x4=__attribute__((ext_vector_type(4)))unsigned;
constexpr int D=64,ZP=2304,OP=1024;
constexpr int NW=8,QBLK=32,QB=QBLK*NW,KVBLK=64;
__device__ __forceinline__ int crow(int r,int hi){return (r&3)+8*(r>>2)+4*hi;}
#define SBAR() __builtin_amdgcn_sched_barrier(0)
constexpr int NSLOT=3, SLOTB=8192;
constexpr int LDS_K=0, LDS_V=NSLOT*SLOTB, LDS_WS=2*NSLOT*SLOTB, LDS_OST=LDS_WS+NW*64*4, LDS_BYTES=LDS_OST+NW*8192;
__device__ __forceinline__ void glds16(const void*gsrc,unsigned lds_dst){unsigned keep;
  asm volatile("s_mov_b32 %0, m0\n\ts_mov_b32 m0, %2\n\ts_nop 0\n\tglobal_load_lds_dwordx4 %1, off\n\ts_mov_b32 m0, %0":"=&s"(keep):"v"(gsrc),"s"(lds_dst):"memory");}
__device__ __forceinline__ float max3f(float a,float b,float c){float r;asm("v_max3_f32 %0, %1, %2, %3":"=v"(r):"v"(a),"v"(b),"v"(c));return r;}
__device__ __forceinline__ float max2f(float a,float b){float r;asm("v_max_f32_e32 %0, %1, %2":"=v"(r):"v"(a),"v"(b));return r;}
__device__ __forceinline__ float fadd_s(float a,float b){float r;asm("v_add_f32_e32 %0, %1, %2":"=v"(r):"v"(a),"v"(b));return r;}
__device__ __forceinline__ float fsub_s(float a,float b){float r;asm("v_sub_f32_e32 %0, %1, %2":"=v"(r):"v"(a),"v"(b));return r;}
typedef float f32x2_t __attribute__((ext_vector_type(2))); typedef __bf16 bf16x2_t __attribute__((ext_vector_type(2)));
__device__ __forceinline__ unsigned cvtpk_s(float lo,float hi){f32x2_t v={lo,hi};bf16x2_t b=__builtin_convertvector(v,bf16x2_t);return __builtin_bit_cast(unsigned,b);}
#define WAIT_BAR(N) asm volatile("s_waitcnt vmcnt(" #N ") lgkmcnt(0)\n\ts_barrier":::"memory")

__device__ __forceinline__ void qkt(f32x16&p0,f32x16&p1,const char*Kslot,const bf16x8*qr,const f32x16&negm,int r32,int hi){
  const char*kb=Kslot+hi*1024+r32*16;
  #pragma unroll
  for(int d0=0;d0<4;++d0){
    const bf16x8 b0=*reinterpret_cast<const bf16x8*>(kb+d0*2048);
    const bf16x8 b1=*reinterpret_cast<const bf16x8*>(kb+d0*2048+512);
    if(d0==0){p0=__builtin_amdgcn_mfma_f32_32x32x16_bf16(b0,qr[0],negm,0,0,0);p1=__builtin_amdgcn_mfma_f32_32x32x16_bf16(b1,qr[0],negm,0,0,0);}
    else{p0=__builtin_amdgcn_mfma_f32_32x32x16_bf16(b0,qr[d0],p0,0,0,0);p1=__builtin_amdgcn_mfma_f32_32x32x16_bf16(b1,qr[d0],p1,0,0,0);}}
}
typedef __attribute__((address_space(3))) const char* lds_cptr;
typedef short v4i16_t __attribute__((ext_vector_type(4)));
__device__ __forceinline__ void kload8(bf16x8*kf,lds_cptr kp){
  kf[0]=*(const __attribute__((address_space(3))) bf16x8*)(kp);      kf[1]=*(const __attribute__((address_space(3))) bf16x8*)(kp+512);
  kf[2]=*(const __attribute__((address_space(3))) bf16x8*)(kp+2048); kf[3]=*(const __attribute__((address_space(3))) bf16x8*)(kp+2560);
  kf[4]=*(const __attribute__((address_space(3))) bf16x8*)(kp+4096); kf[5]=*(const __attribute__((address_space(3))) bf16x8*)(kp+4608);
  kf[6]=*(const __attribute__((address_space(3))) bf16x8*)(kp+6144); kf[7]=*(const __attribute__((address_space(3))) bf16x8*)(kp+6656);
}
__device__ __forceinline__ void kload2(bf16x8*kf,lds_cptr kp,int j){ kf[2*j]=*(const __attribute__((address_space(3))) bf16x8*)(kp+j*2048); kf[2*j+1]=*(const __attribute__((address_space(3))) bf16x8*)(kp+j*2048+512); }
__device__ __forceinline__ s16x4 vtr(lds_cptr p){ return __builtin_bit_cast(s16x4,__builtin_amdgcn_ds_read_tr16_b64_v4i16((__attribute__((address_space(3))) v4i16_t*)p)); }
__device__ __forceinline__ float rowmax(const f32x16&p0,const f32x16&p1){
  float a=max3f(p0[0],p0[1],p1[0]),b=max3f(p0[2],p0[3],p1[1]);a=max3f(a,p1[2],p1[3]);
  #pragma unroll
  for(int r=4;r<16;r+=4){a=max3f(a,p0[r],p0[r+1]);b=max3f(b,p0[r+2],p0[r+3]);a=max3f(a,p1[r],p1[r+1]);b=max3f(b,p1[r+2],p1[r+3]);}
  const float m=max2f(a,b);
  auto rr=__builtin_amdgcn_permlane32_swap(__float_as_uint(m),__float_as_uint(m),false,false);
  return max2f(__uint_as_float(rr[0]),__uint_as_float(rr[1]));
}
__device__ __forceinline__ void pv(f32x16*o,int vb,bf16x8 pa0,bf16x8 pa1,bf16x8 pa2,bf16x8 pa3){
  #pragma unroll
  for(int d0=0;d0<2;++d0){s16x4 lo[4],hi[4];
    #pragma unroll
    for(int ks=0;ks<4;++ks){
      asm volatile("ds_read_b64_tr_b16 %0,%1 offset:%c2":"=&v"(lo[ks]):"v"(vb),"i"(d0*4096+ks*1024):"memory");
      asm volatile("ds_read_b64_tr_b16 %0,%1 offset:%c2":"=&v"(hi[ks]):"v"(vb),"i"(d0*4096+ks*1024+512):"memory");}
    asm volatile("s_waitcnt lgkmcnt(0)":::"memory");SBAR();
    #define PK(k) (bf16x8){lo[k][0],lo[k][1],lo[k][2],lo[k][3],hi[k][0],hi[k][1],hi[k][2],hi[k][3]}
    o[d0]=__builtin_amdgcn_mfma_f32_32x32x16_bf16(pa0,PK(0),o[d0],0,0,0);
    o[d0]=__builtin_amdgcn_mfma_f32_32x32x16_bf16(pa1,PK(1),o[d0],0,0,0);
    o[d0]=__builtin_amdgcn_mfma_f32_32x32x16_bf16(pa2,PK(2),o[d0],0,0,0);
    o[d0]=__builtin_amdgcn_mfma_f32_32x32x16_bf16(pa3,PK(3),o[d0],0,0,0);
    #undef PK
  }
}

template<int MODE,int THRL> __device__ __forceinline__ void attn_unit(const bf16*Zq,const bf16*__restrict__ Zk,const bf16*__restrict__ Zv,int krow_lat,int krow_ctx,int nlat,int NT,bf16*Oblk,char*shm,float lam,const float*subln,float sub_scale){
  int tid_=threadIdx.x; asm volatile("":"+v"(tid_));
  const int tid=tid_,lane=tid&63,r32=lane&31,hi=lane>>5; const int wid=__builtin_amdgcn_readfirstlane(tid>>6);
  const bf16*Qw=Zq+(long)(wid*QBLK)*ZP;
  const unsigned lds0=(unsigned)(uintptr_t)shm;
  float*wsf=(float*)(shm+LDS_WS)+wid*64;
  const bf16*ksrc=Zk+(long)lane*ZP+wid*8;
  const bf16*vsrc=Zv+(long)(16*(wid&3)+(lane>>2))*ZP+(wid>>2)*32+(lane&3)*8;
  const unsigned kdst=lds0+LDS_K+wid*1024, vdst=lds0+LDS_V+wid*1024;
  #define KROW(t) ((long)(((t)<nlat)?(krow_lat+64*(t)):(krow_ctx+64*((t)-nlat)))*ZP)
  #define DMA_K(t,slot) glds16(ksrc+KROW(t),(unsigned)__builtin_amdgcn_readfirstlane(kdst+(slot)))
  #define DMA_V(t,slot) glds16(vsrc+KROW(t),(unsigned)__builtin_amdgcn_readfirstlane(vdst+(slot)))
  const int vb0=(int)(lds0+LDS_V)+((lane>>4)&1)*32+(lane&3)*8+(4*hi+((lane&15)>>2))*64;
  const char*Kbase=shm+LDS_K; bf16x8 kf[8];
  const lds_cptr shm3=(lds_cptr)shm; const lds_cptr kp0=shm3+LDS_K+hi*1024+r32*16; const lds_cptr vp0=shm3+LDS_V+((lane>>4)&1)*32+(lane&3)*8+(4*hi+((lane&15)>>2))*64;
  float*o1s=(float*)(shm+LDS_OST+wid*8192);
  for(int pass=0;pass<(MODE?2:1);++pass){
  DMA_K(0,0);DMA_V(0,0);DMA_K(1,SLOTB);
  bf16x8 qr[4];
  #pragma unroll
  for(int d0=0;d0<4;++d0)qr[d0]=*reinterpret_cast<const bf16x8*>(&Qw[(long)r32*ZP+d0*16+hi*8]);
  if(MODE==1){ const bf16x8 zz={0,0,0,0,0,0,0,0}; if(pass==0){qr[2]=zz;qr[3]=zz;} else {qr[0]=zz;qr[1]=zz;} }
  float mhat=0.f,l_reg=0.f;f32x16 o[2];o[0]=f32x16{};o[1]=f32x16{};f32x16 negm=f32x16{};asm volatile("":"+v"(negm));
  #define CMASK(P0,P1,t) do{}while(0)
  bool resc=false;
  #define START(P0,P1) do{ const float rm=rowmax(P0,P1); resc=false; \
    { const float dl=rm; mhat=fadd_s(mhat,dl); \
      _Pragma("unroll") for(int r=0;r<16;++r){P0[r]=fsub_s(P0[r],dl);P1[r]=fsub_s(P1[r],dl);} \
      _Pragma("unroll") for(int r=0;r<16;++r)negm[r]=-mhat; asm volatile("":"+v"(negm)); } \
    _Pragma("unroll") for(int r=0;r<16;++r)P0[r]=__builtin_amdgcn_exp2f(P0[r]); }while(0)
  #define RESC() do{ if(resc){ asm volatile("s_waitcnt lgkmcnt(0)":::"memory"); \
      _Pragma("unroll") for(int d_=0;d_<2;++d_) _Pragma("unroll") for(int r=0;r<16;++r)o[d_][r]*=wsf[crow(r,hi)]; } }while(0)
  f32x16 pA0,pA1,pB0,pB1;
  int sl_prev=0,sl_cur=0,sl_next=SLOTB;
  #define ROT() do{sl_prev=sl_cur;sl_cur=sl_next;sl_next=(sl_next==(NSLOT-1)*SLOTB)?0:sl_next+SLOTB;}while(0)
  DMA_K(2,2*SLOTB);
  WAIT_BAR(3);
  qkt(pA0,pA1,Kbase,qr,negm,r32,hi);asm volatile("s_nop 15\n\ts_nop 7":"+v"(pA0),"+v"(pA1));CMASK(pA0,pA1,0);
  START(pA0,pA1);
  _Pragma("unroll") for(int r=0;r<16;++r)pA1[r]=__builtin_amdgcn_exp2f(pA1[r]);
  WAIT_BAR(0);
  DMA_K(3,0);DMA_V(1,SLOTB);
  ROT();
  kload8(kf,kp0+sl_cur);
  WAIT_BAR(2);
  s16x4 vlo[8],vhi[8]; u32x4 pw0,pw1,pw2,pw3;
  #define PKW(P,B) cvtpk_s(P[B],P[B+1])
  #define PAF(k) __builtin_bit_cast(bf16x8,pw##k)
  #define VFR(i) (bf16x8){vlo[i][0],vlo[i][1],vlo[i][2],vlo[i][3],vhi[i][0],vhi[i][1],vhi[i][2],vhi[i][3]}
  #define PIN(x) asm volatile("":"+v"(x))
  #define MX3(a,b,c) __builtin_fmaxf(__builtin_fmaxf((a),(b)),(c))
  #define GAPA(MF,A0,A1,A2,A3,W0,W1,PW) do{ MF; sacc+=A0; sacc+=A1; sacc+=A2; sacc+=A3; PIN(sacc); W0; W1; PIN(PW); SBAR(); }while(0)
  #define EX(v) __builtin_amdgcn_exp2f(v)
  #define GAPB(MF,X,B) do{ MF; X[B]=EX(X[B]); X[B+1]=EX(X[B+1]); X[B+2]=EX(X[B+2]); X[B+3]=EX(X[B+3]); PIN(X); SBAR(); }while(0)
  #define VRD(i) do{ vlo[i]=vtr(vp_+(((i)>>2)*4096+((i)&3)*1024)); vhi[i]=vtr(vp_+(((i)>>2)*4096+((i)&3)*1024+512)); }while(0)
  #define KRD(G,j) do{ if(G){ kload2(kf,kp0+sl_next,j); SBAR(); } }while(0)
  #define STEP(C0,C1,P0,P1,t,GK,GV,GL) do{ SBAR(); \
    const lds_cptr vp_=vp0+sl_prev; \
    VRD(0); SBAR(); float sacc=(P0[0]+P0[1]); \
    GAPA(C0=__builtin_amdgcn_mfma_f32_32x32x16_bf16(kf[0],qr[0],negm,0,0,0), P0[2],P0[3],P0[4],P0[5],     pw0[0]=PKW(P0,0), pw0[1]=PKW(P0,2), pw0); \
    VRD(4); SBAR(); GAPA(C1=__builtin_amdgcn_mfma_f32_32x32x16_bf16(kf[1],qr[0],negm,0,0,0), P0[6],P0[7],P0[8],P0[9],     pw0[2]=PKW(P0,4), pw0[3]=PKW(P0,6), pw0); \
    VRD(1); SBAR(); GAPA(C0=__builtin_amdgcn_mfma_f32_32x32x16_bf16(kf[2],qr[1],C0,0,0,0),   P0[10],P0[11],P0[12],P0[13], pw1[0]=PKW(P0,8), pw1[1]=PKW(P0,10), pw1); \
    VRD(5); SBAR(); GAPA(C1=__builtin_amdgcn_mfma_f32_32x32x16_bf16(kf[3],qr[1],C1,0,0,0),   P0[14],P0[15],P1[0],P1[1],   pw1[2]=PKW(P0,12),pw1[3]=PKW(P0,14), pw1); \
    VRD(2); SBAR(); GAPA(C0=__builtin_amdgcn_mfma_f32_32x32x16_bf16(kf[4],qr[2],C0,0,0,0),   P1[2],P1[3],P1[4],P1[5],     pw2[0]=PKW(P1,0), pw2[1]=PKW(P1,2), pw2); \
    VRD(6); SBAR(); GAPA(C1=__builtin_amdgcn_mfma_f32_32x32x16_bf16(kf[5],qr[2],C1,0,0,0),   P1[6],P1[7],P1[8],P1[9],     pw2[2]=PKW(P1,4), pw2[3]=PKW(P1,6), pw2); \
    VRD(3); SBAR(); GAPA(C0=__builtin_amdgcn_mfma_f32_32x32x16_bf16(kf[6],qr[3],C0,0,0,0),   P1[10],P1[11],P1[12],P1[13], pw3[0]=PKW(P1,8), pw3[1]=PKW(P1,10), pw3); \
    VRD(7); SBAR(); GAPA(C1=__builtin_amdgcn_mfma_f32_32x32x16_bf16(kf[7],qr[3],C1,0,0,0),   P1[14],P1[15],0.f,0.f,       pw3[2]=PKW(P1,12),pw3[3]=PKW(P1,14), pw3); \
    l_reg+=sacc; \
    if(GK){DMA_K((t)+3,sl_cur);} if(GV){DMA_V((t)+1,sl_next);} \
    CMASK(C0,C1,t); \
    { float a=MX3(C0[0],C0[1],C1[0]),b=MX3(C0[2],C0[3],C1[1]); a=MX3(a,C1[2],C1[3]); \
      _Pragma("unroll") for(int r=4;r<16;r+=4){a=MX3(a,C0[r],C0[r+1]);b=MX3(b,C0[r+2],C0[r+3]);a=MX3(a,C1[r],C1[r+1]);b=MX3(b,C1[r+2],C1[r+3]);} \
      float rm=__builtin_fmaxf(a,b); { auto rr=__builtin_amdgcn_permlane32_swap(__float_as_uint(rm),__float_as_uint(rm),false,false); rm=__builtin_fmaxf(__uint_as_float(rr[0]),__uint_as_float(rr[1])); } \
      resc=false; \
      if(__builtin_expect(__any(rm>(float)THRL),0)){ const float dl=__builtin_fmaxf(rm,0.f); mhat+=dl; \
        _Pragma("unroll") for(int r=0;r<16;++r){C0[r]-=dl;C1[r]-=dl;} \
        _Pragma("unroll") for(int r=0;r<16;++r)negm[r]=-mhat; asm volatile("":"+v"(negm)); \
        const float f=__builtin_amdgcn_exp2f(-dl); l_reg*=f; if(hi==0)wsf[r32]=f; resc=true; } } \
    SBAR(); \
    GAPB(o[0]=__builtin_amdgcn_mfma_f32_32x32x16_bf16(PAF(0),VFR(0),o[0],0,0,0), C0,0); \
    GAPB(o[1]=__builtin_amdgcn_mfma_f32_32x32x16_bf16(PAF(0),VFR(4),o[1],0,0,0), C0,4); \
    KRD(GL,0); GAPB(o[0]=__builtin_amdgcn_mfma_f32_32x32x16_bf16(PAF(1),VFR(1),o[0],0,0,0), C0,8); \
    KRD(GL,1); GAPB(o[1]=__builtin_amdgcn_mfma_f32_32x32x16_bf16(PAF(1),VFR(5),o[1],0,0,0), C0,12); \
    KRD(GL,2); GAPB(o[0]=__builtin_amdgcn_mfma_f32_32x32x16_bf16(PAF(2),VFR(2),o[0],0,0,0), C1,0); \
    KRD(GL,3); GAPB(o[1]=__builtin_amdgcn_mfma_f32_32x32x16_bf16(PAF(2),VFR(6),o[1],0,0,0), C1,4); \
    GAPB(o[0]=__builtin_amdgcn_mfma_f32_32x32x16_bf16(PAF(3),VFR(3),o[0],0,0,0), C1,8); \
    GAPB(o[1]=__builtin_amdgcn_mfma_f32_32x32x16_bf16(PAF(3),VFR(7),o[1],0,0,0), C1,12); \
    }while(0)
  int t=1;
  #undef CMASK
  #define CMASK(P0,P1,t) do{}while(0)
  for(;t+5<NT;t+=2){
    STEP(pB0,pB1,pA0,pA1,t,true,true,true);     WAIT_BAR(2); RESC(); ROT();
    STEP(pA0,pA1,pB0,pB1,t+1,true,true,true);   WAIT_BAR(2); RESC(); ROT();
  }
  #undef CMASK
  #define CMASK(P0,P1,t) do{}while(0)
  #define ENDW(tt) do{ if((tt)+3<NT){WAIT_BAR(2);} else if((tt)+2<NT){WAIT_BAR(1);} else {WAIT_BAR(0);} }while(0)
  for(;t+1<NT;t+=2){
    STEP(pB0,pB1,pA0,pA1,t,(t+3<NT),(t+1<NT),(t+1<NT));       ENDW(t);   RESC(); ROT();
    STEP(pA0,pA1,pB0,pB1,t+1,(t+4<NT),(t+2<NT),(t+2<NT));     ENDW(t+1); RESC(); ROT();
  }
  STEP(pB0,pB1,pA0,pA1,NT-1,false,false,false); RESC();
  { float sacc=pB0[0]+pB0[1]; _Pragma("unroll") for(int r=2;r<16;++r)sacc+=pB0[r]; _Pragma("unroll") for(int r=0;r<16;++r)sacc+=pB1[r]; l_reg+=sacc;
    pw0=(u32x4){PKW(pB0,0),PKW(pB0,2),PKW(pB0,4),PKW(pB0,6)};pw1=(u32x4){PKW(pB0,8),PKW(pB0,10),PKW(pB0,12),PKW(pB0,14)};pw2=(u32x4){PKW(pB1,0),PKW(pB1,2),PKW(pB1,4),PKW(pB1,6)};pw3=(u32x4){PKW(pB1,8),PKW(pB1,10),PKW(pB1,12),PKW(pB1,14)};
    SBAR(); pv(o,vb0+sl_cur,PAF(0),PAF(1),PAF(2),PAF(3)); }
  #undef PKW
  #undef PAF
  #undef VFR
  #undef PIN
  #undef MX3
  #undef GAPA
  #undef GAPB
  #undef EX
  #undef VRD
  #undef KRD
  #undef STEP
  #undef ENDW
  {auto rr=__builtin_amdgcn_permlane32_swap(__float_as_uint(l_reg),__float_as_uint(l_reg),false,false);l_reg=__uint_as_float(rr[0])+__uint_as_float(rr[1]);}
  if(hi==0)wsf[32+r32]=l_reg;asm volatile("s_waitcnt lgkmcnt(0)":::"memory");
  float rli[16];
  #pragma unroll
  for(int r=0;r<16;++r)rli[r]=__builtin_amdgcn_rcpf(wsf[32+crow(r,hi)]);
  if(MODE==1&&pass==0){
    #pragma unroll
    for(int d0=0;d0<2;++d0){
      #pragma unroll
      for(int r=0;r<16;++r)o1s[(d0*16+r)*64+lane]=o[d0][r]*rli[r];}
  } else {
    bf16*stg=(bf16*)o1s;
    if(MODE==1){
      float g0=subln[r32]*sub_scale,g1=subln[32+r32]*sub_scale;
      #pragma unroll
      for(int d0=0;d0<2;++d0){
        #pragma unroll
        for(int r=0;r<16;++r)o[d0][r]=o1s[(d0*16+r)*64+lane]-lam*(o[d0][r]*rli[r]);}
      asm volatile("s_waitcnt lgkmcnt(0)":::"memory");
      #pragma unroll
      for(int r=0;r<16;++r){float ss=o[0][r]*o[0][r]+o[1][r]*o[1][r];
        ss+=__shfl_xor(ss,1);ss+=__shfl_xor(ss,2);ss+=__shfl_xor(ss,4);ss+=__shfl_xor(ss,8);ss+=__shfl_xor(ss,16);
        const float rn=__builtin_amdgcn_rsqf(ss*(1.0f/64.0f)+1e-6f); const int orow=crow(r,hi);
        stg[orow*64+r32]=__float2bfloat16(o[0][r]*rn*g0); stg[orow*64+32+r32]=__float2bfloat16(o[1][r]*rn*g1);}
    } else {
      #pragma unroll
      for(int r=0;r<16;++r){const int orow=crow(r,hi);
        #pragma unroll
        for(int d0=0;d0<2;++d0)stg[orow*64+d0*32+r32]=__float2bfloat16(o[d0][r]*rli[r]);}
    }
    asm volatile("s_waitcnt lgkmcnt(0)":::"memory");
    bf16*Ow=Oblk+(long)(wid*QBLK)*OP;
    #pragma unroll
    for(int i=0;i<4;++i){const int row=i*8+(lane>>3),ch=lane&7; const u32x4 v=*(const u32x4*)(stg+row*64+ch*8); ATTN_STORE16(Ow+(long)row*OP+ch*8,v);}
  }
  asm volatile("s_waitcnt lgkmcnt(0)\n\ts_barrier":::"memory");
  }
  #undef KROW
  #undef DMA_K
  #undef DMA_V
  #undef CMASK
  #undef START
  #undef RESC
  #undef ROT
}
#undef SBAR
#undef WAIT_BAR
}
namespace hy {
#define HY_LAS __attribute__((address_space(3)))
typedef short bf16x8 __attribute__((ext_vector_type(8)));
typedef short bf16x4 __attribute__((ext_vector_type(4)));
typedef float f32x4 __attribute__((ext_vector_type(4)));
typedef unsigned u32x4 __attribute__((ext_vector_type(4)));
typedef unsigned u32x2 __attribute__((ext_vector_type(2)));
__device__ __forceinline__ float bf2f(unsigned short h) { return __uint_as_float((unsigned)h << 16); }
__device__ __forceinline__ unsigned pk2(float lo, float hi) { unsigned r; asm volatile("v_cvt_pk_bf16_f32 %0, %1, %2" : "=v"(r) : "v"(lo), "v"(hi)); return r; }

template <int NP, int NBLK>
__device__ __forceinline__ void conv_unit(HY_LAS unsigned char* lds, const unsigned short* __restrict__ Rg, const unsigned short* __restrict__ vvT, const unsigned short* __restrict__ x0T, unsigned short* __restrict__ yT, float skip) {
    constexpr int L = 64 * NBLK, VBYTES = 16 * L, CSB = 4 * L + 64, NWORDS = L / 2 + 1, RC = VBYTES;
    int tid_ = threadIdx.x; asm volatile("" : "+v"(tid_));
    const int tid = tid_, lane = tid & 63, wid = __builtin_amdgcn_readfirstlane(tid >> 6);
    for (int g = tid; g < L; g += 512) *(HY_LAS u32x4*)(lds + g * 16) = *(const u32x4*)(vvT + (size_t)g * 8);
    const unsigned long long* G = (const unsigned long long*)Rg;
#pragma unroll
    for (int s = 0; s < 4; ++s)
        for (int w = tid; w < NWORDS; w += 512) {
            const unsigned long long lo = (w >= 1) ? G[w - 1] : 0ull, hi = (w < L / 2) ? G[w] : 0ull;
            const unsigned long long v = (s == 0) ? hi : ((hi << (16 * s)) | (lo >> (64 - 16 * s)));
            *(HY_LAS unsigned long long*)(lds + RC + s * CSB + w * 8) = v;
        }
    __syncthreads();
    const int fr = lane & 15, fq = lane >> 4, sh = fr & 3, ql = fr >> 3, bb = fr & 7;
    if (wid < NBLK / (2 * NP)) {
        f32x4 acc[NP][4];
#pragma unroll
        for (int p = 0; p < NP; ++p)
#pragma unroll
            for (int ic = 0; ic < 4; ++ic) acc[p][ic] = (f32x4){0.f, 0.f, 0.f, 0.f};
        const int tb0 = 2 * NP * wid;
        const int abase = RC + sh * CSB + 2 * (L - fr + 8 * fq + sh) - 96;
        for (int d = tb0 - (NBLK - 1); d <= tb0 + 2 * NP - 1; ++d) {
            bf16x8 A[4][2];
            const int ad = abase - 128 * d;
#pragma unroll
            for (int ic = 0; ic < 4; ++ic)
#pragma unroll
                for (int kc = 0; kc < 2; ++kc) {
                    const bf16x4 lo = *(const HY_LAS bf16x4*)(lds + ad + 2 * (48 - 16 * ic + 32 * kc));
                    const bf16x4 hi = *(const HY_LAS bf16x4*)(lds + ad + 2 * (48 - 16 * ic + 32 * kc) + 8);
                    A[ic][kc] = (bf16x8){lo[0], lo[1], lo[2], lo[3], hi[0], hi[1], hi[2], hi[3]};
                }
#pragma unroll
            for (int p = 0; p < NP; ++p) {
                const int sb0 = tb0 + 2 * p - d, sb1 = sb0 + 1;
                const bool v0 = (sb0 >= 0) && (sb0 < NBLK), v1 = (sb1 >= 0) && (sb1 < NBLK);
                if (!(v0 || v1)) continue;
                const int sbl = ql ? sb1 : sb0; const bool vl = ql ? v1 : v0;
                const int sbc = sbl < 0 ? 0 : (sbl >= NBLK ? NBLK - 1 : sbl);
                bf16x8 B[2];
#pragma unroll
                for (int kc = 0; kc < 2; ++kc) {
                    bf16x8 t = *(const HY_LAS bf16x8*)(lds + ((8 * sbc + 4 * kc + fq) * 8 + bb) * 16);
                    if (!vl) t = (bf16x8){0, 0, 0, 0, 0, 0, 0, 0};
                    B[kc] = t;
                }
#pragma unroll
                for (int ic = 0; ic < 4; ++ic)
#pragma unroll
                    for (int kc = 0; kc < 2; ++kc) acc[p][ic] = __builtin_amdgcn_mfma_f32_16x16x32_bf16(A[ic][kc], B[kc], acc[p][ic], 0, 0, 0);
            }
        }
#pragma unroll
        for (int p = 0; p < NP; ++p)
#pragma unroll
            for (int ic = 0; ic < 4; ++ic) {
                const int tb = tb0 + 2 * p + ql;
                const int gofs = ((8 * tb + 2 * ic + (fq >> 1)) * 8 + bb) * 16 + 8 * (fq & 1);
                const bf16x4 vv = *(const HY_LAS bf16x4*)(lds + gofs);
                const u32x2 xx = *(const u32x2*)((const unsigned char*)x0T + gofs);
                float o[4];
#pragma unroll
                for (int r = 0; r < 4; ++r) {
                    const float x0 = __uint_as_float(((r & 1) ? (xx[r >> 1] & 0xffff0000u) : (xx[r >> 1] << 16)));
                    o[r] = (acc[p][ic][r] + bf2f((unsigned short)vv[r]) * skip) * x0;
                }
                u32x2 w; w.x = pk2(o[0], o[1]); w.y = pk2(o[2], o[3]);
                *(u32x2*)((unsigned char*)yT + gofs) = w;
            }
    }
    __syncthreads();
}
#undef HY_LAS
}
constexpr int DM = 1024, NBATCH = 8, SEQL = 4096, NCTX = 256, DEPTH = 4;
constexpr int ML = NBATCH * SEQL, MC = NBATCH * NCTX, MT = ML + MC;
constexpr int ZP = 2304, DFF = 2816, DFE = 3584, NEXP = 8;
constexpr int MOE_TILES = 280, MOE_ROWS = MOE_TILES * 256;
constexpr float NORM_EPS = 1e-6f;
constexpr int NWAVES = 8;
constexpr size_t MiB = 1u << 20;
constexpr size_t WS_CTL = 0, CTL_ZERO_BYTES = 2 * MiB;
constexpr size_t WS_MODS = 1 * MiB;
constexpr size_t WS_ROPE = 2 * MiB;
constexpr size_t WS_ROUTE = 22 * MiB;
constexpr size_t WS_FILT = 4 * MiB;
constexpr size_t WS_FILTC = 21 * MiB;
constexpr size_t WS_WIN = 24 * MiB, WS_WOUT = 42 * MiB, WS_WGU = 50 * MiB, WS_WD = 72 * MiB, WS_MWGU = 83 * MiB, WS_MWD = 195 * MiB;
constexpr size_t WS_HC = 251 * MiB, WS_U = 259 * MiB;
constexpr size_t WS_R = 327 * MiB;
constexpr size_t WS_Z = WS_R, WS_MIX = WS_R + 153 * MiB, WS_VVT = WS_MIX + 68 * MiB, WS_X0T = WS_VVT + 17 * MiB, WS_YT = WS_X0T + 17 * MiB;
constexpr size_t WS_AS = WS_R, WS_HID = WS_R + 140 * MiB, WS_END = WS_HID + 490 * MiB;
static_assert(WS_YT + 17 * MiB <= WS_END && (size_t)MT * ZP * 2 <= 153 * MiB && (size_t)MOE_ROWS * DM * 2 <= 140 * MiB && (size_t)MOE_ROWS * DFE * 2 <= 490 * MiB, "ws map");
constexpr int CW_TMO = 0;
constexpr int CW_BAR = 4096;
constexpr int CW_QMIX = 8192;
constexpr int CW_CNT = 9216;
constexpr int RING_BYTES = 139264;
constexpr int LDSCTL_OFF = RING_BYTES, MISC_OFF = LDSCTL_OFF + 320;
constexpr int LDS_BYTES = RING_BYTES + 1024;
constexpr int NPL = 11, NPHASES = 1 + DEPTH * NPL + 1;
enum { PH_NORM1 = 0, PH_WIN, PH_HYPRE, PH_MIX, PH_HYPOST, PH_WOUT, PH_NORM2, PH_GATHER, PH_UP, PH_DOWN, PH_COMBINE };
#define GAS __attribute__((address_space(1)))
#define LAS __attribute__((address_space(3)))
typedef unsigned short bf16;
typedef unsigned v4u __attribute__((ext_vector_type(4)));
typedef float f32x4 __attribute__((ext_vector_type(4)));
typedef short bf16x8 __attribute__((ext_vector_type(8)));
typedef GAS unsigned gu32;
typedef GAS unsigned long long gu64;
#define RLX_AGENT __ATOMIC_RELAXED, __HIP_MEMORY_SCOPE_AGENT
#define LDS_WAIT() asm volatile("s_waitcnt lgkmcnt(0)" ::: "memory")
#define VM_WAIT() asm volatile("s_waitcnt vmcnt(0)" ::: "memory")
__device__ __forceinline__ unsigned long long rt() { return __builtin_amdgcn_s_memrealtime(); }
__device__ __forceinline__ unsigned f2bf(float f) { unsigned u = __builtin_bit_cast(unsigned, f); return (u + 0x7fffu + ((u >> 16) & 1u)) >> 16; }
__device__ __forceinline__ unsigned pk2(float lo, float hi) { return f2bf(lo) | (f2bf(hi) << 16); }

#define XB_TMO      128
#define XB_XCNT(j)  (256  + 64 * (j))
#define XB_XSUB(j)  (1280 + 64 * (j))
#define XB_XGEN(j)  (2304 + 64 * (j))
#define XB_TOP      3328
#define XB_TOPGEN   3392
#define XCD_BAR_WORDS 3456
#define XB_SPIN_CAP (1u << 18)

__device__ __forceinline__ unsigned xb_ld(unsigned* p)              { return __hip_atomic_load(p, __ATOMIC_RELAXED, __HIP_MEMORY_SCOPE_AGENT); }
__device__ __forceinline__ unsigned xb_add(unsigned* p, unsigned v) { return __hip_atomic_fetch_add(p, v, __ATOMIC_RELAXED, __HIP_MEMORY_SCOPE_AGENT); }
__device__ __forceinline__ unsigned xb_xcc_id() { return (unsigned)__builtin_amdgcn_s_getreg((3 << 11) | 20) & 0xFu; }
#define XB_SPIN(cond, bar) do { unsigned _sp = 0; while (cond) { __builtin_amdgcn_s_sleep(1); \
    if ((++_sp & 255u) == 0u) { if (xb_ld(&(bar)[XB_TMO])) break; if (_sp > XB_SPIN_CAP) { atomicAdd(&(bar)[XB_TMO], 1u); break; } } } } while (0)

struct XcdBarrier {
    unsigned* bar; unsigned x;
    volatile LAS unsigned* st;
};

__device__ __forceinline__ XcdBarrier xcd_barrier_post(unsigned* bar, volatile LAS unsigned* st) {
    XcdBarrier b; b.bar = bar; b.x = xb_xcc_id(); b.st = st;
    if (threadIdx.x == 0) (void)xb_add(&bar[XB_XCNT(b.x)], 1u);
    return b;
}
__device__ __forceinline__ void xcd_barrier_complete(unsigned* bar, unsigned x, unsigned& nloc, unsigned& nx) {
    const unsigned G = gridDim.x * gridDim.y * gridDim.z;
    unsigned sum, cnt, mine, sp = 0u;
    for (;;) {
        sum = 0u; cnt = 0u; mine = 0u;
#pragma unroll
        for (unsigned j = 0; j < 16; ++j) { const unsigned c = xb_ld(&bar[XB_XCNT(j)]); sum += c; cnt += (c > 0u) ? 1u : 0u; mine = (j == x) ? c : mine; }
        if (sum == G) break;
        __builtin_amdgcn_s_sleep(1);
        if ((++sp & 255u) == 0u) { if (xb_ld(&bar[XB_TMO])) break; if (sp > XB_SPIN_CAP) { atomicAdd(&bar[XB_TMO], 1u); break; } }
    }
    nloc = mine > 0u ? mine : 1u; nx = cnt > 0u ? cnt : 1u;
}

__device__ __forceinline__ void xcd_barrier(const XcdBarrier& b) {
    asm volatile("s_waitcnt vmcnt(0)" ::: "memory");
    __syncthreads();
    if (threadIdx.x == 0) {
        unsigned* bar = b.bar;
        __builtin_amdgcn_s_waitcnt(0);
        unsigned nloc = b.st[0], nx = b.st[1];
        if (nloc == 0u) { xcd_barrier_complete(bar, b.x, nloc, nx); b.st[0] = nloc; b.st[1] = nx; }
        const unsigned old = xb_add(&bar[XB_XSUB(b.x)], 1u);
        const unsigned gen = old / nloc;
        if (old + 1u == (gen + 1u) * nloc) {
            __builtin_amdgcn_fence(__ATOMIC_RELEASE, "agent");
            asm volatile("s_waitcnt vmcnt(0)" ::: "memory");
            const unsigned og = xb_add(&bar[XB_TOP], 1u);
            const unsigned tg = og / nx;
            if (og + 1u == (tg + 1u) * nx) xb_add(&bar[XB_TOPGEN], 1u);
            else XB_SPIN(xb_ld(&bar[XB_TOPGEN]) == tg, bar);
            __builtin_amdgcn_fence(__ATOMIC_ACQUIRE, "agent");
            xb_add(&bar[XB_XGEN(b.x)], 1u);
            asm volatile("s_waitcnt vmcnt(0)" ::: "memory");
        } else {
            XB_SPIN(xb_ld(&bar[XB_XGEN(b.x)]) == gen, bar);
            __builtin_amdgcn_fence(__ATOMIC_ACQUIRE, "agent");
            asm volatile("s_waitcnt vmcnt(0)" ::: "memory");
        }
    }
    __syncthreads();
}
typedef float f32x2 __attribute__((ext_vector_type(2)));
typedef unsigned v2u __attribute__((ext_vector_type(2)));
__device__ __forceinline__ float bf2f(unsigned short h) { return __uint_as_float((unsigned)h << 16); }
__device__ __forceinline__ float bflo(unsigned w) { return __uint_as_float(w << 16); }
__device__ __forceinline__ float bfhi(unsigned w) { return __uint_as_float(w & 0xffff0000u); }
__device__ __forceinline__ float wave_sum(float v) {
#pragma unroll
    for (int o = 1; o < 64; o <<= 1) v += __shfl_xor(v, o);
    return v;
}
__device__ __forceinline__ float cos_rev(float r) { r = r - floorf(r); return __builtin_amdgcn_cosf(r); }
__device__ __forceinline__ float sin_rev(float r) { r = r - floorf(r); return __builtin_amdgcn_sinf(r); }
__device__ __forceinline__ float sin_rad(float x) { return sin_rev(x * 0.15915494309189535f); }
__device__ __forceinline__ const void* karg_ptr(int i) {
    const unsigned long long __attribute__((address_space(4)))* kp = (const unsigned long long __attribute__((address_space(4)))*)__builtin_amdgcn_kernarg_segment_ptr();
    asm volatile("" : "+s"(kp));
    return (const void*)(const __attribute__((address_space(1))) void*)kp[i];
}
#define KARG(i) ((const float*)karg_ptr(i))
#define KOUT() ((float*)karg_ptr(34))
#define KWS() ((unsigned char*)karg_ptr(35))
#define FRESH_TID() int tid_ = threadIdx.x; asm volatile("" : "+v"(tid_)); const int tid = tid_, lane = tid & 63; (void)lane
struct Frame {
    LAS unsigned char* lds; volatile LAS unsigned* MISC; gu32* ctl;
    int wave, vcu, G;
};

struct RmId { __device__ __forceinline__ int operator()(int n) const { return n; } };
struct RmGate { int off; __device__ __forceinline__ int operator()(int n) const { return ((n >> 7) << 8) + (n & 127) + off; } };
struct RmWin { __device__ __forceinline__ int operator()(int n) const {
    const int pn = n >> 8, c = n & 255; int p;
    if (pn == 3 || pn == 4) p = 128 * ((c >> 4) & 1) + 32 * (c >> 6) + 16 * ((c >> 5) & 1) + (c & 15);
    else if (pn >= 6) p = 128 * ((c >> 5) & 1) + 32 * (c >> 6) + (c & 31);
    else p = c;
    return (pn << 8) + p; } };
template <class RM>
__device__ __forceinline__ void transpose_item(const float* __restrict__ W, int K, int N, bf16* WT, LAS float* scr, int item, int lane, RM rm) {
    const int nblk = N / 32, kb = item / nblk, nb = item % nblk, k0 = 64 * kb, n0 = 32 * nb;
#pragma unroll 8
    for (int i = 0; i < 32; ++i) { const int kk = 2 * i + (lane >> 5); scr[kk * 33 + (lane & 31)] = W[(size_t)(k0 + kk) * N + n0 + (lane & 31)]; }
    LDS_WAIT(); asm volatile("" ::: "memory");
    const int c = lane & 7;
#pragma unroll
    for (int j = 0; j < 4; ++j) { const int n = (lane >> 3) + 8 * j; const LAS float* s = scr + (8 * c) * 33 + n;
        v4u o; o.x = pk2(s[0 * 33], s[1 * 33]); o.y = pk2(s[2 * 33], s[3 * 33]); o.z = pk2(s[4 * 33], s[5 * 33]); o.w = pk2(s[6 * 33], s[7 * 33]);
        *(GAS v4u*)(WT + (size_t)rm(n0 + n) * K + k0 + 8 * c) = o; }
    LDS_WAIT(); asm volatile("" ::: "memory");
}

struct Ptrs {
    const float* in[34]; float* out; unsigned char* ws;
};
enum { I_X = 0, I_C, I_CTX, I_CCTX, I_WADA, I_BADA, I_GMIX, I_GFFN, I_WIN, I_WOUT, I_HCW, I_HCB, I_HW1, I_HB1, I_HW2, I_HB2, I_HW3, I_HFREQ, I_HSKIP,
       I_LQ1, I_LK1, I_LQ2, I_LK2, I_SUBLN, I_QNORM, I_KNORM, I_FWG, I_FWU, I_FWD, I_ROUTER, I_MWG, I_MWU, I_MWD, I_GFINAL };

__device__ __forceinline__ void p0_prologue(Frame& F) {
    FRESH_TID();
    unsigned char* ws = KWS();
    const int gw = F.vcu * NWAVES + F.wave, NGW = F.G * NWAVES;
    LAS float* scr = (LAS float*)(F.lds + F.wave * 8704);
    {
        constexpr int I_IN = 16 * 72, I_OUT = 16 * 32, I_G = 16 * 88, I_D = 44 * 32;
        constexpr int NIT = 4 * I_IN + 4 * I_OUT + 4 * I_G + 2 * I_D;
        for (int it = gw; it < NIT; it += NGW) {
            int r = it;
            if (r < 4 * I_IN) { const int l = r / I_IN; transpose_item(KARG(I_WIN) + (size_t)l * DM * ZP, DM, ZP, (bf16*)(ws + WS_WIN) + (size_t)l * ZP * DM, scr, r % I_IN, lane, RmWin{}); continue; } r -= 4 * I_IN;
            if (r < 4 * I_OUT) { const int l = r / I_OUT; transpose_item(KARG(I_WOUT) + (size_t)l * DM * DM, DM, DM, (bf16*)(ws + WS_WOUT) + (size_t)l * DM * DM, scr, r % I_OUT, lane, RmId{}); continue; } r -= 4 * I_OUT;
            if (r < 4 * I_G) { const int q = r / I_G, j = q >> 1, up = q & 1; transpose_item(KARG(up ? I_FWU : I_FWG) + (size_t)j * DM * DFF, DM, DFF, (bf16*)(ws + WS_WGU) + (size_t)j * 2 * DFF * DM, scr, r % I_G, lane, RmGate{up * 128}); continue; } r -= 4 * I_G;
            { const int j = r / I_D; transpose_item(KARG(I_FWD) + (size_t)j * DFF * DM, DFF, DM, (bf16*)(ws + WS_WD) + (size_t)j * DM * DFF, scr, r % I_D, lane, RmId{}); }
        }
    }
    __syncthreads();
    {
        LAS float* sct = (LAS float*)(F.lds + 69632);
        for (int i = tid; i < 9 * 1024; i += NWAVES * 64) { const int mi = i >> 10, k = i & 1023; const float c = mi < 8 ? KARG(I_C)[mi * 1024 + k] : KARG(I_CCTX)[k];
            sct[k * 12 + mi] = c / (1.0f + __expf(-c)); }
        __syncthreads();
        float* mods = (float*)(ws + WS_MODS);
        LAS float* part = (LAS float*)F.lds;
        for (int it = F.vcu; it < 4 * 96; it += F.G) {
            const int l = it / 96, jb = it % 96, ks = F.wave, j = jb * 64 + lane;
            const float* wp = KARG(I_WADA) + ((size_t)l * 1024 + ks * 128) * 6144 + j;
            float acc[9];
#pragma unroll
            for (int mi = 0; mi < 9; ++mi) acc[mi] = 0.f;
#pragma unroll 8
            for (int k = 0; k < 128; ++k) { const float w = wp[(size_t)k * 6144]; const LAS float* sp = sct + (ks * 128 + k) * 12;
                const f32x4 s0 = *(const LAS f32x4*)sp, s1 = *(const LAS f32x4*)(sp + 4); const float s8 = sp[8];
                acc[0] += s0[0] * w; acc[1] += s0[1] * w; acc[2] += s0[2] * w; acc[3] += s0[3] * w; acc[4] += s1[0] * w; acc[5] += s1[1] * w; acc[6] += s1[2] * w; acc[7] += s1[3] * w; acc[8] += s8 * w; }
#pragma unroll
            for (int mi = 0; mi < 9; ++mi) part[(ks * 9 + mi) * 64 + lane] = acc[mi];
            __syncthreads();
            for (int o = tid; o < 9 * 64; o += NWAVES * 64) { const int mi = o >> 6, jl = o & 63; float sum = KARG(I_BADA)[l * 6144 + jb * 64 + jl];
#pragma unroll
                for (int w8 = 0; w8 < 8; ++w8) sum += part[(w8 * 9 + mi) * 64 + jl];
                mods[((size_t)l * 9 + mi) * 6144 + jb * 64 + jl] = sum; }
            __syncthreads();
        }
    }
    __syncthreads();
    {
        LAS unsigned short* tile = (LAS unsigned short*)F.lds;
        for (int it = F.vcu; it < 4 * 68; it += F.G) {
            const int l = it / 68, r = it % 68; const bool ctx = r >= 64; const int L = ctx ? 256 : 4096, t0 = 64 * (ctx ? r - 64 : r);
            const float* w1 = KARG(I_HW1) + l * 33 * 64; const float* b1 = KARG(I_HB1) + l * 64; const float* w2 = KARG(I_HW2) + l * 4096; const float* b2 = KARG(I_HB2) + l * 64;
            const float* w3 = KARG(I_HW3) + l * 64 * 512; const float fr_ = KARG(I_HFREQ)[l * 64 + lane];
            float a2r[8];
#pragma unroll
            for (int i = 0; i < 8; ++i) {
                const int t = t0 + F.wave * 8 + i; const float tn = (float)t / (float)(L - 1);
                float feat = 0.f;
                if (lane == 0) feat = tn;
                else if (lane < 33) { const int kb = (lane - 1) & 15; const float band = 1e-4f + (float)kb * ((15.0f - 1e-4f) / 15.0f); const float rev = ((float)t * band) / (float)L;
                    feat = (lane <= 16) ? cos_rev(rev) : -sin_rev(rev); }
                float z1 = b1[lane];
#pragma unroll
                for (int k = 0; k < 33; ++k) z1 += __shfl(feat, k) * w1[k * 64 + lane];
                const float a1 = sin_rad(fr_ * z1);
                float z2 = b2[lane];
#pragma unroll 16
                for (int k = 0; k < 64; ++k) z2 += __shfl(a1, k) * w2[k * 64 + lane];
                a2r[i] = sin_rad(fr_ * z2);
            }
            float o[8][8];
#pragma unroll
            for (int i = 0; i < 8; ++i)
#pragma unroll
                for (int q = 0; q < 8; ++q) o[i][q] = 0.f;
#pragma unroll 2
            for (int k = 0; k < 64; ++k) {
                float wv[8];
#pragma unroll
                for (int q = 0; q < 8; ++q) wv[q] = w3[k * 512 + q * 64 + lane];
#pragma unroll
                for (int i = 0; i < 8; ++i) { const float a = __shfl(a2r[i], k);
#pragma unroll
                    for (int q = 0; q < 8; ++q) o[i][q] += a * wv[q]; }
            }
            const float dmin = -3.0701134573253945f, dmax = -15.350567286626972f;
#pragma unroll
            for (int q = 0; q < 8; ++q) { const int col = q * 64 + lane, ch = col & 255; const float delta = fabsf(dmin + (float)ch * ((dmax - dmin) / 255.0f));
#pragma unroll
                for (int i = 0; i < 8; ++i) { const int tl = F.wave * 8 + i; const float tn = (float)(t0 + tl) / (float)(L - 1);
                    const float v = o[i][q] * __expf(-tn * delta); tile[col * 66 + tl] = (unsigned short)(pk2(v, 0.f) & 0xffffu); } }
            __syncthreads();
            unsigned short* R = ctx ? (unsigned short*)(ws + WS_FILTC) + ((size_t)l * 256) * 512 : (unsigned short*)(ws + WS_FILT) + ((size_t)l * 256) * 8192;
            const int RL = 2 * L, ch = tid >> 1, half = tid & 1;
            unsigned short* Rc = R + (size_t)ch * RL;
            for (int k = 32 * half; k < 32 * half + 32; ++k) {
                Rc[L - t0 - 63 + k] = tile[ch * 66 + 63 - k];
                if (t0 + k > 0) Rc[L + t0 + k] = tile[(256 + ch) * 66 + k];
            }
            if (t0 == 0 && half == 0) Rc[0] = 0;
            __syncthreads();
        }
    }
    if (F.vcu == 0) {
        float* rope = (float*)(ws + WS_ROPE);
        for (int i = tid; i < 512 + 1024; i += NWAVES * 64) {
            const bool g = i >= 512; const int j = g ? i - 512 : i; const int n = g ? 16 : 8, pos = j / n, f = j % n;
            const float inv = exp2f(-13.287712379549449f * (float)f / (float)n);
            const float rev = (float)pos * inv * 0.15915494309189535f;
            if (g) { rope[1024 + j] = cos_rev(rev); rope[2048 + j] = sin_rev(rev); } else { rope[j] = cos_rev(rev); rope[512 + j] = sin_rev(rev); }
        }
        if (tid < 4) { const int l = tid; float s1 = 0.f, s2 = 0.f;
            for (int k = 0; k < 32; ++k) { s1 += KARG(I_LQ1)[l * 32 + k] * KARG(I_LK1)[l * 32 + k]; s2 += KARG(I_LQ2)[l * 32 + k] * KARG(I_LK2)[l * 32 + k]; }
            const float li = 0.8f - 0.6f * __expf(-0.3f * (float)l);
            float* sc = (float*)(ws + WS_ROPE + 16384) + l * 4; sc[0] = __expf(s1) - __expf(s2) + li; sc[1] = 1.0f - li; }
    }
}

template <bool ROUTE>
__device__ __forceinline__ void norm_phase(Frame& F, const float* Hl, const float* Hc, const float* g, const float* mods_l, int sh_chunk, bf16* U, const float* router, unsigned* route, gu32* cnt) {
    FRESH_TID();
    const int gw = F.vcu * NWAVES + F.wave, NGW = F.G * NWAVES;
    for (int m = gw; m < MT; m += NGW) {
        const bool lat = m < ML; const float* src = lat ? Hl + (size_t)m * DM : Hc + (size_t)(m - ML) * DM; const int mi = lat ? (m >> 12) : 8;
        const float* shp = mods_l + mi * 6144 + sh_chunk * 1024; const float* scp = shp + 1024;
        f32x4 v[4]; float s = 0.f;
#pragma unroll
        for (int j = 0; j < 4; ++j) { v[j] = *(const f32x4*)(src + 256 * j + 4 * lane); s += (v[j][0] * v[j][0] + v[j][1] * v[j][1]) + (v[j][2] * v[j][2] + v[j][3] * v[j][3]); }
        const float rstd = __builtin_amdgcn_rsqf(wave_sum(s) * (1.0f / DM) + NORM_EPS);
        float lg[8];
        if (ROUTE) {
#pragma unroll
            for (int e = 0; e < 8; ++e) lg[e] = 0.f; }
#pragma unroll
        for (int j = 0; j < 4; ++j) { const int c0 = 256 * j + 4 * lane; const f32x4 gg = *(const f32x4*)(g + c0), sc = *(const f32x4*)(scp + c0), sh = *(const f32x4*)(shp + c0);
            v[j] = (v[j] * rstd) * gg * (sc + 1.0f) + sh;
            v2u o; o.x = pk2(v[j][0], v[j][1]); o.y = pk2(v[j][2], v[j][3]);
            *(v2u*)(U + (size_t)m * DM + c0) = o;
            if (ROUTE) {
#pragma unroll
                for (int i = 0; i < 4; ++i) { const f32x4 r0 = *(const f32x4*)(router + (size_t)(c0 + i) * 8), r1 = *(const f32x4*)(router + (size_t)(c0 + i) * 8 + 4);
                    lg[0] += v[j][i] * r0[0]; lg[1] += v[j][i] * r0[1]; lg[2] += v[j][i] * r0[2]; lg[3] += v[j][i] * r0[3]; lg[4] += v[j][i] * r1[0]; lg[5] += v[j][i] * r1[1]; lg[6] += v[j][i] * r1[2]; lg[7] += v[j][i] * r1[3]; } }
        }
        if (ROUTE) {
#pragma unroll
            for (int e = 0; e < 8; ++e) lg[e] = wave_sum(lg[e]);
            if (lane == 0) {
                int i1 = 0; float v1 = lg[0];
#pragma unroll
                for (int e = 1; e < 8; ++e) if (lg[e] > v1) { v1 = lg[e]; i1 = e; }
                int i2 = -1; float v2 = 0.f;
#pragma unroll
                for (int e = 0; e < 8; ++e) if (e != i1 && (i2 < 0 || lg[e] > v2)) { v2 = lg[e]; i2 = e; }
                const float w1 = 1.0f / (1.0f + __expf(v2 - v1)), w2 = 1.0f - w1;
                const unsigned s1 = __hip_atomic_fetch_add(cnt + 64 * i1, 1u, RLX_AGENT), s2 = __hip_atomic_fetch_add(cnt + 64 * i2, 1u, RLX_AGENT);
                v4u a; a.x = (unsigned)i1; a.y = (unsigned)i2; a.z = s1; a.w = s2; v4u b; b.x = __float_as_uint(w1); b.y = __float_as_uint(w2); b.z = 0u; b.w = 0u;
                *(v4u*)(route + (size_t)m * 8) = a; *(v4u*)(route + (size_t)m * 8 + 4) = b;
            }
        }
    }
}
__device__ __forceinline__ void moe_convert(Frame& F, int li) {
    FRESH_TID();
    const int gw = F.vcu * NWAVES + F.wave, NGW = F.G * NWAVES;
    LAS float* scr = (LAS float*)(F.lds + F.wave * 8704);
    constexpr int I_G = 16 * 112, I_D = 56 * 32, NIT = 16 * I_G + 8 * I_D;
    for (int it = gw; it < NIT; it += NGW) {
        int r = it;
        if (r < 16 * I_G) { const int q = r / I_G, e = q >> 1, up = q & 1;
            transpose_item(KARG(up ? I_MWU : I_MWG) + ((size_t)li * 8 + e) * DM * DFE, DM, DFE, (bf16*)(KWS() + WS_MWGU) + (size_t)e * 2 * DFE * DM, scr, r % I_G, lane, RmGate{up * 128}); continue; }
        r -= 16 * I_G;
        { const int e = r / I_D; transpose_item(KARG(I_MWD) + ((size_t)li * 8 + e) * DFE * DM, DFE, DM, (bf16*)(KWS() + WS_MWD) + (size_t)e * DM * DFE, scr, r % I_D, lane, RmId{}); }
    }
}
__device__ __forceinline__ void moe_tile_base(const gu32* cnt, int (&tb)[9]) {
    tb[0] = 0;
#pragma unroll
    for (int e = 0; e < 8; ++e) { const unsigned c = __hip_atomic_load(cnt + 64 * e, RLX_AGENT); tb[e + 1] = tb[e] + (int)((c + 255u) >> 8); }
}
__device__ __forceinline__ void gather_phase(Frame& F, const bf16* U, const unsigned* route, const int (&tb)[9], bf16* AS) {
    FRESH_TID();
    const int gw = F.vcu * NWAVES + F.wave, NGW = F.G * NWAVES;
    for (int m = gw; m < MT; m += NGW) {
        const v4u a = *(const v4u*)(route + (size_t)m * 8);
        int b1 = 0, b2 = 0;
#pragma unroll
        for (int e = 0; e < 8; ++e) { b1 = ((int)a.x == e) ? tb[e] : b1; b2 = ((int)a.y == e) ? tb[e] : b2; }
        const size_t r1 = (size_t)b1 * 256 + a.z, r2 = (size_t)b2 * 256 + a.w;
        const v4u x0 = *(const v4u*)(U + (size_t)m * DM + 8 * lane), x1 = *(const v4u*)(U + (size_t)m * DM + 512 + 8 * lane);
        *(v4u*)(AS + r1 * DM + 8 * lane) = x0; *(v4u*)(AS + r1 * DM + 512 + 8 * lane) = x1;
        *(v4u*)(AS + r2 * DM + 8 * lane) = x0; *(v4u*)(AS + r2 * DM + 512 + 8 * lane) = x1;
    }
}
__device__ __forceinline__ void combine_phase(Frame& F, float* Hl, float* Hc, const unsigned* route, const int (&tb)[9], const bf16* Y, const float* gate) {
    FRESH_TID();
    const int gw = F.vcu * NWAVES + F.wave, NGW = F.G * NWAVES;
    for (int m = gw; m < MT; m += NGW) {
        const bool lat = m < ML; float* hp = lat ? Hl + (size_t)m * DM : Hc + (size_t)(m - ML) * DM; const int mi = lat ? (m >> 12) : 8;
        const v4u a = *(const v4u*)(route + (size_t)m * 8); const v4u b = *(const v4u*)(route + (size_t)m * 8 + 4);
        int b1 = 0, b2 = 0;
#pragma unroll
        for (int e = 0; e < 8; ++e) { b1 = ((int)a.x == e) ? tb[e] : b1; b2 = ((int)a.y == e) ? tb[e] : b2; }
        const bf16* y1 = Y + ((size_t)b1 * 256 + a.z) * DM; const bf16* y2 = Y + ((size_t)b2 * 256 + a.w) * DM;
        const float w1 = __uint_as_float(b.x), w2 = __uint_as_float(b.y);
#pragma unroll
        for (int j = 0; j < 4; ++j) { const int c0 = 256 * j + 4 * lane;
            const v2u p1 = *(const v2u*)(y1 + c0), p2 = *(const v2u*)(y2 + c0); const f32x4 gg = *(const f32x4*)(gate + mi * 6144 + c0); f32x4 h = *(const f32x4*)(hp + c0);
            h[0] += gg[0] * (w1 * bflo(p1.x) + w2 * bflo(p2.x)); h[1] += gg[1] * (w1 * bfhi(p1.x) + w2 * bfhi(p2.x));
            h[2] += gg[2] * (w1 * bflo(p1.y) + w2 * bflo(p2.y)); h[3] += gg[3] * (w1 * bfhi(p1.y) + w2 * bfhi(p2.y));
            *(f32x4*)(hp + c0) = h; }
    }
}
__device__ __forceinline__ void final_phase(Frame& F, float* H, const float* g) {
    FRESH_TID();
    const int gw = F.vcu * NWAVES + F.wave, NGW = F.G * NWAVES;
    for (int m = gw; m < ML; m += NGW) { float* hp = H + (size_t)m * DM;
        f32x4 v[4]; float s = 0.f;
#pragma unroll
        for (int j = 0; j < 4; ++j) { v[j] = *(const f32x4*)(hp + 256 * j + 4 * lane); s += (v[j][0] * v[j][0] + v[j][1] * v[j][1]) + (v[j][2] * v[j][2] + v[j][3] * v[j][3]); }
        const float rstd = __builtin_amdgcn_rsqf(wave_sum(s) * (1.0f / DM) + NORM_EPS);
#pragma unroll
        for (int j = 0; j < 4; ++j) { const f32x4 gg = *(const f32x4*)(g + 256 * j + 4 * lane); *(f32x4*)(hp + 256 * j + 4 * lane) = (v[j] * rstd) * gg; }
    }
}

__device__ __forceinline__ void hypre_phase(Frame& F, const bf16* Z, const float* cw, const float* cb, bf16* VVT, bf16* X0T) {
    FRESH_TID();
    LAS v4u* tl = (LAS v4u*)F.lds;
    const int b = tid >> 6, cl = tid & 63;
    for (int it = F.vcu; it < 2048 + 128; it += F.G) {
        const bool ctx = it >= 2048; const int r = ctx ? it - 2048 : it, tch = r >> 2, cg = r & 3, L = ctx ? NCTX : SEQL, t0 = 8 * tch, c = cg * 64 + cl;
        const size_t rowb = ctx ? (size_t)ML + (size_t)b * NCTX : (size_t)b * SEQL;
        float zz[3][10];
#pragma unroll
        for (int i = 0; i < 10; ++i) { const int t = t0 - 1 + i; const bool ok = (t >= 0) && (t < L); const bf16* zp = Z + (rowb + (ok ? t : 0)) * ZP + c;
#pragma unroll
            for (int s = 0; s < 3; ++s) zz[s][i] = ok ? bf2f(zp[s * 256]) : 0.f; }
        float w[3][3], bs[3];
#pragma unroll
        for (int s = 0; s < 3; ++s) { bs[s] = cb[s * 256 + c];
#pragma unroll
            for (int j = 0; j < 3; ++j) w[s][j] = cw[j * 768 + s * 256 + c]; }
        float vv[8], x0[8];
#pragma unroll
        for (int i = 0; i < 8; ++i) { float y[3];
#pragma unroll
            for (int s = 0; s < 3; ++s) y[s] = bs[s] + zz[s][i] * w[s][0] + zz[s][i + 1] * w[s][1] + zz[s][i + 2] * w[s][2];
            x0[i] = y[0]; vv[i] = y[2] * y[1]; }
        v4u gv, gx; gv.x = pk2(vv[0], vv[1]); gv.y = pk2(vv[2], vv[3]); gv.z = pk2(vv[4], vv[5]); gv.w = pk2(vv[6], vv[7]);
        gx.x = pk2(x0[0], x0[1]); gx.y = pk2(x0[2], x0[3]); gx.z = pk2(x0[4], x0[5]); gx.w = pk2(x0[6], x0[7]);
        tl[cl * 8 + b] = gv; tl[512 + cl * 8 + b] = gx;
        __syncthreads();
        { const int c2 = cg * 64 + (tid >> 3), b2 = tid & 7; const size_t nch = ctx ? 32 : 512; const size_t base = ctx ? (size_t)256 * 512 * 64 : 0;
            const size_t off = base + ((size_t)c2 * nch + tch) * 64 + b2 * 8;
            *(v4u*)(VVT + off) = tl[tid]; *(v4u*)(X0T + off) = tl[512 + tid]; }
        __syncthreads();
    }
}
__device__ __forceinline__ void hypost_phase(Frame& F, const bf16* YT, bf16* MIX) {
    FRESH_TID();
    LAS unsigned short* tl = (LAS unsigned short*)F.lds;
    for (int it = F.vcu; it < 2048 + 128; it += F.G) {
        const bool ctx = it >= 2048; const int r = ctx ? it - 2048 : it, tch = r >> 2, cg = r & 3, t0 = 8 * tch;
        { const int cl = tid >> 3, b2 = tid & 7; const size_t nch = ctx ? 32 : 512; const size_t base = ctx ? (size_t)256 * 512 * 64 : 0;
            const v4u gq = *(const v4u*)(YT + base + ((size_t)(cg * 64 + cl) * nch + tch) * 64 + b2 * 8);
            const unsigned wv[4] = {gq.x, gq.y, gq.z, gq.w};
#pragma unroll
            for (int i = 0; i < 8; ++i) tl[(b2 * 8 + i) * 72 + cl] = (unsigned short)((i & 1) ? (wv[i >> 1] >> 16) : (wv[i >> 1] & 0xffffu)); }
        __syncthreads();
        { const int rr = tid >> 3, ch = tid & 7, b = rr >> 3, t = rr & 7;
            const size_t row = ctx ? (size_t)ML + (size_t)b * NCTX + t0 + t : (size_t)b * SEQL + t0 + t;
            const LAS unsigned short* sp = tl + rr * 72 + ch * 8;
            v4u o; o.x = sp[0] | ((unsigned)sp[1] << 16); o.y = sp[2] | ((unsigned)sp[3] << 16); o.z = sp[4] | ((unsigned)sp[5] << 16); o.w = sp[6] | ((unsigned)sp[7] << 16);
            *(v4u*)(MIX + row * DM + cg * 64 + ch * 8) = o; }
        __syncthreads();
    }
}
constexpr int U_DIFF = 512, U_GQA = 1024, U_HY = 256, U_CDIFF = 32, U_CGQA = 64, U_CHY = 256;
constexpr int NUNITS = U_DIFF + U_GQA + U_HY + U_CDIFF + U_CGQA + U_CHY;
__device__ __forceinline__ void mix_phase(Frame& F, int l, unsigned char* lds_generic) {
    FRESH_TID();
    unsigned char* ws = KWS();
    const attn_body::bf16* Z = (const attn_body::bf16*)(ws + WS_Z); attn_body::bf16* MIX = (attn_body::bf16*)(ws + WS_MIX);
    const float* scal = (const float*)(ws + WS_ROPE + 16384) + l * 4;
    const float lam = scal[0], sub_scale = scal[1];
    const float* subln = KARG(I_SUBLN) + l * 64;
    gu32* qh = F.ctl + CW_QMIX + 64 * l;
    for (;;) {
        if (tid == 0) F.MISC[0] = __hip_atomic_fetch_add(qh, 1u, RLX_AGENT);
        __syncthreads();
        const int t = (int)F.MISC[0];
        __syncthreads();
        if (t >= NUNITS) break;
        int j = t;
        if (j < U_DIFF + U_GQA) {
            const bool diff = j < U_DIFF; if (!diff) j -= U_DIFF;
            const int qb = j & 15, hh = diff ? (j >> 4) & 3 : (j >> 4) & 7, b = diff ? j >> 6 : j >> 7;
            const size_t qrow = (size_t)b * SEQL + qb * 256;
            if (diff) attn_body::attn_unit<1, 8>(Z + qrow * ZP + 768 + hh * 64, Z + 1024 + hh * 64, Z + 1280 + hh * 64, b * SEQL, ML + b * NCTX, 64, 68, MIX + qrow * DM + 256 + hh * 64, (char*)lds_generic, lam, subln, sub_scale);
            else attn_body::attn_unit<0, 8>(Z + qrow * ZP + 1536 + hh * 64, Z + 2048 + (hh >> 2) * 64, Z + 2176 + (hh >> 2) * 64, b * SEQL, ML + b * NCTX, 64, 68, MIX + qrow * DM + 512 + hh * 64, (char*)lds_generic, 0.f, subln, 0.f);
            continue;
        }
        j -= U_DIFF + U_GQA;
        if (j < U_HY) {
            const int c = j;
            hy::conv_unit<4, 64>(F.lds, (const unsigned short*)(ws + WS_FILT) + ((size_t)l * 256 + c) * 8192, (const unsigned short*)(ws + WS_VVT) + (size_t)c * 512 * 64,
                                 (const unsigned short*)(ws + WS_X0T) + (size_t)c * 512 * 64, (unsigned short*)(ws + WS_YT) + (size_t)c * 512 * 64, KARG(I_HSKIP)[l * 256 + c]);
            continue;
        }
        j -= U_HY;
        if (j < U_CDIFF + U_CGQA) {
            const bool diff = j < U_CDIFF; if (!diff) j -= U_CDIFF;
            const int hh = diff ? j & 3 : j & 7, b = diff ? j >> 2 : j >> 3;
            const size_t qrow = (size_t)ML + (size_t)b * NCTX;
            if (diff) attn_body::attn_unit<1, 8>(Z + qrow * ZP + 768 + hh * 64, Z + 1024 + hh * 64, Z + 1280 + hh * 64, 0, ML + b * NCTX, 0, 4, MIX + qrow * DM + 256 + hh * 64, (char*)lds_generic, lam, subln, sub_scale);
            else attn_body::attn_unit<0, 8>(Z + qrow * ZP + 1536 + hh * 64, Z + 2048 + (hh >> 2) * 64, Z + 2176 + (hh >> 2) * 64, 0, ML + b * NCTX, 0, 4, MIX + qrow * DM + 512 + hh * 64, (char*)lds_generic, 0.f, subln, 0.f);
            continue;
        }
        j -= U_CDIFF + U_CGQA;
        { const int c = j; const size_t base = (size_t)256 * 512 * 64;
            hy::conv_unit<1, 4>(F.lds, (const unsigned short*)(ws + WS_FILTC) + ((size_t)l * 256 + c) * 512, (const unsigned short*)(ws + WS_VVT) + base + (size_t)c * 32 * 64,
                                (const unsigned short*)(ws + WS_X0T) + base + (size_t)c * 32 * 64, (unsigned short*)(ws + WS_YT) + base + (size_t)c * 32 * 64, KARG(I_HSKIP)[l * 256 + c]); }
    }
}

struct Args { Ptrs p; int ph_lo, ph_hi, use_bar, pad; };
__global__ void __launch_bounds__(NWAVES * 64, 2) trunk_fwd(Args args) {
    extern __shared__ __attribute__((aligned(16))) unsigned char lds[];
    Frame F;
    F.lds = (LAS unsigned char*)lds; F.MISC = (volatile LAS unsigned*)(F.lds + MISC_OFF);
    F.wave = __builtin_amdgcn_readfirstlane(threadIdx.x >> 6);
    F.G = gridDim.x; { const int bx = blockIdx.x; F.vcu = (F.G % 8 == 0) ? (bx % 8) * (F.G / 8) + bx / 8 : bx; }
    unsigned char* ws = KWS();
    F.ctl = (gu32*)(ws + WS_CTL);
    for (int u = threadIdx.x; u < (LDS_BYTES - LDSCTL_OFF) / 4; u += NWAVES * 64) ((LAS unsigned*)(F.lds + LDSCTL_OFF))[u] = 0u;
    __syncthreads();
    XcdBarrier bar; bar.bar = (unsigned*)(F.ctl + CW_BAR); bar.x = 0; bar.st = nullptr;
    if (args.use_bar) bar = xcd_barrier_post((unsigned*)(F.ctl + CW_BAR), F.MISC + 8);
    const int lo = args.ph_lo, hi = args.ph_hi;
#define IN(k) (lo <= (k) && (k) < hi)
#define SEAM(k) do { if ((k) + 1 < hi) xcd_barrier(bar); } while (0)

    float* Hl = KOUT(); float* Hc = (float*)(ws + WS_HC);
    bf16* U = (bf16*)(ws + WS_U);
    const float* mods = (const float*)(ws + WS_MODS);
    unsigned* route = (unsigned*)(ws + WS_ROUTE);

    if (IN(0)) { p0_prologue(F); SEAM(0); }

    for (int l = 0; l < DEPTH; ++l) {
        const int pb = 1 + l * NPL; const bool moe = (l & 1) != 0; const int li = l >> 1;
        const float* mods_l = mods + (size_t)l * 9 * 6144;
        gu32* cnt = F.ctl + CW_CNT + 64 * 8 * li;
        if (IN(pb + PH_NORM1)) {
            norm_phase<false>(F, l == 0 ? KARG(I_X) : Hl, l == 0 ? KARG(I_CTX) : Hc, KARG(I_GMIX) + l * DM, mods_l, 0, U, nullptr, nullptr, nullptr);
            SEAM(pb + PH_NORM1);
        }
        if (IN(pb + PH_WIN)) {
            pg8::Gemm g{U, (const bf16*)(ws + WS_WIN) + (size_t)l * ZP * DM, MT, ZP, DM}; pg8::Sched2 S; S.init(MT / 256, ZP / 256, F.G, (int)blockIdx.x);
            pg8::EpiWin E{(bf16*)(ws + WS_Z), (const float*)(ws + WS_ROPE), KARG(I_QNORM) + l * 64, KARG(I_KNORM) + l * 64};
            pg8::gemm_phase<pg8::EpiWin, pg8::Sched2, true, true>(F.lds, g, S, E);
            SEAM(pb + PH_WIN);
        }
        if (IN(pb + PH_HYPRE)) {
            hypre_phase(F, (const bf16*)(ws + WS_Z), KARG(I_HCW) + l * 3 * 768, KARG(I_HCB) + l * 768, (bf16*)(ws + WS_VVT), (bf16*)(ws + WS_X0T));
            SEAM(pb + PH_HYPRE);
        }
        if (IN(pb + PH_MIX)) { mix_phase(F, l, lds); SEAM(pb + PH_MIX); }
        if (IN(pb + PH_HYPOST)) { hypost_phase(F, (const bf16*)(ws + WS_YT), (bf16*)(ws + WS_MIX)); SEAM(pb + PH_HYPOST); }
        if (IN(pb + PH_WOUT)) {
            pg8::Gemm g{(const bf16*)(ws + WS_MIX), (const bf16*)(ws + WS_WOUT) + (size_t)l * DM * DM, MT, DM, DM}; pg8::Sched2 S; S.init(MT / 256, DM / 256, F.G, (int)blockIdx.x);
            pg8::EpiRes E{l == 0 ? KARG(I_X) : Hl, l == 0 ? KARG(I_CTX) : Hc, Hl, Hc, mods_l + 2 * 1024};
            pg8::gemm_phase<pg8::EpiRes, pg8::Sched2, true, true>(F.lds, g, S, E);
            SEAM(pb + PH_WOUT);
        }
        if (IN(pb + PH_NORM2)) {
            if (moe) { norm_phase<true>(F, Hl, Hc, KARG(I_GFFN) + l * DM, mods_l, 3, U, KARG(I_ROUTER) + (size_t)li * DM * 8, route, cnt); __syncthreads(); moe_convert(F, li); }
            else norm_phase<false>(F, Hl, Hc, KARG(I_GFFN) + l * DM, mods_l, 3, U, nullptr, nullptr, nullptr);
            SEAM(pb + PH_NORM2);
        }
        if (moe) {
            int tb[9];
            if (IN(pb + PH_GATHER)) { moe_tile_base(cnt, tb); gather_phase(F, U, route, tb, (bf16*)(ws + WS_AS)); SEAM(pb + PH_GATHER); }
            if (IN(pb + PH_UP)) {
                moe_tile_base(cnt, tb);
                pg8::Gemm g{(const bf16*)(ws + WS_AS), (const bf16*)(ws + WS_MWGU), MOE_ROWS, 2 * DFE, DM}; pg8::Sched2 S; S.init(tb[8], 2 * DFE / 256, F.G, (int)blockIdx.x); S.moe = 1;
#pragma unroll
                for (int e = 0; e < 9; ++e) S.tb[e] = tb[e];
                pg8::EpiSwiGLU E{(bf16*)(ws + WS_HID), DFE};
                pg8::gemm_phase<pg8::EpiSwiGLU, pg8::Sched2, true, true>(F.lds, g, S, E);
                SEAM(pb + PH_UP);
            }
            if (IN(pb + PH_DOWN)) {
                moe_tile_base(cnt, tb);
                pg8::Gemm g{(const bf16*)(ws + WS_HID), (const bf16*)(ws + WS_MWD), MOE_ROWS, DM, DFE}; pg8::Sched2 S; S.init(tb[8], DM / 256, F.G, (int)blockIdx.x); S.moe = 1;
#pragma unroll
                for (int e = 0; e < 9; ++e) S.tb[e] = tb[e];
                pg8::EpiBf E{(bf16*)(ws + WS_AS), DM};
                pg8::gemm_phase<pg8::EpiBf, pg8::Sched2, true, true>(F.lds, g, S, E);
                SEAM(pb + PH_DOWN);
            }
            if (IN(pb + PH_COMBINE)) { moe_tile_base(cnt, tb); combine_phase(F, Hl, Hc, route, tb, (const bf16*)(ws + WS_AS), mods_l + 5 * 1024); SEAM(pb + PH_COMBINE); }
        } else {
            if (IN(pb + PH_UP)) {
                pg8::Gemm g{U, (const bf16*)(ws + WS_WGU) + (size_t)li * 2 * DFF * DM, MT, 2 * DFF, DM}; pg8::Sched2 S; S.init(MT / 256, 2 * DFF / 256, F.G, (int)blockIdx.x);
                pg8::EpiSwiGLU E{(bf16*)(ws + WS_HID), DFF};
                pg8::gemm_phase<pg8::EpiSwiGLU, pg8::Sched2, true, true>(F.lds, g, S, E);
                SEAM(pb + PH_UP);
            }
            if (IN(pb + PH_DOWN)) {
                pg8::Gemm g{(const bf16*)(ws + WS_HID), (const bf16*)(ws + WS_WD) + (size_t)li * DM * DFF, MT, DM, DFF}; pg8::Sched2 S; S.init(MT / 256, DM / 256, F.G, (int)blockIdx.x);
                pg8::EpiRes E{Hl, Hc, Hl, Hc, mods_l + 5 * 1024};
                pg8::gemm_phase<pg8::EpiRes, pg8::Sched2, true, true>(F.lds, g, S, E);
                SEAM(pb + PH_DOWN);
            }
        }
    }
    if (IN(NPHASES - 1)) final_phase(F, Hl, KARG(I_GFINAL));
#undef IN
#undef SEAM
}

#ifndef MK_MULTI
#define MK_MULTI 1
#endif
extern "C" void kernel_launch(void* const* d_in, const int* in_sizes, int n_in, void* d_out, int out_size, void* d_ws, size_t ws_size, hipStream_t stream) {
    static int grid = 0;
    if (grid == 0) {
        if (n_in != 34 || out_size != ML * DM || ws_size < WS_END) { fprintf(stderr, "kernel_launch: unexpected problem (n_in %d, out %d, ws %zu < %zu)\n", n_in, out_size, ws_size, (size_t)WS_END); grid = -1; return; }
        int dev = 0, cus = 0, per_cu = 0;
        if (hipGetDevice(&dev) != hipSuccess || hipDeviceGetAttribute(&cus, hipDeviceAttributeMultiprocessorCount, dev) != hipSuccess) { grid = -1; return; }
        if (hipFuncSetAttribute((const void*)trunk_fwd, hipFuncAttributeMaxDynamicSharedMemorySize, LDS_BYTES) != hipSuccess) { fprintf(stderr, "kernel_launch: hipFuncSetAttribute failed\n"); grid = -1; return; }
        if (hipOccupancyMaxActiveBlocksPerMultiprocessor(&per_cu, (const void*)trunk_fwd, NWAVES * 64, LDS_BYTES) != hipSuccess || per_cu < 1) { fprintf(stderr, "kernel_launch: occupancy query says %d\n", per_cu); (void)hipGetLastError(); per_cu = 1; }
        grid = cus;
    }
    if (grid < 0) return;
    (void)hipMemsetAsync((char*)d_ws + WS_CTL, 0, CTL_ZERO_BYTES, stream);
    Args a{};
    for (int i = 0; i < 34; ++i) a.p.in[i] = (const float*)d_in[i];
    a.p.out = (float*)d_out; a.p.ws = (unsigned char*)d_ws;
#if MK_MULTI
    for (int ph = 0; ph < NPHASES; ++ph) {
        if (ph >= 1 && ph < NPHASES - 1) { const int l = (ph - 1) / NPL, k = (ph - 1) % NPL; if (!(l & 1) && (k == PH_GATHER || k == PH_COMBINE)) continue; }
        a.ph_lo = ph; a.ph_hi = ph + 1; a.use_bar = 0;
        hipLaunchKernelGGL(trunk_fwd, dim3(grid), dim3(NWAVES * 64), LDS_BYTES, stream, a);
    }
#else
    a.ph_lo = 0; a.ph_hi = NPHASES; a.use_bar = 1;
    hipLaunchKernelGGL(trunk_fwd, dim3(grid), dim3(NWAVES * 64), LDS_BYTES, stream, a);
#endif
}
```

```cpp
#include <hip/hip_runtime.h>
#include <hip/hip_bf16.h>
#include <cstdio>
#include <cstdint>
#include <cmath>
__device__ __forceinline__ float shx(float v, int o, int lane) { return __int_as_float(__builtin_amdgcn_ds_bpermute((lane ^ o) << 2, __float_as_int(v))); }
namespace pg8 {
#define PG8_LAS __attribute__((address_space(3)))
typedef unsigned short bf16_t;
typedef short bf16x8 __attribute__((ext_vector_type(8)));
typedef float f32x4 __attribute__((ext_vector_type(4)));
typedef unsigned u32x4 __attribute__((ext_vector_type(4)));
constexpr int BM = 256, BK = 64, HALF = 128, HTB = HALF * BK * 2  , STAGE_BYTES = 8 * HTB, NXCD = 8, WGM = 4;

__host__ __device__ __forceinline__ int lds_byte(int r, int c) { const int st = (r >> 4) * 2 + (c >> 5), rr = r & 15, cc = c & 31, ob = rr * 64 + cc * 2; return st * 1024 + (ob ^ (((ob >> 9) & 1) << 5)); }
__host__ __device__ __forceinline__ void stage_rc(int b, int& R, int& C) { const int st = b / 1024, sb = b % 1024, swz = sb ^ (((sb >> 9) & 1) << 5); R = (st >> 1) * 16 + swz / 64; C = (st & 1) * 32 + (swz % 64) / 2; }
__host__ __device__ __forceinline__ int perm32(int rho) { const int n = rho >> 4, i = rho & 15; return 8 * (i >> 2) + 4 * n + (i & 3); }

__host__ __device__ __forceinline__ int lds_byte8(int r, int cb) { const int st = (r >> 4) * 2 + (cb >> 6), rr = r & 15, ch = ((cb >> 4) & 3) ^ ((rr >> 3) & 1); return st * 1024 + rr * 64 + ch * 16 + (cb & 15); }
__host__ __device__ __forceinline__ void stage_rc8(int b, int& R, int& C) { const int st = b / 1024, sb = b % 1024, rr = sb / 64, ch = ((sb % 64) / 16) ^ ((rr >> 3) & 1); R = (st >> 1) * 16 + rr; C = ((st & 1) * 64 + ch * 16) / 2; }
typedef int v4i_t __attribute__((ext_vector_type(4)));
typedef int v8i_t __attribute__((ext_vector_type(8)));
__device__ __forceinline__ v8i_t cat8(bf16x8 lo, bf16x8 hi) { return __builtin_shufflevector(__builtin_bit_cast(v4i_t, lo), __builtin_bit_cast(v4i_t, hi), 0, 1, 2, 3, 4, 5, 6, 7); }
__device__ __forceinline__ unsigned pk_fp8x4(float a, float b, float c, float d) {
    a = __builtin_amdgcn_fmed3f(a, -448.f, 448.f); b = __builtin_amdgcn_fmed3f(b, -448.f, 448.f); c = __builtin_amdgcn_fmed3f(c, -448.f, 448.f); d = __builtin_amdgcn_fmed3f(d, -448.f, 448.f);
    unsigned w = 0u; w = __builtin_amdgcn_cvt_pk_fp8_f32(a, b, w, false); w = __builtin_amdgcn_cvt_pk_fp8_f32(c, d, w, true); return w; }
struct Unit { int pm, pn, pnl, e, ko, sl; };
struct Gemm { const bf16_t* A; const bf16_t* Bt; int M, N, K, ld; };

__device__ __forceinline__ unsigned cvt_pk_bf16(float lo, float hi) { unsigned r; asm volatile("v_cvt_pk_bf16_f32 %0, %1, %2" : "=v"(r) : "v"(lo), "v"(hi)); return r; }
constexpr int P_ML = 32768, P_ZP = 2304, P_D = 1024, P_MODS = 6144;
constexpr float P_EPS = 1e-6f;
constexpr float C2D = 0.17677669529663687f * 1.4426950408889634f;
constexpr float C2G = 0.125f * 1.4426950408889634f;

struct Sched2 {
    int nM, nN, nwg, G, c, moe, wgm; int tb[9];
    __device__ __forceinline__ void init(int nM_, int nN_, int G_, int c_) { nM = nM_; nN = nN_; nwg = nM * nN; G = G_; c = c_; moe = 0; wgm = WGM; }
    __device__ __forceinline__ bool next(int i, Unit& u) const {
        const long L = (long)i * G + c; if (L >= nwg) return false;
        int wgid = (int)L; { const int q = nwg / NXCD, r = nwg % NXCD, xcd = wgid % NXCD, off = wgid / NXCD; wgid = (xcd < r ? xcd * (q + 1) : r * (q + 1) + (xcd - r) * q) + off; }
        const int nig = wgm * nN, gid = wgid / nig, fm = gid * wgm, gsz = (nM - fm) < wgm ? (nM - fm) : wgm;
        u.pm = fm + ((wgid % nig) % gsz); u.pnl = (wgid % nig) / gsz;
        int e = 0;
        if (moe) {
#pragma unroll
            for (int k = 1; k < 8; ++k) e += (u.pm >= tb[k]) ? 1 : 0;
        }
        u.e = e; u.pn = e * nN + u.pnl; u.ko = 0; u.sl = 0; return true;
    }
    __device__ __forceinline__ void a_ready(const Unit&) const {}
    __device__ __forceinline__ void done(const Unit&) const {}
};

struct SchedTail {
    int S, Kp, G, c;
    __device__ __forceinline__ bool next(int i, Unit& u) const {
        const int q = i * G + c; if (q >= 32 * S) return false;
        const int tu = q / S, sl = q - tu * S;
        u.pm = 128 + (tu >> 2); u.pnl = tu & 3; u.pn = u.pnl; u.e = 0; u.ko = sl * Kp; u.sl = sl; return true;
    }
    __device__ __forceinline__ void a_ready(const Unit&) const {}
    __device__ __forceinline__ void done(const Unit&) const {}
};
struct EpiPart {
    static constexpr bool PERM = false, AFTER_DRAIN = false;
    float* P; int S;
    __device__ __forceinline__ void operator()(const f32x4 (&acc)[2][2][4][2], const Unit& u, int wr, int wc, int fr, int fq) const {
        float* base = P + (size_t)((((u.pm - 128) << 2) + u.pnl) * S + u.sl) * 65536;
        const int row0 = wr * 64 + fr, col0 = wc * 32 + 4 * fq;
#pragma unroll
        for (int ai = 0; ai < 2; ++ai)
#pragma unroll
            for (int m = 0; m < 4; ++m) { float* rowp = base + (size_t)(row0 + ai * HALF + m * 16) * 256 + col0;
#pragma unroll
                for (int bj = 0; bj < 2; ++bj)
#pragma unroll
                    for (int n = 0; n < 2; ++n) *(f32x4*)(rowp + bj * HALF + n * 16) = acc[ai][bj][m][n]; }
    }
};

struct EpiWin {
    static constexpr bool PERM = true, AFTER_DRAIN = false;
    bf16_t* Z; const PG8_LAS float* rope;
    const float* qn; const float* kn;
    __device__ __forceinline__ void operator()(const f32x4 (&acc)[2][2][4][2], const Unit& u, int wr, int wc, int fr, int fq) const {
        const int pn = u.pnl, pm = u.pm; const bool lat = pm < 128;
        int kind;
        if (pn == 3 || pn == 4) kind = 1; else if (pn == 6 || pn == 7) kind = 2; else if (pn == 8) kind = (wc < 2) ? 2 : 3; else kind = 0;
        const PG8_LAS float* Cd = rope; const PG8_LAS float* Sd = rope + 512; const PG8_LAS float* Cg = rope + 1024; const PG8_LAS float* Sg = rope + 2048;
        float gn0[8], gn1[8];
        if (kind == 2) { const float* gp = (pn == 8) ? kn : qn;
#pragma unroll
            for (int j = 0; j < 8; ++j) { gn0[j] = gp[8 * fq + j]; gn1[j] = gp[32 + 8 * fq + j]; } }
#pragma unroll
        for (int ai = 0; ai < 2; ++ai)
#pragma unroll
            for (int m = 0; m < 4; ++m) {
                const int row = pm * BM + ai * HALF + wr * 64 + m * 16 + fr;
                const int grow = (4 * pm + 2 * ai + wr) & 63, gcol = 16 * m + fr;
                float x0[8], x1[8];
#pragma unroll
                for (int j = 0; j < 8; ++j) { x0[j] = acc[ai][0][m][j >> 2][j & 3]; x1[j] = acc[ai][1][m][j >> 2][j & 3]; }
                bf16_t* zr = Z + (size_t)row * P_ZP;
                int col0, col1;
                if (kind == 0) { col0 = pn * 256 + wc * 32 + 8 * fq; col1 = col0 + 128; }
                else if (kind == 3) { col0 = pn * 256 + wc * 64 + 8 * fq; col1 = col0 + 32; }
                else if (kind == 1) {
                    col0 = pn * 256 + wc * 64 + 32 * (fq >> 1) + 8 * (fq & 1); col1 = col0 + 16;
                    const float sc = (pn == 3) ? C2D : 1.0f;
                    if (lat) { const int pos = (fq & 1) ? gcol : grow;
                        const f32x4 c0 = *(const PG8_LAS f32x4*)(Cd + pos * 8), c1 = *(const PG8_LAS f32x4*)(Cd + pos * 8 + 4), s0 = *(const PG8_LAS f32x4*)(Sd + pos * 8), s1 = *(const PG8_LAS f32x4*)(Sd + pos * 8 + 4);
#pragma unroll
                        for (int j = 0; j < 8; ++j) { const float c = j < 4 ? c0[j & 3] : c1[j & 3], s = j < 4 ? s0[j & 3] : s1[j & 3]; const float a = x0[j], b = x1[j]; x0[j] = (a * c - b * s) * sc; x1[j] = (a * s + b * c) * sc; }
                    } else {
#pragma unroll
                        for (int j = 0; j < 8; ++j) { x0[j] *= sc; x1[j] *= sc; }
                    }
                } else {
                    col0 = pn * 256 + wc * 64 + 8 * fq; col1 = col0 + 32;
                    float ss = 0.f;
#pragma unroll
                    for (int j = 0; j < 8; ++j) ss += x0[j] * x0[j] + x1[j] * x1[j];
                    { const int ln = fq * 16 + fr; ss += shx(ss, 16, ln); ss += shx(ss, 32, ln); }
                    const float rn = __builtin_amdgcn_rsqf(ss * (1.0f / 64.0f) + P_EPS);
                    const float sc = (pn == 8) ? 1.0f : C2G;
#pragma unroll
                    for (int j = 0; j < 8; ++j) { x0[j] = x0[j] * rn * gn0[j]; x1[j] = x1[j] * rn * gn1[j]; }
                    if (lat) { const int pos = (fq < 2) ? grow : gcol; const int fo = pos * 16 + 8 * (fq & 1);
                        const f32x4 c0 = *(const PG8_LAS f32x4*)(Cg + fo), c1 = *(const PG8_LAS f32x4*)(Cg + fo + 4), s0 = *(const PG8_LAS f32x4*)(Sg + fo), s1 = *(const PG8_LAS f32x4*)(Sg + fo + 4);
#pragma unroll
                        for (int j = 0; j < 8; ++j) { const float c = j < 4 ? c0[j & 3] : c1[j & 3], s = j < 4 ? s0[j & 3] : s1[j & 3]; const float a = x0[j], b = x1[j]; x0[j] = (a * c - b * s) * sc; x1[j] = (a * s + b * c) * sc; }
                    } else {
#pragma unroll
                        for (int j = 0; j < 8; ++j) { x0[j] *= sc; x1[j] *= sc; }
                    }
                }
                u32x4 w0, w1;
                w0.x = cvt_pk_bf16(x0[0], x0[1]); w0.y = cvt_pk_bf16(x0[2], x0[3]); w0.z = cvt_pk_bf16(x0[4], x0[5]); w0.w = cvt_pk_bf16(x0[6], x0[7]);
                w1.x = cvt_pk_bf16(x1[0], x1[1]); w1.y = cvt_pk_bf16(x1[2], x1[3]); w1.z = cvt_pk_bf16(x1[4], x1[5]); w1.w = cvt_pk_bf16(x1[6], x1[7]);
                *(u32x4*)(zr + col0) = w0; *(u32x4*)(zr + col1) = w1;
            }
    }
};

template <bool BASE_F32> struct EpiRes {
    static constexpr bool PERM = true, AFTER_DRAIN = false;
    const void* base_l; const void* base_c; bf16_t* out_l; bf16_t* out_c; const float* gate; float gs;
    __device__ __forceinline__ void operator()(const f32x4 (&acc)[2][2][4][2], const Unit& u, int wr, int wc, int fr, int fq) const {
        const bool lat = u.pm < 128; const int mi = lat ? (u.pm >> 4) : 8;
        const int row0 = (lat ? u.pm : (u.pm - 128)) * BM + wr * 64 + fr, col0 = u.pnl * BM + wc * 32 + 8 * fq;
        const void* bp = lat ? base_l : base_c; bf16_t* op = lat ? out_l : out_c;
        f32x4 gv[2][2];
#pragma unroll
        for (int bj = 0; bj < 2; ++bj)
#pragma unroll
            for (int n = 0; n < 2; ++n) gv[bj][n] = *(const f32x4*)(gate + mi * P_MODS + col0 + bj * HALF + n * 4) * gs;
#pragma unroll
        for (int ai = 0; ai < 2; ++ai) {
            f32x4 bq[4][2][2];
#pragma unroll
            for (int m = 0; m < 4; ++m) { const size_t off = (size_t)(row0 + ai * HALF + m * 16) * P_D + col0;
#pragma unroll
                for (int bj = 0; bj < 2; ++bj) {
                    if (BASE_F32) { bq[m][bj][0] = *(const f32x4*)((const float*)bp + off + bj * HALF); bq[m][bj][1] = *(const f32x4*)((const float*)bp + off + bj * HALF + 4); }
                    else { const u32x4 w = *(const u32x4*)((const bf16_t*)bp + off + bj * HALF);
                        bq[m][bj][0] = (f32x4){__uint_as_float(w.x << 16), __uint_as_float(w.x & 0xffff0000u), __uint_as_float(w.y << 16), __uint_as_float(w.y & 0xffff0000u)};
                        bq[m][bj][1] = (f32x4){__uint_as_float(w.z << 16), __uint_as_float(w.z & 0xffff0000u), __uint_as_float(w.w << 16), __uint_as_float(w.w & 0xffff0000u)}; } } }
            asm volatile("" ::: "memory");
#pragma unroll
            for (int m = 0; m < 4; ++m) { const size_t off = (size_t)(row0 + ai * HALF + m * 16) * P_D + col0;
#pragma unroll
                for (int bj = 0; bj < 2; ++bj) { const f32x4 v0 = bq[m][bj][0] + gv[bj][0] * acc[ai][bj][m][0], v1 = bq[m][bj][1] + gv[bj][1] * acc[ai][bj][m][1];
                    u32x4 w; w.x = cvt_pk_bf16(v0[0], v0[1]); w.y = cvt_pk_bf16(v0[2], v0[3]); w.z = cvt_pk_bf16(v1[0], v1[1]); w.w = cvt_pk_bf16(v1[2], v1[3]);
                    *(u32x4*)(op + off + bj * HALF) = w; } }
            asm volatile("" ::: "memory");
        }
    }
};

struct EpiSwiGLU {
    static constexpr bool PERM = true, AFTER_DRAIN = false;
    bf16_t* H; int ldh; int dry;
    __device__ __forceinline__ void operator()(const f32x4 (&acc)[2][2][4][2], const Unit& u, int wr, int wc, int fr, int fq) const {
        if (dry) { if (acc[0][0][0][0][0] == 1.2345e-30f) H[0] = 0; return; }
        const int row0 = u.pm * BM + wr * 64 + fr, col0 = u.pnl * HALF + wc * 32 + 8 * fq;
#pragma unroll
        for (int ai = 0; ai < 2; ++ai)
#pragma unroll
            for (int m = 0; m < 4; ++m) {
                typedef float f32x2p __attribute__((ext_vector_type(2)));
                float v[8];
#pragma unroll
                for (int j = 0; j < 8; j += 2) {
                    const f32x2p g = {acc[ai][0][m][j >> 2][j & 3], acc[ai][0][m][j >> 2][(j & 3) + 1]}, up = {acc[ai][1][m][j >> 2][j & 3], acc[ai][1][m][j >> 2][(j & 3) + 1]};
                    const f32x2p a = g * (-1.4426950408889634f);
                    f32x2p e; e.x = __builtin_amdgcn_exp2f(a.x); e.y = __builtin_amdgcn_exp2f(a.y);
                    const f32x2p d = e + 1.0f; f32x2p r; r.x = __builtin_amdgcn_rcpf(d.x); r.y = __builtin_amdgcn_rcpf(d.y);
                    const f32x2p o = (g * up) * r; v[j] = o.x; v[j + 1] = o.y; }
                u32x4 w; w.x = cvt_pk_bf16(v[0], v[1]); w.y = cvt_pk_bf16(v[2], v[3]); w.z = cvt_pk_bf16(v[4], v[5]); w.w = cvt_pk_bf16(v[6], v[7]);
                *(u32x4*)(H + (size_t)(row0 + ai * HALF + m * 16) * ldh + col0) = w;
            }
    }
};

constexpr float F8_SA = 4.0f, F8_SW = 32.0f, F8_SH = 4.0f, F8_SWD = 64.0f;
struct EpiSwiGLU8 {
    static constexpr bool PERM = true, AFTER_DRAIN = false;
    unsigned char* H; int ldh; int dry;
    __device__ __forceinline__ void operator()(const f32x4 (&acc)[2][2][4][2], const Unit& u, int wr, int wc, int fr, int fq) const {
        if (dry) { if (acc[0][0][0][0][0] == 1.2345e-30f) H[0] = 0; return; }
        const int row0 = u.pm * BM + wr * 64 + fr, col0 = u.pnl * HALF + wc * 32 + 8 * fq;
        constexpr float inv = 1.0f / (F8_SA * F8_SW), c1 = -1.4426950408889634f * inv, rk = 1.0f / (inv * inv * F8_SH);
#pragma unroll
        for (int ai = 0; ai < 2; ++ai)
#pragma unroll
            for (int m = 0; m < 4; ++m) {
                float v[8];
#pragma unroll
                for (int j = 0; j < 8; j += 2) {
                    typedef float f32x2p __attribute__((ext_vector_type(2)));
                    const f32x2p ag = {acc[ai][0][m][j >> 2][j & 3], acc[ai][0][m][j >> 2][(j & 3) + 1]}, au = {acc[ai][1][m][j >> 2][j & 3], acc[ai][1][m][j >> 2][(j & 3) + 1]};
                    const f32x2p a = ag * c1; f32x2p e; e.x = __builtin_amdgcn_exp2f(a.x); e.y = __builtin_amdgcn_exp2f(a.y);
                    const f32x2p d = e * rk + rk; f32x2p r; r.x = __builtin_amdgcn_rcpf(d.x); r.y = __builtin_amdgcn_rcpf(d.y);
                    const f32x2p o = (ag * au) * r; v[j] = o.x; v[j + 1] = o.y; }
                typedef unsigned u32x2e __attribute__((ext_vector_type(2)));
                u32x2e w; w.x = pk_fp8x4(v[0], v[1], v[2], v[3]); w.y = pk_fp8x4(v[4], v[5], v[6], v[7]);
                *(u32x2e*)(H + (size_t)(row0 + ai * HALF + m * 16) * ldh + col0) = w;
            }
    }
};
struct EpiBf {
    static constexpr bool PERM = true, AFTER_DRAIN = false;
    bf16_t* O; int ldc; float sc;
    __device__ __forceinline__ void operator()(const f32x4 (&acc)[2][2][4][2], const Unit& u, int wr, int wc, int fr, int fq) const {
        const int row0 = u.pm * BM + wr * 64 + fr, col0 = u.pnl * BM + wc * 32 + 8 * fq;
#pragma unroll
        for (int ai = 0; ai < 2; ++ai)
#pragma unroll
            for (int m = 0; m < 4; ++m) { bf16_t* rowp = O + (size_t)(row0 + ai * HALF + m * 16) * ldc + col0;
#pragma unroll
                for (int bj = 0; bj < 2; ++bj) { const f32x4 v0 = acc[ai][bj][m][0] * sc, v1 = acc[ai][bj][m][1] * sc;
                    u32x4 w; w.x = cvt_pk_bf16(v0[0], v0[1]); w.y = cvt_pk_bf16(v0[2], v0[3]); w.z = cvt_pk_bf16(v1[0], v1[1]); w.w = cvt_pk_bf16(v1[2], v1[3]);
                    *(u32x4*)(rowp + bj * HALF) = w; } }
    }
};
template <class Epi, class Sched, bool ALIGN_EPI = false, bool SP2 = false, bool FP8 = false>
__device__ __forceinline__ void gemm_phase(PG8_LAS unsigned char* lds, const Gemm g, const Sched& S, const Epi& E) {
    int tid_ = threadIdx.x; asm volatile("" : "+v"(tid_));
    const int tid = tid_, wid = __builtin_amdgcn_readfirstlane(tid >> 6), lane = tid & 63, wr = wid >> 2, wc = wid & 3, fr = lane & 15, fq = lane >> 4;
    const int K = g.ld, nt = g.K / BK;
    unsigned voffA[2], voffB[2];
#pragma unroll
    for (int i = 0; i < 2; ++i) { int R, C; if constexpr (FP8) stage_rc8(tid * 16 + i * 8192, R, C); else stage_rc(tid * 16 + i * 8192, R, C); const int Rb = Epi::PERM ? ((R & ~31) + perm32(R & 31)) : R;
        voffA[i] = (unsigned)(R * K + C) * 2u; voffB[i] = (unsigned)(Rb * K + C) * 2u; }
    const size_t kstep = (size_t)(BK * 2);
    const size_t hstep = (size_t)HALF * K * 2;
    const size_t tstep = 2 * hstep;
    const unsigned ldsw = (unsigned)wid * 1024u;
    int aoff, boff, aoff1 = 0, boff1 = 0;
    if constexpr (FP8) { aoff = lds_byte8(wr * 64 + fr, 32 * fq); aoff1 = lds_byte8(wr * 64 + fr, 32 * fq + 16); boff = lds_byte8(wc * 32 + fr, 32 * fq); boff1 = lds_byte8(wc * 32 + fr, 32 * fq + 16); }
    else { aoff = lds_byte(wr * 64 + fr, fq * 8); boff = lds_byte(wc * 32 + fr, fq * 8); }
#define PG8_SA(b, h) (((b) * 2 + (h)) * HTB)
#define PG8_SB(b, h) ((4 + (b) * 2 + (h)) * HTB)
#define PG8_STAGE(bufoff, gbase, voff) do { _Pragma("unroll") for (int _i = 0; _i < 2; ++_i) { unsigned _vo = (voff)[_i]; asm volatile("" : "+v"(_vo));     \
        __builtin_amdgcn_global_load_lds((const unsigned*)((const char*)(gbase) + _vo), (PG8_LAS unsigned*)(lds + (bufoff) + ldsw + _i * 8192), 16, 0, 0); } } while (0)
#define PG8_LDA(dst, b, h) do { if constexpr (FP8) { _Pragma("unroll") for (int m = 0; m < 4; ++m) dst##8[m] = __builtin_shufflevector(*(const PG8_LAS v4i_t*)(lds + PG8_SA(b, h) + aoff + m * 2048), *(const PG8_LAS v4i_t*)(lds + PG8_SA(b, h) + aoff1 + m * 2048), 0, 1, 2, 3, 4, 5, 6, 7); } \
    else { _Pragma("unroll") for (int m = 0; m < 4; ++m) _Pragma("unroll") for (int k = 0; k < 2; ++k) dst[m][k] = *(const PG8_LAS bf16x8*)(lds + PG8_SA(b, h) + aoff + m * 2048 + k * 1024); } } while (0)
#define PG8_LDB(dst, b, h) do { if constexpr (FP8) { _Pragma("unroll") for (int n = 0; n < 2; ++n) dst##8[n] = __builtin_shufflevector(*(const PG8_LAS v4i_t*)(lds + PG8_SB(b, h) + boff + n * 2048), *(const PG8_LAS v4i_t*)(lds + PG8_SB(b, h) + boff1 + n * 2048), 0, 1, 2, 3, 4, 5, 6, 7); } \
    else { _Pragma("unroll") for (int n = 0; n < 2; ++n) _Pragma("unroll") for (int k = 0; k < 2; ++k) dst[n][k] = *(const PG8_LAS bf16x8*)(lds + PG8_SB(b, h) + boff + n * 2048 + k * 1024); } } while (0)
#define PG8_MMA(ai, bj, At, Bt) do { if constexpr (FP8) __builtin_amdgcn_sched_barrier(0); __builtin_amdgcn_s_setprio(1); _Pragma("unroll") for (int m = 0; m < 4; ++m) _Pragma("unroll") for (int n = 0; n < 2; ++n) { \
        if constexpr (FP8) { acc[ai][bj][m][n] = __builtin_amdgcn_mfma_scale_f32_16x16x128_f8f6f4(Bt##8[n], At##8[m], acc[ai][bj][m][n], 0, 0, 0, 0x7f7f7f7f, 0, 0x7f7f7f7f); } \
        else { _Pragma("unroll") for (int k = 0; k < 2; ++k) acc[ai][bj][m][n] = __builtin_amdgcn_mfma_f32_16x16x32_bf16(Bt[n][k], At[m][k], acc[ai][bj][m][n], 0, 0, 0); } } __builtin_amdgcn_s_setprio(0); if constexpr (FP8) __builtin_amdgcn_sched_barrier(0); } while (0)
#define PG8_WAIT_V(n) asm volatile("s_waitcnt vmcnt(" #n ")" ::: "memory")
#define PG8_WAIT_L(n) asm volatile("s_waitcnt lgkmcnt(" #n ")" ::: "memory")
#define PG8_BAR __builtin_amdgcn_s_barrier()
#define PG8_SCHED __builtin_amdgcn_sched_barrier(0)
    Unit cur, nxt; int ui = 0;
    if (!S.next(0, cur)) return;
    f32x4 acc[2][2][4][2];
#pragma unroll
    for (int a = 0; a < 2; ++a)
#pragma unroll
        for (int b = 0; b < 2; ++b)
#pragma unroll
            for (int m = 0; m < 4; ++m)
#pragma unroll
                for (int n = 0; n < 2; ++n) acc[a][b][m][n] = (f32x4){0.f, 0.f, 0.f, 0.f};
    bf16x8 At[4][2], B0[2][2], B1[2][2];
    v8i_t At8[4], B08[2], B18[2];
    const char* cA = (const char*)g.A + (size_t)cur.pm * tstep + (size_t)cur.ko * 2; const char* cB = (const char*)g.Bt + (size_t)cur.pn * tstep + (size_t)cur.ko * 2;
    S.a_ready(cur);
    if constexpr (SP2) {
        PG8_STAGE(PG8_SB(0, 0), cB, voffB); PG8_STAGE(PG8_SB(0, 1), cB + hstep, voffB); PG8_STAGE(PG8_SA(0, 0), cA, voffA); PG8_STAGE(PG8_SA(0, 1), cA + hstep, voffA);
        if (wr == 1) PG8_BAR;
        PG8_WAIT_V(2); PG8_BAR;
        PG8_STAGE(PG8_SB(1, 0), cB + kstep, voffB); PG8_STAGE(PG8_SA(1, 0), cA + kstep, voffA); PG8_STAGE(PG8_SB(1, 1), cB + hstep + kstep, voffB);
        PG8_WAIT_V(6); PG8_BAR;
    } else {
        PG8_STAGE(PG8_SB(0, 0), cB, voffB); PG8_STAGE(PG8_SA(0, 0), cA, voffA); PG8_STAGE(PG8_SB(0, 1), cB + hstep, voffB); PG8_STAGE(PG8_SA(0, 1), cA + hstep, voffA);
        if (wr == 1) PG8_BAR;
        PG8_WAIT_V(4); PG8_BAR;
        PG8_STAGE(PG8_SB(1, 0), cB + kstep, voffB); PG8_STAGE(PG8_SA(1, 0), cA + kstep, voffA); PG8_STAGE(PG8_SB(1, 1), cB + hstep + kstep, voffB);
        PG8_WAIT_V(6); PG8_BAR;
    }
    for (;;) {
        const bool has_next = S.next(ui + 1, nxt);
        const char* nA = has_next ? (const char*)g.A + (size_t)nxt.pm * tstep + (size_t)nxt.ko * 2 : cA; const char* nB = has_next ? (const char*)g.Bt + (size_t)nxt.pn * tstep + (size_t)nxt.ko * 2 : cB;
#pragma nounroll
        for (int t = 0; t < nt; t += 2) {
            const bool last = (t == nt - 2);
            const char* a1 = cA + (size_t)(t + 1) * kstep;
            const char* a2 = last ? nA : cA + (size_t)(t + 2) * kstep; const char* b2 = last ? nB : cB + (size_t)(t + 2) * kstep;
            const char* a3 = a2 + kstep; const char* b3 = b2 + kstep;
            if (last && has_next) S.a_ready(nxt);
            if constexpr (SP2) {
            PG8_LDB(B0, 0, 0); PG8_LDB(B1, 0, 1); PG8_SCHED; PG8_LDA(At, 0, 0); PG8_STAGE(PG8_SA(1, 1), a1 + hstep, voffA);
            PG8_WAIT_V(8); PG8_WAIT_L(0); PG8_BAR; PG8_MMA(0, 0, At, B0); PG8_MMA(0, 1, At, B1); PG8_BAR; PG8_SCHED;
            PG8_LDA(At, 0, 1); PG8_STAGE(PG8_SB(0, 0), b2, voffB); PG8_STAGE(PG8_SB(0, 1), b2 + hstep, voffB); PG8_STAGE(PG8_SA(0, 0), a2, voffA);
            PG8_WAIT_V(8); PG8_WAIT_L(0); PG8_BAR; PG8_MMA(1, 0, At, B0); PG8_MMA(1, 1, At, B1); PG8_BAR; PG8_SCHED;
            PG8_LDB(B0, 1, 0); PG8_LDB(B1, 1, 1); PG8_SCHED; PG8_LDA(At, 1, 0); PG8_STAGE(PG8_SA(0, 1), a2 + hstep, voffA);
            PG8_WAIT_V(8); PG8_WAIT_L(0); PG8_BAR; PG8_MMA(0, 0, At, B0); PG8_MMA(0, 1, At, B1); PG8_BAR; PG8_SCHED;
            PG8_LDA(At, 1, 1); PG8_STAGE(PG8_SB(1, 0), b3, voffB); PG8_STAGE(PG8_SB(1, 1), b3 + hstep, voffB); PG8_STAGE(PG8_SA(1, 0), a3, voffA);
            PG8_WAIT_V(8); PG8_WAIT_L(0); PG8_BAR; PG8_MMA(1, 0, At, B0); PG8_MMA(1, 1, At, B1); PG8_BAR; PG8_SCHED;
            } else {
            PG8_LDB(B0, 0, 0); PG8_SCHED; PG8_LDA(At, 0, 0); PG8_STAGE(PG8_SA(1, 1), a1 + hstep, voffA);
            PG8_WAIT_L(8); PG8_BAR; PG8_WAIT_L(0); PG8_MMA(0, 0, At, B0); PG8_BAR; PG8_SCHED;
            PG8_LDB(B1, 0, 1); PG8_STAGE(PG8_SB(0, 0), b2, voffB);
            PG8_BAR; PG8_WAIT_L(0); PG8_MMA(0, 1, At, B1); PG8_BAR;
            PG8_LDA(At, 0, 1); PG8_STAGE(PG8_SA(0, 0), a2, voffA);
            PG8_BAR; PG8_WAIT_L(0); PG8_MMA(1, 0, At, B0); PG8_BAR; PG8_SCHED;
            PG8_STAGE(PG8_SB(0, 1), b2 + hstep, voffB);
            PG8_WAIT_V(6); PG8_BAR; PG8_MMA(1, 1, At, B1); PG8_BAR;
            PG8_LDB(B0, 1, 0); PG8_SCHED; PG8_LDA(At, 1, 0); PG8_STAGE(PG8_SA(0, 1), a2 + hstep, voffA);
            PG8_WAIT_L(8); PG8_BAR; PG8_WAIT_L(0); PG8_MMA(0, 0, At, B0); PG8_BAR; PG8_SCHED;
            PG8_LDB(B1, 1, 1); PG8_STAGE(PG8_SB(1, 0), b3, voffB);
            PG8_BAR; PG8_WAIT_L(0); PG8_MMA(0, 1, At, B1); PG8_BAR;
            PG8_LDA(At, 1, 1); PG8_STAGE(PG8_SA(1, 0), a3, voffA);
            PG8_BAR; PG8_WAIT_L(0); PG8_MMA(1, 0, At, B0); PG8_BAR; PG8_SCHED;
            PG8_STAGE(PG8_SB(1, 1), b3 + hstep, voffB);
            PG8_WAIT_V(6); PG8_BAR; PG8_MMA(1, 1, At, B1); PG8_BAR;
            }
        }
        if constexpr (ALIGN_EPI) { if (wr == 0) PG8_BAR; }
        if constexpr (!Epi::AFTER_DRAIN) { int l2 = lane; asm volatile("" : "+v"(l2));     E(acc, cur, wr, wc, l2 & 15, l2 >> 4); S.done(cur); }
        if (!has_next) break;
#pragma unroll
        for (int a = 0; a < 2; ++a)
#pragma unroll
            for (int b = 0; b < 2; ++b)
#pragma unroll
                for (int m = 0; m < 4; ++m)
#pragma unroll
                    for (int n = 0; n < 2; ++n) acc[a][b][m][n] = (f32x4){0.f, 0.f, 0.f, 0.f};
        cur = nxt; cA = nA; cB = nB; ++ui;
        if constexpr (ALIGN_EPI) { if (wr == 1) PG8_BAR; }
    }
    PG8_WAIT_V(0);
    if constexpr (!ALIGN_EPI) { if (wr == 0) PG8_BAR; }
    PG8_BAR;
    if constexpr (Epi::AFTER_DRAIN) { E.fused(acc, cur, wr, wc, fr, fq, lds, wid, lane); S.done(cur); }
#undef PG8_SA
#undef PG8_SB
#undef PG8_STAGE
#undef PG8_LDA
#undef PG8_LDB
#undef PG8_MMA
#undef PG8_WAIT_V
#undef PG8_WAIT_L
#undef PG8_BAR
#undef PG8_SCHED
}
}
#ifndef ATTN_STORE16
#define ATTN_STORE16(p,v) (*(u32x4*)(p)=(v))
#endif
namespace attn_body {
using bf16=__hip_bfloat16;
using bf16x8=__attribute__((ext_vector_type(8)))short;
using s16x4=__attribute__((ext_vector_type(4)))short;
using f32x16=__attribute__((ext_vector_type(16)))float;
using u32x4=__attribute__((ext_vector_type(4)))unsigned;
constexpr int D=64,ZP=2304,OP=1024;
constexpr int NW=8,QBLK=32,QB=QBLK*NW,KVBLK=64;
__device__ __forceinline__ int crow(int r,int hi){return (r&3)+8*(r>>2)+4*hi;}
#define SBAR() __builtin_amdgcn_sched_barrier(0)
constexpr int NSLOT=3, SLOTB=8192;
constexpr int LDS_K=0, LDS_V=NSLOT*SLOTB, LDS_WS=2*NSLOT*SLOTB, LDS_OST=LDS_WS+NW*64*4, LDS_BYTES=LDS_OST+NW*8192;
__device__ __forceinline__ void glds16(const void*gsrc,unsigned lds_dst){unsigned keep;
  asm volatile("s_mov_b32 %0, m0\n\ts_mov_b32 m0, %2\n\ts_nop 0\n\tglobal_load_lds_dwordx4 %1, off\n\ts_mov_b32 m0, %0":"=&s"(keep):"v"(gsrc),"s"(lds_dst):"memory");}
__device__ __forceinline__ float max3f(float a,float b,float c){float r;asm("v_max3_f32 %0, %1, %2, %3":"=v"(r):"v"(a),"v"(b),"v"(c));return r;}
__device__ __forceinline__ float max2f(float a,float b){float r;asm("v_max_f32_e32 %0, %1, %2":"=v"(r):"v"(a),"v"(b));return r;}
__device__ __forceinline__ float fadd_s(float a,float b){float r;asm("v_add_f32_e32 %0, %1, %2":"=v"(r):"v"(a),"v"(b));return r;}
__device__ __forceinline__ float fsub_s(float a,float b){float r;asm("v_sub_f32_e32 %0, %1, %2":"=v"(r):"v"(a),"v"(b));return r;}
typedef float f32x2_t __attribute__((ext_vector_type(2))); typedef __bf16 bf16x2_t __attribute__((ext_vector_type(2)));
__device__ __forceinline__ unsigned cvtpk_s(float lo,float hi){f32x2_t v={lo,hi};bf16x2_t b=__builtin_convertvector(v,bf16x2_t);return __builtin_bit_cast(unsigned,b);}
#define WAIT_BAR(N) asm volatile("s_waitcnt vmcnt(" #N ") lgkmcnt(0)\n\ts_barrier":::"memory")

__device__ __forceinline__ void qkt(f32x16&p0,f32x16&p1,const char*Kslot,const bf16x8*qr,const f32x16&negm,int r32,int hi){
  const char*kb=Kslot+hi*1024+r32*16;
  #pragma unroll
  for(int d0=0;d0<4;++d0){
    const bf16x8 b0=*reinterpret_cast<const bf16x8*>(kb+d0*2048);
    const bf16x8 b1=*reinterpret_cast<const bf16x8*>(kb+d0*2048+512);
    if(d0==0){p0=__builtin_amdgcn_mfma_f32_32x32x16_bf16(b0,qr[0],negm,0,0,0);p1=__builtin_amdgcn_mfma_f32_32x32x16_bf16(b1,qr[0],negm,0,0,0);}
    else{p0=__builtin_amdgcn_mfma_f32_32x32x16_bf16(b0,qr[d0],p0,0,0,0);p1=__builtin_amdgcn_mfma_f32_32x32x16_bf16(b1,qr[d0],p1,0,0,0);}}
}
typedef __attribute__((address_space(3))) const char* lds_cptr;
typedef short v4i16_t __attribute__((ext_vector_type(4)));
__device__ __forceinline__ void kload8(bf16x8*kf,lds_cptr kp){
  kf[0]=*(const __attribute__((address_space(3))) bf16x8*)(kp);      kf[1]=*(const __attribute__((address_space(3))) bf16x8*)(kp+512);
  kf[2]=*(const __attribute__((address_space(3))) bf16x8*)(kp+2048); kf[3]=*(const __attribute__((address_space(3))) bf16x8*)(kp+2560);
  kf[4]=*(const __attribute__((address_space(3))) bf16x8*)(kp+4096); kf[5]=*(const __attribute__((address_space(3))) bf16x8*)(kp+4608);
  kf[6]=*(const __attribute__((address_space(3))) bf16x8*)(kp+6144); kf[7]=*(const __attribute__((address_space(3))) bf16x8*)(kp+6656);
}
__device__ __forceinline__ void kload2(bf16x8*kf,lds_cptr kp,int j){ kf[2*j]=*(const __attribute__((address_space(3))) bf16x8*)(kp+j*2048); kf[2*j+1]=*(const __attribute__((address_space(3))) bf16x8*)(kp+j*2048+512); }
__device__ __forceinline__ s16x4 vtr(lds_cptr p){ return __builtin_bit_cast(s16x4,__builtin_amdgcn_ds_read_tr16_b64_v4i16((__attribute__((address_space(3))) v4i16_t*)p)); }
__device__ __forceinline__ float rowmax(const f32x16&p0,const f32x16&p1){
  float a=max3f(p0[0],p0[1],p1[0]),b=max3f(p0[2],p0[3],p1[1]);a=max3f(a,p1[2],p1[3]);
  #pragma unroll
  for(int r=4;r<16;r+=4){a=max3f(a,p0[r],p0[r+1]);b=max3f(b,p0[r+2],p0[r+3]);a=max3f(a,p1[r],p1[r+1]);b=max3f(b,p1[r+2],p1[r+3]);}
  const float m=max2f(a,b);
  auto rr=__builtin_amdgcn_permlane32_swap(__float_as_uint(m),__float_as_uint(m),false,false);
  return max2f(__uint_as_float(rr[0]),__uint_as_float(rr[1]));
}
__device__ __forceinline__ void pv(f32x16*o,int vb,bf16x8 pa0,bf16x8 pa1,bf16x8 pa2,bf16x8 pa3){
  #pragma unroll
  for(int d0=0;d0<2;++d0){s16x4 lo[4],hi[4];
    #pragma unroll
    for(int ks=0;ks<4;++ks){
      asm volatile("ds_read_b64_tr_b16 %0,%1 offset:%c2":"=&v"(lo[ks]):"v"(vb),"i"(d0*4096+ks*1024):"memory");
      asm volatile("ds_read_b64_tr_b16 %0,%1 offset:%c2":"=&v"(hi[ks]):"v"(vb),"i"(d0*4096+ks*1024+512):"memory");}
    asm volatile("s_waitcnt lgkmcnt(0)":::"memory");SBAR();
    #define PK(k) (bf16x8){lo[k][0],lo[k][1],lo[k][2],lo[k][3],hi[k][0],hi[k][1],hi[k][2],hi[k][3]}
    o[d0]=__builtin_amdgcn_mfma_f32_32x32x16_bf16(pa0,PK(0),o[d0],0,0,0);
    o[d0]=__builtin_amdgcn_mfma_f32_32x32x16_bf16(pa1,PK(1),o[d0],0,0,0);
    o[d0]=__builtin_amdgcn_mfma_f32_32x32x16_bf16(pa2,PK(2),o[d0],0,0,0);
    o[d0]=__builtin_amdgcn_mfma_f32_32x32x16_bf16(pa3,PK(3),o[d0],0,0,0);
    #undef PK
  }
}

template<int MODE,int THRL> __device__ __forceinline__ void attn_unit(const bf16*Zq,const bf16*__restrict__ Zk,const bf16*__restrict__ Zv,int krow_lat,int krow_ctx,int nlat,int NT,bf16*Oblk,char*shm,float lam,const float*subln,float sub_scale){
  int tid_=threadIdx.x; asm volatile("":"+v"(tid_));
  const int tid=tid_,lane=tid&63,r32=lane&31,hi=lane>>5; const int wid=__builtin_amdgcn_readfirstlane(tid>>6);
  const bf16*Qw=Zq+(long)(wid*QBLK)*ZP;
  const unsigned lds0=(unsigned)(uintptr_t)shm;
  float*wsf=(float*)(shm+LDS_WS)+wid*64;
  const bf16*ksrc=Zk+(long)lane*ZP+wid*8;
  const bf16*vsrc=Zv+(long)(16*(wid&3)+(lane>>2))*ZP+(wid>>2)*32+(lane&3)*8;
  const unsigned kdst=lds0+LDS_K+wid*1024, vdst=lds0+LDS_V+wid*1024;
  #define KROW(t) ((long)(((t)<nlat)?(krow_lat+64*(t)):(krow_ctx+64*((t)-nlat)))*ZP)
  #define DMA_K(t,slot) glds16(ksrc+KROW(t),(unsigned)__builtin_amdgcn_readfirstlane(kdst+(slot)))
  #define DMA_V(t,slot) glds16(vsrc+KROW(t),(unsigned)__builtin_amdgcn_readfirstlane(vdst+(slot)))
  const int vb0=(int)(lds0+LDS_V)+((lane>>4)&1)*32+(lane&3)*8+(4*hi+((lane&15)>>2))*64;
  const char*Kbase=shm+LDS_K; bf16x8 kf[8];
  const lds_cptr shm3=(lds_cptr)shm; const lds_cptr kp0=shm3+LDS_K+hi*1024+r32*16; const lds_cptr vp0=shm3+LDS_V+((lane>>4)&1)*32+(lane&3)*8+(4*hi+((lane&15)>>2))*64;
  float*o1s=(float*)(shm+LDS_OST+wid*8192);
  for(int pass=0;pass<(MODE?2:1);++pass){
  DMA_K(0,0);DMA_V(0,0);DMA_K(1,SLOTB);
  bf16x8 qr[4];
  #pragma unroll
  for(int d0=0;d0<4;++d0)qr[d0]=*reinterpret_cast<const bf16x8*>(&Qw[(long)r32*ZP+d0*16+hi*8]);
  if(MODE==1){ const bf16x8 zz={0,0,0,0,0,0,0,0}; if(pass==0){qr[2]=zz;qr[3]=zz;} else {qr[0]=zz;qr[1]=zz;} }
  float mhat=0.f,l_reg=0.f;f32x16 o[2];o[0]=f32x16{};o[1]=f32x16{};f32x16 negm=f32x16{};asm volatile("":"+v"(negm));
  #define CMASK(P0,P1,t) do{}while(0)
  bool resc=false;
  #define START(P0,P1) do{ const float rm=rowmax(P0,P1); resc=false; \
    { const float dl=rm; mhat=fadd_s(mhat,dl); \
      _Pragma("unroll") for(int r=0;r<16;++r){P0[r]=fsub_s(P0[r],dl);P1[r]=fsub_s(P1[r],dl);} \
      _Pragma("unroll") for(int r=0;r<16;++r)negm[r]=-mhat; asm volatile("":"+v"(negm)); } \
    _Pragma("unroll") for(int r=0;r<16;++r)P0[r]=__builtin_amdgcn_exp2f(P0[r]); }while(0)
  #define RESC() do{ if(resc){ asm volatile("s_waitcnt lgkmcnt(0)":::"memory"); \
      _Pragma("unroll") for(int d_=0;d_<2;++d_) _Pragma("unroll") for(int r=0;r<16;++r)o[d_][r]*=wsf[crow(r,hi)]; } }while(0)
  f32x16 pA0,pA1,pB0,pB1;
  int sl_prev=0,sl_cur=0,sl_next=SLOTB;
  #define ROT() do{sl_prev=sl_cur;sl_cur=sl_next;sl_next=(sl_next==(NSLOT-1)*SLOTB)?0:sl_next+SLOTB;}while(0)
  DMA_K(2,2*SLOTB);
  WAIT_BAR(3);
  qkt(pA0,pA1,Kbase,qr,negm,r32,hi);asm volatile("s_nop 15\n\ts_nop 7":"+v"(pA0),"+v"(pA1));CMASK(pA0,pA1,0);
  START(pA0,pA1);
  _Pragma("unroll") for(int r=0;r<16;++r)pA1[r]=__builtin_amdgcn_exp2f(pA1[r]);
  WAIT_BAR(0);
  DMA_K(3,0);DMA_V(1,SLOTB);
  ROT();
  kload8(kf,kp0+sl_cur);
  WAIT_BAR(2);
  s16x4 vlo[8],vhi[8]; u32x4 pw0,pw1,pw2,pw3;
  #define PKW(P,B) cvtpk_s(P[B],P[B+1])
  #define PAF(k) __builtin_bit_cast(bf16x8,pw##k)
  #define VFR(i) (bf16x8){vlo[i][0],vlo[i][1],vlo[i][2],vlo[i][3],vhi[i][0],vhi[i][1],vhi[i][2],vhi[i][3]}
  #define PIN(x) asm volatile("":"+v"(x))
  #define MX3(a,b,c) __builtin_fmaxf(__builtin_fmaxf((a),(b)),(c))
  #define GAPA(MF,A0,A1,A2,A3,W0,W1,PW) do{ MF; sacc+=A0; sacc+=A1; sacc+=A2; sacc+=A3; PIN(sacc); W0; W1; PIN(PW); SBAR(); }while(0)
  #define EX(v) __builtin_amdgcn_exp2f(v)
  #define GAPB(MF,X,B) do{ MF; X[B]=EX(X[B]); X[B+1]=EX(X[B+1]); X[B+2]=EX(X[B+2]); X[B+3]=EX(X[B+3]); PIN(X); SBAR(); }while(0)
  #define VRD(i) do{ vlo[i]=vtr(vp_+(((i)>>2)*4096+((i)&3)*1024)); vhi[i]=vtr(vp_+(((i)>>2)*4096+((i)&3)*1024+512)); }while(0)
  #define KRD(G,j) do{ if(G){ kload2(kf,kp0+sl_next,j); SBAR(); } }while(0)
  #define STEP(C0,C1,P0,P1,t,GK,GV,GL) do{ SBAR(); \
    const lds_cptr vp_=vp0+sl_prev; \
    VRD(0); SBAR(); float sacc=(P0[0]+P0[1]); \
    GAPA(C0=__builtin_amdgcn_mfma_f32_32x32x16_bf16(kf[0],qr[0],negm,0,0,0), P0[2],P0[3],P0[4],P0[5],     pw0[0]=PKW(P0,0), pw0[1]=PKW(P0,2), pw0); \
    VRD(4); SBAR(); GAPA(C1=__builtin_amdgcn_mfma_f32_32x32x16_bf16(kf[1],qr[0],negm,0,0,0), P0[6],P0[7],P0[8],P0[9],     pw0[2]=PKW(P0,4), pw0[3]=PKW(P0,6), pw0); \
    VRD(1); SBAR(); GAPA(C0=__builtin_amdgcn_mfma_f32_32x32x16_bf16(kf[2],qr[1],C0,0,0,0),   P0[10],P0[11],P0[12],P0[13], pw1[0]=PKW(P0,8), pw1[1]=PKW(P0,10), pw1); \
    VRD(5); SBAR(); GAPA(C1=__builtin_amdgcn_mfma_f32_32x32x16_bf16(kf[3],qr[1],C1,0,0,0),   P0[14],P0[15],P1[0],P1[1],   pw1[2]=PKW(P0,12),pw1[3]=PKW(P0,14), pw1); \
    VRD(2); SBAR(); GAPA(C0=__builtin_amdgcn_mfma_f32_32x32x16_bf16(kf[4],qr[2],C0,0,0,0),   P1[2],P1[3],P1[4],P1[5],     pw2[0]=PKW(P1,0), pw2[1]=PKW(P1,2), pw2); \
    VRD(6); SBAR(); GAPA(C1=__builtin_amdgcn_mfma_f32_32x32x16_bf16(kf[5],qr[2],C1,0,0,0),   P1[6],P1[7],P1[8],P1[9],     pw2[2]=PKW(P1,4), pw2[3]=PKW(P1,6), pw2); \
    VRD(3); SBAR(); GAPA(C0=__builtin_amdgcn_mfma_f32_32x32x16_bf16(kf[6],qr[3],C0,0,0,0),   P1[10],P1[11],P1[12],P1[13], pw3[0]=PKW(P1,8), pw3[1]=PKW(P1,10), pw3); \
    VRD(7); SBAR(); GAPA(C1=__builtin_amdgcn_mfma_f32_32x32x16_bf16(kf[7],qr[3],C1,0,0,0),   P1[14],P1[15],0.f,0.f,       pw3[2]=PKW(P1,12),pw3[3]=PKW(P1,14), pw3); \
    l_reg+=sacc; \
    if(GK){DMA_K((t)+3,sl_cur);} if(GV){DMA_V((t)+1,sl_next);} \
    CMASK(C0,C1,t); \
    { float a=MX3(C0[0],C0[1],C1[0]),b=MX3(C0[2],C0[3],C1[1]); a=MX3(a,C1[2],C1[3]); \
      _Pragma("unroll") for(int r=4;r<16;r+=4){a=MX3(a,C0[r],C0[r+1]);b=MX3(b,C0[r+2],C0[r+3]);a=MX3(a,C1[r],C1[r+1]);b=MX3(b,C1[r+2],C1[r+3]);} \
      float rm=__builtin_fmaxf(a,b); { auto rr=__builtin_amdgcn_permlane32_swap(__float_as_uint(rm),__float_as_uint(rm),false,false); rm=__builtin_fmaxf(__uint_as_float(rr[0]),__uint_as_float(rr[1])); } \
      resc=false; \
      if(__builtin_expect(__any(rm>(float)THRL),0)){ const float dl=__builtin_fmaxf(rm,0.f); mhat+=dl; \
        _Pragma("unroll") for(int r=0;r<16;++r){C0[r]-=dl;C1[r]-=dl;} \
        _Pragma("unroll") for(int r=0;r<16;++r)negm[r]=-mhat; asm volatile("":"+v"(negm)); \
        const float f=__builtin_amdgcn_exp2f(-dl); l_reg*=f; if(hi==0)wsf[r32]=f; resc=true; } } \
    SBAR(); \
    GAPB(o[0]=__builtin_amdgcn_mfma_f32_32x32x16_bf16(PAF(0),VFR(0),o[0],0,0,0), C0,0); \
    GAPB(o[1]=__builtin_amdgcn_mfma_f32_32x32x16_bf16(PAF(0),VFR(4),o[1],0,0,0), C0,4); \
    KRD(GL,0); GAPB(o[0]=__builtin_amdgcn_mfma_f32_32x32x16_bf16(PAF(1),VFR(1),o[0],0,0,0), C0,8); \
    KRD(GL,1); GAPB(o[1]=__builtin_amdgcn_mfma_f32_32x32x16_bf16(PAF(1),VFR(5),o[1],0,0,0), C0,12); \
    KRD(GL,2); GAPB(o[0]=__builtin_amdgcn_mfma_f32_32x32x16_bf16(PAF(2),VFR(2),o[0],0,0,0), C1,0); \
    KRD(GL,3); GAPB(o[1]=__builtin_amdgcn_mfma_f32_32x32x16_bf16(PAF(2),VFR(6),o[1],0,0,0), C1,4); \
    GAPB(o[0]=__builtin_amdgcn_mfma_f32_32x32x16_bf16(PAF(3),VFR(3),o[0],0,0,0), C1,8); \
    GAPB(o[1]=__builtin_amdgcn_mfma_f32_32x32x16_bf16(PAF(3),VFR(7),o[1],0,0,0), C1,12); \
    }while(0)
  int t=1;
  #undef CMASK
  #define CMASK(P0,P1,t) do{}while(0)
  for(;t+5<NT;t+=2){
    STEP(pB0,pB1,pA0,pA1,t,true,true,true);     WAIT_BAR(2); RESC(); ROT();
    STEP(pA0,pA1,pB0,pB1,t+1,true,true,true);   WAIT_BAR(2); RESC(); ROT();
  }
  #undef CMASK
  #define CMASK(P0,P1,t) do{}while(0)
  #define ENDW(tt) do{ if((tt)+3<NT){WAIT_BAR(2);} else if((tt)+2<NT){WAIT_BAR(1);} else {WAIT_BAR(0);} }while(0)
  for(;t+1<NT;t+=2){
    STEP(pB0,pB1,pA0,pA1,t,(t+3<NT),(t+1<NT),(t+1<NT));       ENDW(t);   RESC(); ROT();
    STEP(pA0,pA1,pB0,pB1,t+1,(t+4<NT),(t+2<NT),(t+2<NT));     ENDW(t+1); RESC(); ROT();
  }
  STEP(pB0,pB1,pA0,pA1,NT-1,false,false,false); RESC();
  { float sacc=pB0[0]+pB0[1]; _Pragma("unroll") for(int r=2;r<16;++r)sacc+=pB0[r]; _Pragma("unroll") for(int r=0;r<16;++r)sacc+=pB1[r]; l_reg+=sacc;
    pw0=(u32x4){PKW(pB0,0),PKW(pB0,2),PKW(pB0,4),PKW(pB0,6)};pw1=(u32x4){PKW(pB0,8),PKW(pB0,10),PKW(pB0,12),PKW(pB0,14)};pw2=(u32x4){PKW(pB1,0),PKW(pB1,2),PKW(pB1,4),PKW(pB1,6)};pw3=(u32x4){PKW(pB1,8),PKW(pB1,10),PKW(pB1,12),PKW(pB1,14)};
    SBAR(); pv(o,vb0+sl_cur,PAF(0),PAF(1),PAF(2),PAF(3)); }
  #undef PKW
  #undef PAF
  #undef VFR
  #undef PIN
  #undef MX3
  #undef GAPA
  #undef GAPB
  #undef EX
  #undef VRD
  #undef KRD
  #undef STEP
  #undef ENDW
  {auto rr=__builtin_amdgcn_permlane32_swap(__float_as_uint(l_reg),__float_as_uint(l_reg),false,false);l_reg=__uint_as_float(rr[0])+__uint_as_float(rr[1]);}
  if(hi==0)wsf[32+r32]=l_reg;asm volatile("s_waitcnt lgkmcnt(0)":::"memory");
  float rli[16];
  #pragma unroll
  for(int r=0;r<16;++r)rli[r]=__builtin_amdgcn_rcpf(wsf[32+crow(r,hi)]);
  if(MODE==1&&pass==0){
    #pragma unroll
    for(int d0=0;d0<2;++d0){
      #pragma unroll
      for(int r=0;r<16;++r)o1s[(d0*16+r)*64+lane]=o[d0][r]*rli[r];}
  } else {
    bf16*stg=(bf16*)o1s;
    if(MODE==1){
      float g0=subln[r32]*sub_scale,g1=subln[32+r32]*sub_scale;
      #pragma unroll
      for(int d0=0;d0<2;++d0){
        #pragma unroll
        for(int r=0;r<16;++r)o[d0][r]=o1s[(d0*16+r)*64+lane]-lam*(o[d0][r]*rli[r]);}
      asm volatile("s_waitcnt lgkmcnt(0)":::"memory");
      #pragma unroll
      for(int r=0;r<16;++r){float ss=o[0][r]*o[0][r]+o[1][r]*o[1][r];
        ss+=shx(ss,1,lane);ss+=shx(ss,2,lane);ss+=shx(ss,4,lane);ss+=shx(ss,8,lane);ss+=shx(ss,16,lane);
        const float rn=__builtin_amdgcn_rsqf(ss*(1.0f/64.0f)+1e-6f); const int orow=crow(r,hi);
        stg[orow*64+r32]=__float2bfloat16(o[0][r]*rn*g0); stg[orow*64+32+r32]=__float2bfloat16(o[1][r]*rn*g1);}
    } else {
      #pragma unroll
      for(int r=0;r<16;++r){const int orow=crow(r,hi);
        #pragma unroll
        for(int d0=0;d0<2;++d0)stg[orow*64+d0*32+r32]=__float2bfloat16(o[d0][r]*rli[r]);}
    }
    asm volatile("s_waitcnt lgkmcnt(0)":::"memory");
    bf16*Ow=Oblk+(long)(wid*QBLK)*OP;
    #pragma unroll
    for(int i=0;i<4;++i){const int row=i*8+(lane>>3),ch=lane&7; const u32x4 v=*(const u32x4*)(stg+row*64+ch*8); ATTN_STORE16(Ow+(long)row*OP+ch*8,v);}
  }
  asm volatile("s_waitcnt lgkmcnt(0)\n\ts_barrier":::"memory");
  }
  #undef KROW
  #undef DMA_K
  #undef DMA_V
  #undef CMASK
  #undef START
  #undef RESC
  #undef ROT
}
template<int THRL> __device__ __forceinline__ void diff_unit(const bf16*Zq,const bf16*__restrict__ Zk,const bf16*__restrict__ Zv,int krow_lat,int krow_ctx,int nlat,int NT,bf16*Oblk,char*shm,float lam,const float*subln,float sub_scale){
  int tid_=threadIdx.x; asm volatile("":"+v"(tid_));
  const int tid=tid_,lane=tid&63,r32=lane&31,hi=lane>>5; const int wid=__builtin_amdgcn_readfirstlane(tid>>6);
  const bf16*Qw=Zq+(long)(wid*QBLK)*ZP;
  const unsigned lds0=(unsigned)(uintptr_t)shm;
  float*wsf=(float*)(shm+LDS_WS)+wid*64;
  const bf16*ksrc=Zk+(long)lane*ZP+wid*8;
  const bf16*vsrc=Zv+(long)(16*(wid&3)+(lane>>2))*ZP+(wid>>2)*32+(lane&3)*8;
  const unsigned kdst=lds0+LDS_K+wid*1024, vdst=lds0+LDS_V+wid*1024;
  #define KROW(t) ((long)(((t)<nlat)?(krow_lat+64*(t)):(krow_ctx+64*((t)-nlat)))*ZP)
  #define DMA_K(t,slot) glds16(ksrc+KROW(t),(unsigned)__builtin_amdgcn_readfirstlane(kdst+(slot)))
  #define DMA_V(t,slot) glds16(vsrc+KROW(t),(unsigned)__builtin_amdgcn_readfirstlane(vdst+(slot)))
  const int vb0=(int)(lds0+LDS_V)+((lane>>4)&1)*32+(lane&3)*8+(4*hi+((lane&15)>>2))*64;
  const char*kb0=shm+LDS_K+hi*1024+r32*16;
  bf16x8 qr[4];
  #pragma unroll
  for(int d0=0;d0<4;++d0)qr[d0]=*reinterpret_cast<const bf16x8*>(&Qw[(long)r32*ZP+d0*16+hi*8]);
  asm volatile("":"+v"(qr[0]),"+v"(qr[1]),"+v"(qr[2]),"+v"(qr[3]));
  DMA_K(0,0);DMA_V(0,0);DMA_K(1,SLOTB);DMA_V(1,SLOTB);
  f32x16 o1[2],o2[2]; o1[0]=f32x16{};o1[1]=f32x16{};o2[0]=f32x16{};o2[1]=f32x16{};
  f32x16 negm1=f32x16{},negm2=f32x16{}; asm volatile("":"+v"(negm1),"+v"(negm2));
  float mh1=0.f,mh2=0.f,l1=0.f,l2=0.f;
  int sl=0,sl2=2*SLOTB;
  #define PKW(P,B) cvtpk_s(P[B],P[B+1])
  #define SOFTMAX(SA,SB,NEGM,MH,LS,WOFF,RESCF,PW0,PW1,PW2,PW3) do{ \
    float a_=__builtin_fmaxf(__builtin_fmaxf(SA[0],SA[1]),SB[0]),b_=__builtin_fmaxf(__builtin_fmaxf(SA[2],SA[3]),SB[1]); a_=__builtin_fmaxf(__builtin_fmaxf(a_,SB[2]),SB[3]); \
    _Pragma("unroll") for(int r=4;r<16;r+=4){a_=__builtin_fmaxf(__builtin_fmaxf(a_,SA[r]),SA[r+1]);b_=__builtin_fmaxf(__builtin_fmaxf(b_,SA[r+2]),SA[r+3]);a_=__builtin_fmaxf(__builtin_fmaxf(a_,SB[r]),SB[r+1]);b_=__builtin_fmaxf(__builtin_fmaxf(b_,SB[r+2]),SB[r+3]);} \
    float rm_=__builtin_fmaxf(a_,b_); { auto rr_=__builtin_amdgcn_permlane32_swap(__float_as_uint(rm_),__float_as_uint(rm_),false,false); rm_=__builtin_fmaxf(__uint_as_float(rr_[0]),__uint_as_float(rr_[1])); } \
    RESCF=false; \
    if(t==0||__any(rm_>(float)THRL)){ const float dl_=(t==0)?rm_:__builtin_fmaxf(rm_,0.f); MH+=dl_; \
      _Pragma("unroll") for(int r=0;r<16;++r){SA[r]-=dl_;SB[r]-=dl_;} \
      _Pragma("unroll") for(int r=0;r<16;++r)NEGM[r]=-MH; asm volatile("":"+v"(NEGM)); \
      const float f_=__builtin_amdgcn_exp2f(-dl_); LS*=f_; if(hi==0)wsf[(WOFF)+r32]=f_; RESCF=(t!=0); } \
    _Pragma("unroll") for(int r=0;r<16;++r){SA[r]=__builtin_amdgcn_exp2f(SA[r]);SB[r]=__builtin_amdgcn_exp2f(SB[r]);} \
    { float s0_=SA[0]+SA[1],s1_=SB[0]+SB[1]; _Pragma("unroll") for(int r=2;r<16;r+=2){s0_+=SA[r]+SA[r+1];s1_+=SB[r]+SB[r+1];} LS+=s0_+s1_; } \
    PW0=(u32x4){PKW(SA,0),PKW(SA,2),PKW(SA,4),PKW(SA,6)};PW1=(u32x4){PKW(SA,8),PKW(SA,10),PKW(SA,12),PKW(SA,14)};PW2=(u32x4){PKW(SB,0),PKW(SB,2),PKW(SB,4),PKW(SB,6)};PW3=(u32x4){PKW(SB,8),PKW(SB,10),PKW(SB,12),PKW(SB,14)}; \
  }while(0)
  for(int t=0;t<NT;++t){
    if(t+1<NT){WAIT_BAR(2);}else{WAIT_BAR(0);}
    if(t+2<NT){DMA_K(t+2,sl2);DMA_V(t+2,sl2);}
    const char*kb=kb0+sl;
    f32x16 s1a,s1b,s2a,s2b;
    { const bf16x8 a0=*reinterpret_cast<const bf16x8*>(kb),b0=*reinterpret_cast<const bf16x8*>(kb+512),a1=*reinterpret_cast<const bf16x8*>(kb+2048),b1=*reinterpret_cast<const bf16x8*>(kb+2048+512);
      s1a=__builtin_amdgcn_mfma_f32_32x32x16_bf16(a0,qr[0],negm1,0,0,0); s1b=__builtin_amdgcn_mfma_f32_32x32x16_bf16(b0,qr[0],negm1,0,0,0);
      s1a=__builtin_amdgcn_mfma_f32_32x32x16_bf16(a1,qr[1],s1a,0,0,0);   s1b=__builtin_amdgcn_mfma_f32_32x32x16_bf16(b1,qr[1],s1b,0,0,0); }
    { const bf16x8 a0=*reinterpret_cast<const bf16x8*>(kb+4096),b0=*reinterpret_cast<const bf16x8*>(kb+4096+512),a1=*reinterpret_cast<const bf16x8*>(kb+6144),b1=*reinterpret_cast<const bf16x8*>(kb+6144+512);
      s2a=__builtin_amdgcn_mfma_f32_32x32x16_bf16(a0,qr[2],negm2,0,0,0); s2b=__builtin_amdgcn_mfma_f32_32x32x16_bf16(b0,qr[2],negm2,0,0,0);
      s2a=__builtin_amdgcn_mfma_f32_32x32x16_bf16(a1,qr[3],s2a,0,0,0);   s2b=__builtin_amdgcn_mfma_f32_32x32x16_bf16(b1,qr[3],s2b,0,0,0); }
    bool rs1,rs2; u32x4 p10,p11,p12,p13,p20,p21,p22,p23;
    SOFTMAX(s1a,s1b,negm1,mh1,l1,0,rs1,p10,p11,p12,p13);
    SOFTMAX(s2a,s2b,negm2,mh2,l2,32,rs2,p20,p21,p22,p23);
    if(rs1||rs2){ asm volatile("s_waitcnt lgkmcnt(0)":::"memory");
      if(rs1){ _Pragma("unroll") for(int d_=0;d_<2;++d_) _Pragma("unroll") for(int r=0;r<16;++r)o1[d_][r]*=wsf[crow(r,hi)]; }
      if(rs2){ _Pragma("unroll") for(int d_=0;d_<2;++d_) _Pragma("unroll") for(int r=0;r<16;++r)o2[d_][r]*=wsf[32+crow(r,hi)]; } }
    { const int vb=vb0+sl;
      #pragma unroll
      for(int d0=0;d0<2;++d0){ s16x4 lo[4],hv[4];
        #pragma unroll
        for(int ks=0;ks<4;++ks){
          asm volatile("ds_read_b64_tr_b16 %0,%1 offset:%c2":"=&v"(lo[ks]):"v"(vb),"i"(d0*4096+ks*1024):"memory");
          asm volatile("ds_read_b64_tr_b16 %0,%1 offset:%c2":"=&v"(hv[ks]):"v"(vb),"i"(d0*4096+ks*1024+512):"memory");}
        asm volatile("s_waitcnt lgkmcnt(0)":::"memory");SBAR();
        #define PK(k) (bf16x8){lo[k][0],lo[k][1],lo[k][2],lo[k][3],hv[k][0],hv[k][1],hv[k][2],hv[k][3]}
        o1[d0]=__builtin_amdgcn_mfma_f32_32x32x16_bf16(__builtin_bit_cast(bf16x8,p10),PK(0),o1[d0],0,0,0);
        o2[d0]=__builtin_amdgcn_mfma_f32_32x32x16_bf16(__builtin_bit_cast(bf16x8,p20),PK(0),o2[d0],0,0,0);
        o1[d0]=__builtin_amdgcn_mfma_f32_32x32x16_bf16(__builtin_bit_cast(bf16x8,p11),PK(1),o1[d0],0,0,0);
        o2[d0]=__builtin_amdgcn_mfma_f32_32x32x16_bf16(__builtin_bit_cast(bf16x8,p21),PK(1),o2[d0],0,0,0);
        o1[d0]=__builtin_amdgcn_mfma_f32_32x32x16_bf16(__builtin_bit_cast(bf16x8,p12),PK(2),o1[d0],0,0,0);
        o2[d0]=__builtin_amdgcn_mfma_f32_32x32x16_bf16(__builtin_bit_cast(bf16x8,p22),PK(2),o2[d0],0,0,0);
        o1[d0]=__builtin_amdgcn_mfma_f32_32x32x16_bf16(__builtin_bit_cast(bf16x8,p13),PK(3),o1[d0],0,0,0);
        o2[d0]=__builtin_amdgcn_mfma_f32_32x32x16_bf16(__builtin_bit_cast(bf16x8,p23),PK(3),o2[d0],0,0,0);
        #undef PK
      } }
    sl2=sl; sl=(sl==(NSLOT-1)*SLOTB)?0:sl+SLOTB;
  }
  #undef SOFTMAX
  #undef PKW
  {auto rr=__builtin_amdgcn_permlane32_swap(__float_as_uint(l1),__float_as_uint(l1),false,false);l1=__uint_as_float(rr[0])+__uint_as_float(rr[1]);}
  {auto rr=__builtin_amdgcn_permlane32_swap(__float_as_uint(l2),__float_as_uint(l2),false,false);l2=__uint_as_float(rr[0])+__uint_as_float(rr[1]);}
  if(hi==0){wsf[r32]=l1;wsf[32+r32]=l2;} asm volatile("s_waitcnt lgkmcnt(0)":::"memory");
  bf16*stg=(bf16*)(shm+LDS_OST+wid*8192);
  { const float g0=subln[r32]*sub_scale,g1=subln[32+r32]*sub_scale;
    #pragma unroll
    for(int r=0;r<16;++r){ const int orow=crow(r,hi); const float i1=__builtin_amdgcn_rcpf(wsf[orow]),i2=lam*__builtin_amdgcn_rcpf(wsf[32+orow]);
      const float v0=o1[0][r]*i1-o2[0][r]*i2,v1=o1[1][r]*i1-o2[1][r]*i2; float ss=v0*v0+v1*v1;
      ss+=shx(ss,1,lane);ss+=shx(ss,2,lane);ss+=shx(ss,4,lane);ss+=shx(ss,8,lane);ss+=shx(ss,16,lane);
      const float rn=__builtin_amdgcn_rsqf(ss*(1.0f/64.0f)+1e-6f);
      stg[orow*64+r32]=__float2bfloat16(v0*rn*g0); stg[orow*64+32+r32]=__float2bfloat16(v1*rn*g1);} }
  asm volatile("s_waitcnt lgkmcnt(0)":::"memory");
  bf16*Ow=Oblk+(long)(wid*QBLK)*OP;
  #pragma unroll
  for(int i=0;i<4;++i){const int row=i*8+(lane>>3),ch=lane&7; const u32x4 v=*(const u32x4*)(stg+row*64+ch*8); ATTN_STORE16(Ow+(long)row*OP+ch*8,v);}
  asm volatile("s_waitcnt lgkmcnt(0)\n\ts_barrier":::"memory");
  #undef KROW
  #undef DMA_K
  #undef DMA_V
}
#undef SBAR
#undef WAIT_BAR
}
namespace hy {
#define HY_LAS __attribute__((address_space(3)))
typedef short bf16x8 __attribute__((ext_vector_type(8)));
typedef short bf16x4 __attribute__((ext_vector_type(4)));
typedef float f32x4 __attribute__((ext_vector_type(4)));
typedef unsigned u32x4 __attribute__((ext_vector_type(4)));
typedef unsigned u32x2 __attribute__((ext_vector_type(2)));
__device__ __forceinline__ float bf2f(unsigned short h) { return __uint_as_float((unsigned)h << 16); }
__device__ __forceinline__ unsigned pk2(float lo, float hi) { unsigned r; asm volatile("v_cvt_pk_bf16_f32 %0, %1, %2" : "=v"(r) : "v"(lo), "v"(hi)); return r; }

template <int NP, int NBLK>
__device__ __forceinline__ void conv_unit(HY_LAS unsigned char* lds, const unsigned short* __restrict__ Rg, const unsigned short* __restrict__ vvT, const unsigned short* __restrict__ x0T, unsigned short* __restrict__ yT, float skip) {
    constexpr int L = 64 * NBLK, VBYTES = 16 * L, CSB = 4 * L + 64, NWORDS = L / 2 + 1, RC = VBYTES;
    int tid_ = threadIdx.x; asm volatile("" : "+v"(tid_));
    const int tid = tid_, lane = tid & 63, wid = __builtin_amdgcn_readfirstlane(tid >> 6);
    for (int g = tid; g < L; g += 512) *(HY_LAS u32x4*)(lds + g * 16) = *(const u32x4*)(vvT + (size_t)g * 8);
    const unsigned long long* G = (const unsigned long long*)Rg;
#pragma unroll
    for (int s = 0; s < 4; ++s)
        for (int w = tid; w < NWORDS; w += 512) {
            unsigned long long lo = G[w >= 1 ? w - 1 : 0], hi = G[w < L / 2 ? w : L / 2 - 1];
            lo = (w >= 1) ? lo : 0ull; hi = (w < L / 2) ? hi : 0ull;
            const unsigned long long v = (s == 0) ? hi : ((hi << (16 * s)) | (lo >> (64 - 16 * s)));
            *(HY_LAS unsigned long long*)(lds + RC + s * CSB + w * 8) = v;
        }
    __syncthreads();
    const int fr = lane & 15, fq = lane >> 4, sh = fr & 3, ql = fr >> 3, bb = fr & 7;
    if (wid < NBLK / (2 * NP)) {
        f32x4 acc[NP][4];
#pragma unroll
        for (int p = 0; p < NP; ++p)
#pragma unroll
            for (int ic = 0; ic < 4; ++ic) acc[p][ic] = (f32x4){0.f, 0.f, 0.f, 0.f};
        const int tb0 = 2 * NP * wid;
        const int abase = RC + sh * CSB + 2 * (L - fr + 8 * fq + sh) - 96;
        for (int d = tb0 - (NBLK - 1); d <= tb0 + 2 * NP - 1; ++d) {
            bf16x8 A[4][2];
            const int ad = abase - 128 * d;
#pragma unroll
            for (int ic = 0; ic < 4; ++ic)
#pragma unroll
                for (int kc = 0; kc < 2; ++kc) {
                    const bf16x4 lo = *(const HY_LAS bf16x4*)(lds + ad + 2 * (48 - 16 * ic + 32 * kc));
                    const bf16x4 hi = *(const HY_LAS bf16x4*)(lds + ad + 2 * (48 - 16 * ic + 32 * kc) + 8);
                    A[ic][kc] = (bf16x8){lo[0], lo[1], lo[2], lo[3], hi[0], hi[1], hi[2], hi[3]};
                }
#pragma unroll
            for (int p = 0; p < NP; ++p) {
                const int sb0 = tb0 + 2 * p - d, sb1 = sb0 + 1;
                const bool v0 = (sb0 >= 0) && (sb0 < NBLK), v1 = (sb1 >= 0) && (sb1 < NBLK);
                if (!(v0 || v1)) continue;
                const int sbl = ql ? sb1 : sb0; const bool vl = ql ? v1 : v0;
                const int sbc = sbl < 0 ? 0 : (sbl >= NBLK ? NBLK - 1 : sbl);
                bf16x8 B[2];
#pragma unroll
                for (int kc = 0; kc < 2; ++kc) {
                    bf16x8 t = *(const HY_LAS bf16x8*)(lds + ((8 * sbc + 4 * kc + fq) * 8 + bb) * 16);
                    if (!vl) t = (bf16x8){0, 0, 0, 0, 0, 0, 0, 0};
                    B[kc] = t;
                }
#pragma unroll
                for (int ic = 0; ic < 4; ++ic)
#pragma unroll
                    for (int kc = 0; kc < 2; ++kc) acc[p][ic] = __builtin_amdgcn_mfma_f32_16x16x32_bf16(A[ic][kc], B[kc], acc[p][ic], 0, 0, 0);
            }
        }
#pragma unroll
        for (int p = 0; p < NP; ++p)
#pragma unroll
            for (int ic = 0; ic < 4; ++ic) {
                const int tb = tb0 + 2 * p + ql;
                const int gofs = ((8 * tb + 2 * ic + (fq >> 1)) * 8 + bb) * 16 + 8 * (fq & 1);
                const bf16x4 vv = *(const HY_LAS bf16x4*)(lds + gofs);
                const u32x2 xx = *(const u32x2*)((const unsigned char*)x0T + gofs);
                float o[4];
#pragma unroll
                for (int r = 0; r < 4; ++r) {
                    const float x0 = __uint_as_float(((r & 1) ? (xx[r >> 1] & 0xffff0000u) : (xx[r >> 1] << 16)));
                    o[r] = (acc[p][ic][r] + bf2f((unsigned short)vv[r]) * skip) * x0;
                }
                u32x2 w; w.x = pk2(o[0], o[1]); w.y = pk2(o[2], o[3]);
                *(u32x2*)((unsigned char*)yT + gofs) = w;
            }
    }
    __syncthreads();
}
#undef HY_LAS
}
constexpr int DM = 1024, NBATCH = 8, SEQL = 4096, NCTX = 256, DEPTH = 4;
constexpr int ML = NBATCH * SEQL, MC = NBATCH * NCTX, MT = ML + MC;
constexpr int ZP = 2304, DFF = 2816, DFE = 3584, NEXP = 8;
constexpr int MOE_TILES = 280, MOE_ROWS = MOE_TILES * 256;
constexpr float NORM_EPS = 1e-6f;
constexpr int NWAVES = 8;
constexpr size_t MiB = 1u << 20;
constexpr size_t WS_CTL = 0, CTL_ZERO_BYTES = 2 * MiB;
constexpr size_t WS_MODS = 1 * MiB;
constexpr size_t WS_ROPE = 2 * MiB;
constexpr size_t WS_ROUTE = 22 * MiB;
constexpr size_t WS_FILT = 4 * MiB;
constexpr size_t WS_FILTC = 21 * MiB;
constexpr size_t WS_WIN = 24 * MiB, WS_WOUT = 42 * MiB, WS_WGU = 50 * MiB, WS_WD = 72 * MiB, WS_MWGU = 83 * MiB, WS_MWD = 195 * MiB;
constexpr size_t WS_HC = 251 * MiB, WS_U = 259 * MiB;
constexpr size_t WS_R = 327 * MiB;
constexpr size_t WS_Z = WS_R, WS_MIX = WS_R + 153 * MiB, WS_VVT = WS_MIX + 68 * MiB, WS_X0T = WS_VVT + 17 * MiB, WS_YT = WS_X0T + 17 * MiB;
#ifndef DENSE_F8_MASK
#define DENSE_F8_MASK 2
#endif
constexpr size_t WS_AS8 = WS_R  , WS_AS = WS_R, WS_HID = WS_R + 140 * MiB, WS_HB = WS_HID + 490 * MiB, WS_END = WS_HB + 64 * MiB;
static_assert(WS_YT + 17 * MiB <= WS_HB && (size_t)MT * ZP * 2 <= 153 * MiB && (size_t)MOE_ROWS * DM * 2 <= 140 * MiB && (size_t)MOE_ROWS * DFE * 2 <= 490 * MiB, "ws map");
constexpr int CW_TMO = 0;
constexpr int CW_BAR = 4096;
constexpr int CW_QMIX = 16384;
constexpr int CW_CNT = 9216;
constexpr int RING_BYTES = 139264;
constexpr int LDSCTL_OFF = RING_BYTES, MISC_OFF = LDSCTL_OFF + 320;
constexpr int ROPE_LDS_OFF = RING_BYTES + 1024, LDS_BYTES = ROPE_LDS_OFF + 12288;
constexpr int NPL = 11, NPHASES = 1 + DEPTH * NPL + 1;
enum { PH_NORM1 = 0, PH_WIN, PH_HYPRE, PH_MIX, PH_HYPOST, PH_WOUT, PH_NORM2, PH_GATHER, PH_UP, PH_DOWN, PH_COMBINE };
#define GAS __attribute__((address_space(1)))
#define LAS __attribute__((address_space(3)))
typedef unsigned short bf16;
typedef unsigned v4u __attribute__((ext_vector_type(4)));
typedef float f32x4 __attribute__((ext_vector_type(4)));
typedef short bf16x8 __attribute__((ext_vector_type(8)));
typedef GAS unsigned gu32;
typedef GAS unsigned long long gu64;
#define RLX_AGENT __ATOMIC_RELAXED, __HIP_MEMORY_SCOPE_AGENT
#define LDS_WAIT() asm volatile("s_waitcnt lgkmcnt(0)" ::: "memory")
#define VM_WAIT() asm volatile("s_waitcnt vmcnt(0)" ::: "memory")
__device__ __forceinline__ unsigned long long rt() { return __builtin_amdgcn_s_memrealtime(); }
__device__ __forceinline__ unsigned f2bf(float f) { unsigned u = __builtin_bit_cast(unsigned, f); return (u + 0x7fffu + ((u >> 16) & 1u)) >> 16; }
__device__ __forceinline__ unsigned pk2(float lo, float hi) { return f2bf(lo) | (f2bf(hi) << 16); }

#define XB_TMO      128
#define XB_XCNT(j)  (256  + 64 * (j))
#define XB_XSUB(j)  (1280 + 64 * (j))
#define XB_XGEN(j)  (2304 + 64 * (j))
#define XB_TOP      3328
#define XB_TOPGEN   3392
#define XCD_BAR_WORDS 3456
#define XB_SPIN_CAP (1u << 18)

__device__ __forceinline__ unsigned xb_ld(unsigned* p)              { return __hip_atomic_load(p, __ATOMIC_RELAXED, __HIP_MEMORY_SCOPE_AGENT); }
__device__ __forceinline__ unsigned xb_add(unsigned* p, unsigned v) { return __hip_atomic_fetch_add(p, v, __ATOMIC_RELAXED, __HIP_MEMORY_SCOPE_AGENT); }
__device__ __forceinline__ unsigned xb_xcc_id() { return (unsigned)__builtin_amdgcn_s_getreg((3 << 11) | 20) & 0xFu; }
#define XB_SPIN(cond, bar) do { unsigned _sp = 0; while (cond) { __builtin_amdgcn_s_sleep(1); \
    if ((++_sp & 255u) == 0u) { if (xb_ld(&(bar)[XB_TMO])) break; if (_sp > XB_SPIN_CAP) { atomicAdd(&(bar)[XB_TMO], 1u); break; } } } } while (0)

struct XcdBarrier {
    unsigned* bar; unsigned x;
    volatile LAS unsigned* st;
};

__device__ __forceinline__ XcdBarrier xcd_barrier_post(unsigned* bar, volatile LAS unsigned* st) {
    XcdBarrier b; b.bar = bar; b.x = xb_xcc_id(); b.st = st;
    if (threadIdx.x == 0) (void)xb_add(&bar[XB_XCNT(b.x)], 1u);
    return b;
}
__device__ __forceinline__ void xcd_barrier_complete(unsigned* bar, unsigned x, unsigned& nloc, unsigned& nx) {
    const unsigned G = gridDim.x * gridDim.y * gridDim.z;
    unsigned sum, cnt, mine, sp = 0u;
    for (;;) {
        sum = 0u; cnt = 0u; mine = 0u;
#pragma unroll
        for (unsigned j = 0; j < 16; ++j) { const unsigned c = xb_ld(&bar[XB_XCNT(j)]); sum += c; cnt += (c > 0u) ? 1u : 0u; mine = (j == x) ? c : mine; }
        if (sum == G) break;
        __builtin_amdgcn_s_sleep(1);
        if ((++sp & 255u) == 0u) { if (xb_ld(&bar[XB_TMO])) break; if (sp > XB_SPIN_CAP) { atomicAdd(&bar[XB_TMO], 1u); break; } }
    }
    nloc = mine > 0u ? mine : 1u; nx = cnt > 0u ? cnt : 1u;
}

__device__ __forceinline__ void xcd_barrier(const XcdBarrier& b) {
    asm volatile("s_waitcnt vmcnt(0)" ::: "memory");
    __syncthreads();
    if (threadIdx.x == 0) {
        unsigned* bar = b.bar;
        __builtin_amdgcn_s_waitcnt(0);
        unsigned nloc = b.st[0], nx = b.st[1];
        if (nloc == 0u) { xcd_barrier_complete(bar, b.x, nloc, nx); b.st[0] = nloc; b.st[1] = nx; }
        const unsigned old = xb_add(&bar[XB_XSUB(b.x)], 1u);
        const unsigned gen = old / nloc;
        if (old + 1u == (gen + 1u) * nloc) {
            __builtin_amdgcn_fence(__ATOMIC_RELEASE, "agent");
            asm volatile("s_waitcnt vmcnt(0)" ::: "memory");
            const unsigned og = xb_add(&bar[XB_TOP], 1u);
            const unsigned tg = og / nx;
            if (og + 1u == (tg + 1u) * nx) {
#pragma unroll
                for (unsigned j = 0; j < 16; ++j) (void)__hip_atomic_fetch_add(&bar[XB_XGEN(j)], 1u, __ATOMIC_RELAXED, __HIP_MEMORY_SCOPE_AGENT);
            }
        }
        XB_SPIN(xb_ld(&bar[XB_XGEN(b.x)]) == gen, bar);
        __builtin_amdgcn_fence(__ATOMIC_ACQUIRE, "agent");
        asm volatile("s_waitcnt vmcnt(0)" ::: "memory");
    }
    __syncthreads();
}
typedef float f32x2 __attribute__((ext_vector_type(2)));
typedef unsigned v2u __attribute__((ext_vector_type(2)));
__device__ __forceinline__ float bf2f(unsigned short h) { return __uint_as_float((unsigned)h << 16); }
__device__ __forceinline__ float bflo(unsigned w) { return __uint_as_float(w << 16); }
__device__ __forceinline__ float bfhi(unsigned w) { return __uint_as_float(w & 0xffff0000u); }
__device__ __forceinline__ float wave_sum(float v) {
    int ln = (int)__builtin_amdgcn_mbcnt_hi(~0u, __builtin_amdgcn_mbcnt_lo(~0u, 0u)); asm volatile("" : "+v"(ln));
#pragma unroll
    for (int o = 1; o < 64; o <<= 1) v += shx(v, o, ln);
    return v;
}
__device__ __forceinline__ float cos_rev(float r) { r = r - floorf(r); return __builtin_amdgcn_cosf(r); }
__device__ __forceinline__ float sin_rev(float r) { r = r - floorf(r); return __builtin_amdgcn_sinf(r); }
__device__ __forceinline__ float sin_rad(float x) { return sin_rev(x * 0.15915494309189535f); }
__device__ __forceinline__ const void* karg_ptr(int i) {
    const unsigned long long __attribute__((address_space(4)))* kp = (const unsigned long long __attribute__((address_space(4)))*)__builtin_amdgcn_kernarg_segment_ptr();
    asm volatile("" : "+s"(kp));
    return (const void*)(const __attribute__((address_space(1))) void*)kp[i];
}
#define KARG(i) ((const float*)karg_ptr(i))
#define KOUT() ((float*)karg_ptr(34))
#define KWS() ((unsigned char*)karg_ptr(35))
#define FRESH_TID() int tid_ = threadIdx.x; asm volatile("" : "+v"(tid_)); const int tid = tid_, lane = tid & 63; (void)lane
struct Frame {
    LAS unsigned char* lds; volatile LAS unsigned* MISC; gu32* ctl;
    int wave, vcu, G;
};

struct RmId { __device__ __forceinline__ int operator()(int n) const { return n; } };
struct RmGate { int off; __device__ __forceinline__ int operator()(int n) const { return ((n >> 7) << 8) + (n & 127) + off; } };
struct RmWin { __device__ __forceinline__ int operator()(int n) const {
    const int pn = n >> 8, c = n & 255; int p;
    if (pn == 3 || pn == 4) p = 128 * ((c >> 4) & 1) + 32 * (c >> 6) + 16 * ((c >> 5) & 1) + (c & 15);
    else if (pn >= 6) p = 128 * ((c >> 5) & 1) + 32 * (c >> 6) + (c & 31);
    else p = c;
    return (pn << 8) + p; } };
template <class RM>
__device__ __forceinline__ void transpose_item(const float* __restrict__ W, int K, int N, bf16* WT, LAS float* scr, int item, int lane, RM rm) {
    const int nblk = N / 32, kb = item / nblk, nb = item % nblk, k0 = 64 * kb, n0 = 32 * nb;
    float wv[32];
#pragma unroll
    for (int i = 0; i < 32; ++i) wv[i] = W[(size_t)(k0 + 2 * i + (lane >> 5)) * N + n0 + (lane & 31)];
#pragma unroll
    for (int i = 0; i < 32; ++i) scr[(2 * i + (lane >> 5)) * 33 + (lane & 31)] = wv[i];
    LDS_WAIT(); asm volatile("" ::: "memory");
    const int c = lane & 7;
#pragma unroll
    for (int j = 0; j < 4; ++j) { const int n = (lane >> 3) + 8 * j; const LAS float* s = scr + (8 * c) * 33 + n;
        v4u o; o.x = pk2(s[0 * 33], s[1 * 33]); o.y = pk2(s[2 * 33], s[3 * 33]); o.z = pk2(s[4 * 33], s[5 * 33]); o.w = pk2(s[6 * 33], s[7 * 33]);
        *(GAS v4u*)(WT + (size_t)rm(n0 + n) * K + k0 + 8 * c) = o; }
    LDS_WAIT(); asm volatile("" ::: "memory");
}
template <class RM>
__device__ __forceinline__ void transpose_item8(const float* __restrict__ W, int K, int N, unsigned char* WT, LAS float* scr, int item, int lane, RM rm, float scale) {
    const int nblk = N / 32, kb = item / nblk, nb = item % nblk, k0 = 64 * kb, n0 = 32 * nb;
    float wv[32];
#pragma unroll
    for (int i = 0; i < 32; ++i) wv[i] = W[(size_t)(k0 + 2 * i + (lane >> 5)) * N + n0 + (lane & 31)];
#pragma unroll
    for (int i = 0; i < 32; ++i) scr[(2 * i + (lane >> 5)) * 33 + (lane & 31)] = wv[i] * scale;
    LDS_WAIT(); asm volatile("" ::: "memory");
    const int c = lane & 7;
#pragma unroll
    for (int j = 0; j < 4; ++j) { const int n = (lane >> 3) + 8 * j; const LAS float* s = scr + (8 * c) * 33 + n;
        v2u o; o.x = pg8::pk_fp8x4(s[0 * 33], s[1 * 33], s[2 * 33], s[3 * 33]); o.y = pg8::pk_fp8x4(s[4 * 33], s[5 * 33], s[6 * 33], s[7 * 33]);
        *(GAS v2u*)(WT + (size_t)rm(n0 + n) * K + k0 + 8 * c) = o; }
    LDS_WAIT(); asm volatile("" ::: "memory");
}

struct Ptrs {
    const float* in[34]; float* out; unsigned char* ws;
};
enum { I_X = 0, I_C, I_CTX, I_CCTX, I_WADA, I_BADA, I_GMIX, I_GFFN, I_WIN, I_WOUT, I_HCW, I_HCB, I_HW1, I_HB1, I_HW2, I_HB2, I_HW3, I_HFREQ, I_HSKIP,
       I_LQ1, I_LK1, I_LQ2, I_LK2, I_SUBLN, I_QNORM, I_KNORM, I_FWG, I_FWU, I_FWD, I_ROUTER, I_MWG, I_MWU, I_MWD, I_GFINAL };

#ifdef PROBE_P0
#define g_p0acc (*p0acc_)
__device__ __forceinline__ void p0_prologue(Frame& F, unsigned long long* p0acc_) {
#else
__device__ __forceinline__ void p0_prologue(Frame& F) {
#endif
    FRESH_TID();
    unsigned char* ws = KWS();
    LAS float* scr = (LAS float*)(F.lds + F.wave * 8704);
    constexpr int NT_B = 96, NT_A = 1888, NT_TOT = 272 + NT_B + NT_A;
    LAS float* sct = (LAS float*)(F.lds + 90112);
    for (int i = tid; i < 9 * 1024; i += NWAVES * 64) { const int mi = i >> 10, k = i & 1023; const float c = mi < 8 ? KARG(I_C)[mi * 1024 + k] : KARG(I_CCTX)[k];
        sct[k * 12 + mi] = c / (1.0f + __expf(-c)); }
    gu32* qh = F.ctl + 12288;
#ifdef PROBE_P0
    unsigned long long tprev0_ = 0ull; int typrev_ = -1;
#endif
    for (;;) {
#ifdef PROBE_P0
        if (typrev_ == PROBE_P0) g_p0acc += rt() - tprev0_;
#endif
        if (tid == 0) F.MISC[2] = __hip_atomic_fetch_add(qh, 1u, RLX_AGENT);
        __syncthreads();
        const int t = (int)F.MISC[2];
        __syncthreads();
        if (t >= NT_TOT) break;
#ifdef PROBE_P0
        tprev0_ = rt(); typrev_ = t < 272 ? 0 : (t < 272 + NT_B ? 1 : 2);
#endif
        if (t < 272) { int tq_ = tid; asm volatile("" : "+v"(tq_)); const int tid = tq_, lane = tid & 63; (void)lane;
        {
        LAS unsigned short* tile = (LAS unsigned short*)(F.lds + 16896);
        { const int it = t;
            const int l = it / 68, r = it % 68; const bool ctx = r >= 64; const int L = ctx ? 256 : 4096, t0 = 64 * (ctx ? r - 64 : r);
            const float* w1 = KARG(I_HW1) + l * 33 * 64; const float* b1 = KARG(I_HB1) + l * 64; const float* w2 = KARG(I_HW2) + l * 4096; const float* b2 = KARG(I_HB2) + l * 64;
            const float* w3 = KARG(I_HW3) + l * 64 * 512; const float fr_ = KARG(I_HFREQ)[l * 64 + lane];
            float a2r[8];
#pragma unroll
            for (int i = 0; i < 8; ++i) {
                const int t = t0 + F.wave * 8 + i; const float tn = (float)t / (float)(L - 1);
                float feat = 0.f;
                if (lane == 0) feat = tn;
                else if (lane < 33) { const int kb = (lane - 1) & 15; const float band = 1e-4f + (float)kb * ((15.0f - 1e-4f) / 15.0f); const float rev = ((float)t * band) / (float)L;
                    feat = (lane <= 16) ? cos_rev(rev) : -sin_rev(rev); }
                float z1 = b1[lane];
#pragma unroll
                for (int k = 0; k < 33; ++k) z1 += __int_as_float(__builtin_amdgcn_readlane(__float_as_int(feat), k)) * w1[k * 64 + lane];
                const float a1 = sin_rad(fr_ * z1);
                float z2 = b2[lane];
#pragma unroll
                for (int k = 0; k < 64; ++k) z2 += __int_as_float(__builtin_amdgcn_readlane(__float_as_int(a1), k)) * w2[k * 64 + lane];
                a2r[i] = sin_rad(fr_ * z2);
            }
            const float dmin = -3.0701134573253945f, dmax = -15.350567286626972f;
            LAS float* A2 = (LAS float*)F.lds;
#pragma unroll
            for (int i = 0; i < 8; ++i) A2[(F.wave * 8 + i) * 65 + lane] = a2r[i];
            __syncthreads();
            {
                typedef float f32x16 __attribute__((ext_vector_type(16)));
                const int l32 = lane & 31, hi = lane >> 5, col0 = F.wave * 64;
                float bw[2][32];
#pragma unroll
                for (int cb = 0; cb < 2; ++cb)
#pragma unroll
                    for (int sk = 0; sk < 32; ++sk) bw[cb][sk] = w3[(2 * sk + hi) * 512 + col0 + 32 * cb + l32];
                f32x16 acc[2][2];
#pragma unroll
                for (int rb = 0; rb < 2; ++rb)
#pragma unroll
                    for (int cb = 0; cb < 2; ++cb) acc[rb][cb] = (f32x16){0.f,0.f,0.f,0.f,0.f,0.f,0.f,0.f,0.f,0.f,0.f,0.f,0.f,0.f,0.f,0.f};
#pragma unroll
                for (int sk = 0; sk < 32; ++sk) {
#pragma unroll
                    for (int rb = 0; rb < 2; ++rb) { const float a = A2[(rb * 32 + l32) * 65 + 2 * sk + hi];
#pragma unroll
                        for (int cb = 0; cb < 2; ++cb) acc[rb][cb] = __builtin_amdgcn_mfma_f32_32x32x2f32(a, bw[cb][sk], acc[rb][cb], 0, 0, 0); }
                }
#pragma unroll
                for (int cb = 0; cb < 2; ++cb) { const int col = col0 + 32 * cb + l32, ch = col & 255; const float delta = fabsf(dmin + (float)ch * ((dmax - dmin) / 255.0f));
#pragma unroll
                    for (int rb = 0; rb < 2; ++rb)
#pragma unroll
                        for (int r = 0; r < 16; ++r) { const int tl = rb * 32 + (r & 3) + 8 * (r >> 2) + 4 * hi; const float tn = (float)(t0 + tl) / (float)(L - 1);
                            const float v = acc[rb][cb][r] * __expf(-tn * delta); tile[col * 66 + tl] = (unsigned short)(pk2(v, 0.f) & 0xffffu); } }
            }
            __syncthreads();
            unsigned short* R = ctx ? (unsigned short*)(ws + WS_FILTC) + ((size_t)l * 256) * 512 : (unsigned short*)(ws + WS_FILT) + ((size_t)l * 256) * 8192;
            const int RL = 2 * L, ch = tid >> 1, half = tid & 1;
            unsigned short* Rc = R + (size_t)ch * RL;
            for (int k = 32 * half; k < 32 * half + 32; ++k) {
                Rc[L - t0 - 63 + k] = tile[ch * 66 + 63 - k];
                if (t0 + k > 0) Rc[L + t0 + k] = tile[(256 + ch) * 66 + k];
            }
            if (t0 == 0 && half == 0) Rc[0] = 0;
            __syncthreads();
        }
    }
        } else if (t < 272 + NT_B) { int tq_ = tid; asm volatile("" : "+v"(tq_)); const int tid = tq_, lane = tid & 63; (void)lane;
    {
        float* mods = (float*)(ws + WS_MODS);
        LAS float* part = (LAS float*)F.lds;
        { const int it = t - 272;
            const int l = it / 24, jb = it % 24, ks = F.wave, j = jb * 256 + 4 * lane;
            const float* wp = KARG(I_WADA) + ((size_t)l * 1024 + ks * 128) * 6144 + j;
            f32x4 acc[9];
#pragma unroll
            for (int mi = 0; mi < 9; ++mi) acc[mi] = (f32x4){0.f, 0.f, 0.f, 0.f};
#pragma unroll 1
            for (int kb = 0; kb < 128; kb += 16) {
                f32x4 wv[16];
#pragma unroll
                for (int k = 0; k < 16; ++k) wv[k] = *(const f32x4*)(wp + (size_t)(kb + k) * 6144);
                asm volatile("" ::: "memory");
#pragma unroll
                for (int k = 0; k < 16; ++k) { const f32x4 w = wv[k]; const LAS float* sp = sct + (ks * 128 + kb + k) * 12;
                    const f32x4 s0 = *(const LAS f32x4*)sp, s1 = *(const LAS f32x4*)(sp + 4); const float s8 = sp[8];
                    acc[0] += w * s0[0]; acc[1] += w * s0[1]; acc[2] += w * s0[2]; acc[3] += w * s0[3]; acc[4] += w * s1[0]; acc[5] += w * s1[1]; acc[6] += w * s1[2]; acc[7] += w * s1[3]; acc[8] += w * s8; }
            }
#pragma unroll
            for (int mi = 0; mi < 9; ++mi) *(LAS f32x4*)(part + (ks * 9 + mi) * 256 + 4 * lane) = acc[mi];
            __syncthreads();
            for (int o = tid; o < 9 * 256; o += NWAVES * 64) { const int mi = o >> 8, jl = o & 255; float sum = KARG(I_BADA)[l * 6144 + jb * 256 + jl];
#pragma unroll
                for (int w8 = 0; w8 < 8; ++w8) sum += part[(w8 * 9 + mi) * 256 + jl];
                mods[((size_t)l * 9 + mi) * 6144 + jb * 256 + jl] = sum; }
            __syncthreads();
        }
    }
        } else { int tq_ = tid; asm volatile("" : "+v"(tq_)); const int tid = tq_, lane = tid & 63; (void)lane;
    {
        constexpr int I_IN = 16 * 72, I_OUT = 16 * 32, I_G = 16 * 88, I_D = 44 * 32;
        constexpr int NIT = 4 * I_IN + 4 * I_OUT + 4 * I_G + 2 * I_D; static_assert(NIT == NT_A * 8, "transpose block items");
        { const int it = (t - (272 + NT_B)) * 8 + F.wave;
            int r = it;
            if (r < 4 * I_IN) { const int l = r / I_IN; transpose_item(KARG(I_WIN) + (size_t)l * DM * ZP, DM, ZP, (bf16*)(ws + WS_WIN) + (size_t)l * ZP * DM, scr, r % I_IN, lane, RmWin{}); continue; } r -= 4 * I_IN;
            if (r < 4 * I_OUT) { const int l = r / I_OUT; transpose_item(KARG(I_WOUT) + (size_t)l * DM * DM, DM, DM, (bf16*)(ws + WS_WOUT) + (size_t)l * DM * DM, scr, r % I_OUT, lane, RmId{}); continue; } r -= 4 * I_OUT;
            if (r < 4 * I_G) { const int q = r / I_G, j = q >> 1, up = q & 1; if ((DENSE_F8_MASK >> j) & 1) transpose_item8(KARG(up ? I_FWU : I_FWG) + (size_t)j * DM * DFF, DM, DFF, (unsigned char*)(ws + WS_WGU) + (size_t)j * 4 * DFF * DM, scr, r % I_G, lane, RmGate{up * 128}, pg8::F8_SW);
                else transpose_item(KARG(up ? I_FWU : I_FWG) + (size_t)j * DM * DFF, DM, DFF, (bf16*)(ws + WS_WGU) + (size_t)j * 2 * DFF * DM, scr, r % I_G, lane, RmGate{up * 128}); continue; } r -= 4 * I_G;
            { const int j = r / I_D; if ((DENSE_F8_MASK >> j) & 1) transpose_item8(KARG(I_FWD) + (size_t)j * DFF * DM, DFF, DM, (unsigned char*)(ws + WS_WD) + (size_t)j * 2 * DM * DFF, scr, r % I_D, lane, RmId{}, pg8::F8_SWD);
              else transpose_item(KARG(I_FWD) + (size_t)j * DFF * DM, DFF, DM, (bf16*)(ws + WS_WD) + (size_t)j * DM * DFF, scr, r % I_D, lane, RmId{}); }
        }
    }
        }
    }
    if (F.vcu == 0) {
        float* rope = (float*)(ws + WS_ROPE);
        for (int i = tid; i < 512 + 1024; i += NWAVES * 64) {
            const bool g = i >= 512; const int j = g ? i - 512 : i; const int n = g ? 16 : 8, pos = j / n, f = j % n;
            const float inv = exp2f(-13.287712379549449f * (float)f / (float)n);
            const float rev = (float)pos * inv * 0.15915494309189535f;
            if (g) { rope[1024 + j] = cos_rev(rev); rope[2048 + j] = sin_rev(rev); } else { rope[j] = cos_rev(rev); rope[512 + j] = sin_rev(rev); }
        }
        if (tid < 4) { const int l = tid; float s1 = 0.f, s2 = 0.f;
            for (int k = 0; k < 32; ++k) { s1 += KARG(I_LQ1)[l * 32 + k] * KARG(I_LK1)[l * 32 + k]; s2 += KARG(I_LQ2)[l * 32 + k] * KARG(I_LK2)[l * 32 + k]; }
            const float li = 0.8f - 0.6f * __expf(-0.3f * (float)l);
            float* sc = (float*)(ws + WS_ROPE + 16384) + l * 4; sc[0] = __expf(s1) - __expf(s2) + li; sc[1] = 1.0f - li; }
    }
}

struct Comb { const unsigned* route; const bf16* Y; const float* gate; int tb[9]; };
struct Pend { const float* part; const float* gate; int S; const float* ctx32; };
template <bool ROUTE, bool COMB, bool SRC16, bool PEND, bool OUT8 = false>
__device__ __forceinline__ void norm_phase(Frame& F, const void* Hl, const void* Hc, const float* g, const float* mods_l, int sh_chunk, bf16* U, const float* router, unsigned* route, gu32* cnt, int MR, const Comb& cb, const Pend& pd) {
    FRESH_TID();
    int gw_ = F.vcu * NWAVES + F.wave; asm volatile("" : "+s"(gw_)); const int gw = gw_, NGW = F.G * NWAVES;
    if (ROUTE) { if (tid < 16) ((LAS unsigned*)(F.lds + 64))[tid] = 0u; __syncthreads(); }
    f32x4 gg[4];
#pragma unroll
    for (int j = 0; j < 4; ++j) gg[j] = *(const f32x4*)(g + 256 * j + 4 * lane);
    for (int q = gw; q < MR / 4; q += NGW) {
        const int m0 = 4 * q; const bool lat = m0 < ML; const size_t roff = lat ? (size_t)m0 * DM : (size_t)(m0 - ML) * DM; const void* srcv = lat ? Hl : Hc; const int mi = lat ? (m0 >> 12) : 8;
        const float* shp = mods_l + mi * 6144 + sh_chunk * 1024; const float* scp = shp + 1024;
        f32x4 v[4][4], sc[4], sh[4];
#pragma unroll
        for (int k = 0; k < 4; ++k)
#pragma unroll
            for (int j = 0; j < 4; ++j) {
                if (SRC16) { const v2u w = *(const v2u*)((const bf16*)srcv + roff + (size_t)k * DM + 256 * j + 4 * lane); v[k][j] = (f32x4){bflo(w.x), bfhi(w.x), bflo(w.y), bfhi(w.y)}; }
                else v[k][j] = *(const f32x4*)((const float*)srcv + roff + (size_t)k * DM + 256 * j + 4 * lane); }
#pragma unroll
        for (int j = 0; j < 4; ++j) { sc[j] = *(const f32x4*)(scp + 256 * j + 4 * lane); sh[j] = *(const f32x4*)(shp + 256 * j + 4 * lane); }
        if (PEND && !lat) {
            const int mc = m0 - ML, tile = mc >> 8, rin = mc & 255;
            if (pd.ctx32) {
#pragma unroll
                for (int k = 0; k < 4; ++k)
#pragma unroll
                    for (int j = 0; j < 4; ++j) v[k][j] = *(const f32x4*)(pd.ctx32 + roff + (size_t)k * DM + 256 * j + 4 * lane); }
#pragma unroll
            for (int j = 0; j < 4; ++j) { const f32x4 gt = *(const f32x4*)(pd.gate + 8 * 6144 + 256 * j + 4 * lane);
#pragma unroll
                for (int k = 0; k < 4; ++k) { f32x4 acc = (f32x4){0.f, 0.f, 0.f, 0.f};
                    for (int sidx = 0; sidx < pd.S; ++sidx) acc += *(const f32x4*)(pd.part + ((size_t)((tile * 4 + j) * pd.S + sidx) * 65536) + (size_t)(rin + k) * 256 + 4 * lane);
                    v[k][j] += gt * acc;
                    v2u o; o.x = pk2(v[k][j][0], v[k][j][1]); o.y = pk2(v[k][j][2], v[k][j][3]); *(v2u*)((bf16*)Hc + roff + (size_t)k * DM + 256 * j + 4 * lane) = o;
                    v[k][j] = (f32x4){bflo(o.x), bfhi(o.x), bflo(o.y), bfhi(o.y)}; } }
        }
        if (COMB) {
            v4u ra[4];
#pragma unroll
            for (int k = 0; k < 4; ++k) ra[k] = *(const v4u*)(cb.route + (size_t)(m0 + k) * 4);
            f32x4 gt[4];
#pragma unroll
            for (int j = 0; j < 4; ++j) gt[j] = *(const f32x4*)(cb.gate + mi * 6144 + 256 * j + 4 * lane);
#pragma unroll
            for (int k = 0; k < 4; ++k) {
                int b1 = 0, b2 = 0;
#pragma unroll
                for (int e = 0; e < 8; ++e) { b1 = ((int)(ra[k].x & 255u) == e) ? cb.tb[e] : b1; b2 = ((int)(ra[k].x >> 8) == e) ? cb.tb[e] : b2; }
                const bf16* y1 = cb.Y + ((size_t)b1 * 256 + ra[k].y) * DM; const bf16* y2 = cb.Y + ((size_t)b2 * 256 + ra[k].z) * DM;
                const float w1 = __uint_as_float(ra[k].w), w2 = 1.0f - w1;
                v2u p1[4], p2[4];
#pragma unroll
                for (int j = 0; j < 4; ++j) { p1[j] = *(const v2u*)(y1 + 256 * j + 4 * lane); p2[j] = *(const v2u*)(y2 + 256 * j + 4 * lane); }
#pragma unroll
                for (int j = 0; j < 4; ++j) {
                    v[k][j][0] += gt[j][0] * (w1 * bflo(p1[j].x) + w2 * bflo(p2[j].x)); v[k][j][1] += gt[j][1] * (w1 * bfhi(p1[j].x) + w2 * bfhi(p2[j].x));
                    v[k][j][2] += gt[j][2] * (w1 * bflo(p1[j].y) + w2 * bflo(p2[j].y)); v[k][j][3] += gt[j][3] * (w1 * bfhi(p1[j].y) + w2 * bfhi(p2[j].y));
                    { v2u o; o.x = pk2(v[k][j][0], v[k][j][1]); o.y = pk2(v[k][j][2], v[k][j][3]); *(v2u*)((bf16*)srcv + roff + (size_t)k * DM + 256 * j + 4 * lane) = o;
                      v[k][j] = (f32x4){bflo(o.x), bfhi(o.x), bflo(o.y), bfhi(o.y)}; } }
            }
        }
        float rstd[4];
#pragma unroll
        for (int k = 0; k < 4; ++k) { float s = 0.f;
#pragma unroll
            for (int j = 0; j < 4; ++j) s += (v[k][j][0] * v[k][j][0] + v[k][j][1] * v[k][j][1]) + (v[k][j][2] * v[k][j][2] + v[k][j][3] * v[k][j][3]);
            rstd[k] = s; }
#pragma unroll
        for (int o = 1; o < 64; o <<= 1) {
#pragma unroll
            for (int k = 0; k < 4; ++k) rstd[k] += shx(rstd[k], o, lane); }
#pragma unroll
        for (int k = 0; k < 4; ++k) rstd[k] = __builtin_amdgcn_rsqf(rstd[k] * (1.0f / DM) + NORM_EPS);
        float lg[4][8];
        if (ROUTE) {
#pragma unroll
            for (int k = 0; k < 4; ++k)
#pragma unroll
                for (int e = 0; e < 8; ++e) lg[k][e] = 0.f; }
#pragma unroll
        for (int j = 0; j < 4; ++j) { const int c0 = 256 * j + 4 * lane;
#pragma unroll
            for (int k = 0; k < 4; ++k) {
                v[k][j] = (v[k][j] * rstd[k]) * gg[j] * (sc[j] + 1.0f) + sh[j];
                if (OUT8) { constexpr float sa = pg8::F8_SA; *(unsigned*)((unsigned char*)U + (size_t)(m0 + k) * DM + c0) = pg8::pk_fp8x4(v[k][j][0] * sa, v[k][j][1] * sa, v[k][j][2] * sa, v[k][j][3] * sa); }
                else { v2u o; o.x = pk2(v[k][j][0], v[k][j][1]); o.y = pk2(v[k][j][2], v[k][j][3]);
                *(v2u*)(U + (size_t)(m0 + k) * DM + c0) = o; } }
            if (ROUTE) {
#pragma unroll
                for (int i = 0; i < 4; ++i) { const f32x4 r0 = *(const f32x4*)(router + (size_t)(c0 + i) * 8), r1 = *(const f32x4*)(router + (size_t)(c0 + i) * 8 + 4);
#pragma unroll
                    for (int k = 0; k < 4; ++k) { const float x = v[k][j][i];
                        lg[k][0] += x * r0[0]; lg[k][1] += x * r0[1]; lg[k][2] += x * r0[2]; lg[k][3] += x * r0[3]; lg[k][4] += x * r1[0]; lg[k][5] += x * r1[1]; lg[k][6] += x * r1[2]; lg[k][7] += x * r1[3]; } } }
        }
        if (ROUTE) {
#pragma unroll
            for (int o = 1; o < 64; o <<= 1) {
#pragma unroll
                for (int k = 0; k < 4; ++k)
#pragma unroll
                    for (int e = 0; e < 8; ++e) lg[k][e] += shx(lg[k][e], o, lane); }
            if (lane < 4) {
                float l8[8];
#pragma unroll
                for (int e = 0; e < 8; ++e) l8[e] = lane == 0 ? lg[0][e] : (lane == 1 ? lg[1][e] : (lane == 2 ? lg[2][e] : lg[3][e]));
                int i1 = 0; float v1 = l8[0];
#pragma unroll
                for (int e = 1; e < 8; ++e) if (l8[e] > v1) { v1 = l8[e]; i1 = e; }
                int i2 = -1; float v2 = 0.f;
#pragma unroll
                for (int e = 0; e < 8; ++e) if (e != i1 && (i2 < 0 || l8[e] > v2)) { v2 = l8[e]; i2 = e; }
                const float w1 = 1.0f / (1.0f + __expf(v2 - v1)), w2 = 1.0f - w1;
                const unsigned s1 = __hip_atomic_fetch_add((LAS unsigned*)(F.lds + 64) + i1, 1u, __ATOMIC_RELAXED, __HIP_MEMORY_SCOPE_WORKGROUP);
                const unsigned s2 = __hip_atomic_fetch_add((LAS unsigned*)(F.lds + 64) + i2, 1u, __ATOMIC_RELAXED, __HIP_MEMORY_SCOPE_WORKGROUP);
                (void)w2; v4u a; a.x = (unsigned)i1 | ((unsigned)i2 << 8); a.y = s1; a.z = s2; a.w = __float_as_uint(w1);
                *(v4u*)(route + (size_t)(m0 + lane) * 4) = a;
            }
        }
    }
    if (ROUTE) {
        LAS unsigned* lc = (LAS unsigned*)(F.lds + 64);
        __syncthreads();
        if (tid < 8) lc[8 + tid] = __hip_atomic_fetch_add(cnt + 64 * tid, lc[tid], RLX_AGENT);
        __syncthreads();
        for (int q = gw; q < MR / 4; q += NGW) {
            if (lane < 4) { const int m = 4 * q + lane; v4u a = *(v4u*)(route + (size_t)m * 4); a.y += lc[8 + (a.x & 255u)]; a.z += lc[8 + (a.x >> 8)]; *(v4u*)(route + (size_t)m * 4) = a; }
        }
        __syncthreads();
    }
}
constexpr int CW_FILL = 10240;
__device__ __forceinline__ void moe_filler(Frame& F, int li, int quota) {
    FRESH_TID();
    LAS float* scr = (LAS float*)(F.lds + F.wave * 8704);
    constexpr int I_G = 16 * 112, I_D = 56 * 32, NIT = 16 * I_G + 8 * I_D;
    static_assert(NIT % 8 == 0, "block items");
    gu32* qh = F.ctl + CW_FILL + 64 * li;
    for (int n = 0; n < quota; ++n) {
        if (tid == 0) F.MISC[1] = __hip_atomic_fetch_add(qh, 1u, RLX_AGENT);
        __syncthreads();
        const int t = (int)F.MISC[1];
        __syncthreads();
        if (t >= NIT / 8) break;
        int r = t * 8 + F.wave;
        if (r < 16 * I_G) { const int q = r / I_G, e = q >> 1, up = q & 1;
            transpose_item8(KARG(up ? I_MWU : I_MWG) + ((size_t)li * 8 + e) * DM * DFE, DM, DFE, (unsigned char*)(KWS() + WS_MWGU) + ((size_t)li * 8 + e) * 2 * DFE * DM, scr, r % I_G, lane, RmGate{up * 128}, pg8::F8_SW); }
        else { r -= 16 * I_G; const int e = r / I_D; transpose_item8(KARG(I_MWD) + ((size_t)li * 8 + e) * DFE * DM, DFE, DM, (unsigned char*)(KWS() + WS_MWD) + ((size_t)li * 8 + e) * DM * DFE, scr, r % I_D, lane, RmId{}, pg8::F8_SWD); }
    }
}
__device__ __forceinline__ void moe_tile_base(const gu32* cnt, int (&tb)[9]) {
    tb[0] = 0;
#pragma unroll
    for (int e = 0; e < 8; ++e) { const unsigned c = __hip_atomic_load(cnt + 64 * e, RLX_AGENT); tb[e + 1] = tb[e] + (int)((c + 255u) >> 8); }
}
__device__ __forceinline__ void gather_phase(Frame& F, const unsigned char* U8, const unsigned* route, const int (&tb)[9], unsigned char* AS, int MR) {
    FRESH_TID();
    int gw_ = F.vcu * NWAVES + F.wave; asm volatile("" : "+s"(gw_)); const int gw = gw_, NGW = F.G * NWAVES;
    for (int m0 = gw; m0 < MR; m0 += 8 * NGW) {
        v4u x0[8]; size_t r1[8], r2[8];
#pragma unroll
        for (int k = 0; k < 8; ++k) { const int m = m0 + k * NGW; const int mc = m < MR ? m : m0;
            const v4u a = *(const v4u*)(route + (size_t)mc * 4); const int e1 = (int)(a.x & 255u), e2 = (int)(a.x >> 8);
            int b1 = 0, b2 = 0;
#pragma unroll
            for (int e = 0; e < 8; ++e) { b1 = (e1 == e) ? tb[e] : b1; b2 = (e2 == e) ? tb[e] : b2; }
            r1[k] = (size_t)b1 * 256 + a.y; r2[k] = (size_t)b2 * 256 + a.z;
            x0[k] = *(const v4u*)(U8 + (size_t)mc * DM + 16 * lane); }
#pragma unroll
        for (int k = 0; k < 8; ++k) { if (m0 + k * NGW < MR) { *(v4u*)(AS + r1[k] * DM + 16 * lane) = x0[k]; *(v4u*)(AS + r2[k] * DM + 16 * lane) = x0[k]; } }
    }
}
__device__ __forceinline__ void final_phase(Frame& F, const bf16* H, float* OUT, const float* g, const Comb& cb) {
    FRESH_TID();
    int gw_ = F.vcu * NWAVES + F.wave; asm volatile("" : "+s"(gw_)); const int gw = gw_, NGW = F.G * NWAVES;
    f32x4 gg[4];
#pragma unroll
    for (int j = 0; j < 4; ++j) gg[j] = *(const f32x4*)(g + 256 * j + 4 * lane);
    for (int q = gw; q < ML / 4; q += NGW) { const int m0 = 4 * q; const bf16* hp = H + (size_t)m0 * DM; float* op = OUT + (size_t)m0 * DM; const int mi = m0 >> 12;
        f32x4 v[4][4]; v4u ra[4]; f32x4 gt[4];
#pragma unroll
        for (int k = 0; k < 4; ++k) {
#pragma unroll
            for (int j = 0; j < 4; ++j) { const v2u w = *(const v2u*)(hp + (size_t)k * DM + 256 * j + 4 * lane); v[k][j] = (f32x4){bflo(w.x), bfhi(w.x), bflo(w.y), bfhi(w.y)}; }
            ra[k] = *(const v4u*)(cb.route + (size_t)(m0 + k) * 4); }
#pragma unroll
        for (int j = 0; j < 4; ++j) gt[j] = *(const f32x4*)(cb.gate + mi * 6144 + 256 * j + 4 * lane);
#pragma unroll
        for (int k = 0; k < 4; ++k) {
            int b1 = 0, b2 = 0;
#pragma unroll
            for (int e = 0; e < 8; ++e) { b1 = ((int)(ra[k].x & 255u) == e) ? cb.tb[e] : b1; b2 = ((int)(ra[k].x >> 8) == e) ? cb.tb[e] : b2; }
            const bf16* y1 = cb.Y + ((size_t)b1 * 256 + ra[k].y) * DM; const bf16* y2 = cb.Y + ((size_t)b2 * 256 + ra[k].z) * DM;
            const float w1 = __uint_as_float(ra[k].w), w2 = 1.0f - w1;
            v2u p1[4], p2[4];
#pragma unroll
            for (int j = 0; j < 4; ++j) { p1[j] = *(const v2u*)(y1 + 256 * j + 4 * lane); p2[j] = *(const v2u*)(y2 + 256 * j + 4 * lane); }
#pragma unroll
            for (int j = 0; j < 4; ++j) {
                v[k][j][0] += gt[j][0] * (w1 * bflo(p1[j].x) + w2 * bflo(p2[j].x)); v[k][j][1] += gt[j][1] * (w1 * bfhi(p1[j].x) + w2 * bfhi(p2[j].x));
                v[k][j][2] += gt[j][2] * (w1 * bflo(p1[j].y) + w2 * bflo(p2[j].y)); v[k][j][3] += gt[j][3] * (w1 * bfhi(p1[j].y) + w2 * bfhi(p2[j].y)); }
        }
        float rstd[4];
#pragma unroll
        for (int k = 0; k < 4; ++k) { float s = 0.f;
#pragma unroll
            for (int j = 0; j < 4; ++j) s += (v[k][j][0] * v[k][j][0] + v[k][j][1] * v[k][j][1]) + (v[k][j][2] * v[k][j][2] + v[k][j][3] * v[k][j][3]);
            rstd[k] = s; }
#pragma unroll
        for (int o = 1; o < 64; o <<= 1) {
#pragma unroll
            for (int k = 0; k < 4; ++k) rstd[k] += shx(rstd[k], o, lane); }
#pragma unroll
        for (int k = 0; k < 4; ++k) { const float r = __builtin_amdgcn_rsqf(rstd[k] * (1.0f / DM) + NORM_EPS);
#pragma unroll
            for (int j = 0; j < 4; ++j) *(f32x4*)(op + (size_t)k * DM + 256 * j + 4 * lane) = (v[k][j] * r) * gg[j]; }
    }
}

__device__ __forceinline__ void hypre_phase(Frame& F, const bf16* Z, const float* cw, const float* cb, bf16* VVT, bf16* X0T, int nitems) {
    FRESH_TID();
    int gw_ = F.vcu * NWAVES + F.wave; asm volatile("" : "+s"(gw_)); const int gw = gw_, NGW = F.G * NWAVES;
    const int b = lane & 7, cl = lane >> 3;
    for (int it = gw; it < 8 * nitems; it += NGW) {
        const int r0 = it >> 3, co = it & 7;
        const bool ctx = r0 >= 2048; const int r = ctx ? r0 - 2048 : r0, tch = r >> 2, L = ctx ? NCTX : SEQL, t0 = 8 * tch, c = (r & 3) * 64 + co * 8 + cl;
        float w[3][3], bs[3];
#pragma unroll
        for (int s = 0; s < 3; ++s) { bs[s] = cb[s * 256 + c];
#pragma unroll
            for (int j = 0; j < 3; ++j) w[s][j] = cw[j * 768 + s * 256 + c]; }
        const size_t nch = ctx ? 32 : 512; const size_t base = ctx ? (size_t)256 * 512 * 64 : 0;
        const size_t off = base + ((size_t)c * nch + tch) * 64 + b * 8;
        const size_t rowb = ctx ? (size_t)ML + (size_t)b * NCTX : (size_t)b * SEQL;
        float zz[3][10];
#pragma unroll
        for (int i = 0; i < 10; ++i) { const int t = t0 - 1 + i; const bool ok = (t >= 0) && (t < L); const bf16* zp = Z + (rowb + (ok ? t : 0)) * ZP + c;
#pragma unroll
            for (int s = 0; s < 3; ++s) { const float lv = bf2f(zp[s * 256]); zz[s][i] = ok ? lv : 0.f; } }
        float vv[8], x0[8];
#pragma unroll
        for (int i = 0; i < 8; ++i) { float y[3];
#pragma unroll
            for (int s = 0; s < 3; ++s) y[s] = bs[s] + zz[s][i] * w[s][0] + zz[s][i + 1] * w[s][1] + zz[s][i + 2] * w[s][2];
            x0[i] = y[0]; vv[i] = y[2] * y[1]; }
        v4u gv, gx; gv.x = pk2(vv[0], vv[1]); gv.y = pk2(vv[2], vv[3]); gv.z = pk2(vv[4], vv[5]); gv.w = pk2(vv[6], vv[7]);
        gx.x = pk2(x0[0], x0[1]); gx.y = pk2(x0[2], x0[3]); gx.z = pk2(x0[4], x0[5]); gx.w = pk2(x0[6], x0[7]);
        *(v4u*)(VVT + off) = gv; *(v4u*)(X0T + off) = gx;
    }
}
__device__ __forceinline__ void hypost_phase(Frame& F, const bf16* YT, bf16* MIX, int nitems) {
    FRESH_TID();
    int gw_ = F.vcu * NWAVES + F.wave; asm volatile("" : "+s"(gw_)); const int gw = gw_, NGW = F.G * NWAVES;
    for (int it4 = gw; it4 < 4 * nitems; it4 += NGW) {
        const int it = it4 >> 2, b0 = 2 * (it4 & 3);
        const bool ctx = it >= 2048; const int r = ctx ? it - 2048 : it, tch = r >> 2, cg = r & 3, t0 = 8 * tch, c = cg * 64 + lane;
        const size_t nch = ctx ? 32 : 512; const size_t base = ctx ? (size_t)256 * 512 * 64 : 0;
        const bf16* gp = YT + base + ((size_t)c * nch + tch) * 64;
        v4u g[2];
#pragma unroll
        for (int bb = 0; bb < 2; ++bb) g[bb] = *(const v4u*)(gp + (b0 + bb) * 8);
#pragma unroll
        for (int bb = 0; bb < 2; ++bb) { const int b = b0 + bb;
            const size_t row = ctx ? (size_t)ML + (size_t)b * NCTX + t0 : (size_t)b * SEQL + t0;
            bf16* mp = MIX + row * DM + c;
            const unsigned wv[4] = {g[bb].x, g[bb].y, g[bb].z, g[bb].w};
#pragma unroll
            for (int i = 0; i < 8; ++i) mp[(size_t)i * DM] = (bf16)((i & 1) ? (wv[i >> 1] >> 16) : (wv[i >> 1] & 0xffffu));
        }
    }
}
constexpr int UX_DIFF = 64, UX_GQA = 128, UX_HY = 32, UX_CDIFF = 4, UX_CGQA = 8, UX_CHY = 32;
constexpr int NUNITS_X = UX_DIFF + UX_GQA + UX_HY + UX_CDIFF + UX_CGQA + UX_CHY, NUNITS_X_LAST = UX_DIFF + UX_GQA + UX_HY;
#ifndef PROBE_MIXT
#define PROBE_MIXT 0
#endif
#define MIXT(ty, ...) do { unsigned long long t0_ = 0ull; if ((PROBE_MIXT >> (ty)) & 1) t0_ = rt(); __VA_ARGS__; if (((PROBE_MIXT >> (ty)) & 1) && threadIdx.x == 0) atomicAdd((unsigned long long*)(KWS() + WS_ROPE + 32768), rt() - t0_); } while (0)
__device__ __forceinline__ void mix_phase(Frame& F, int l, unsigned char* lds_generic, int qslot, int nunits) {
    FRESH_TID();
    unsigned char* ws = KWS();
    const attn_body::bf16* Z = (const attn_body::bf16*)(ws + WS_Z); attn_body::bf16* MIX = (attn_body::bf16*)(ws + WS_MIX);
    const float* scal = (const float*)(ws + WS_ROPE + 16384) + l * 4;
    const float lam = scal[0], sub_scale = scal[1];
    const float* subln = KARG(I_SUBLN) + l * 64;
    const int x = (int)blockIdx.x & 7, b = x;
    gu32* qh = F.ctl + CW_QMIX + 64 * (qslot * 8 + x);
    for (;;) {
        if (tid == 0) F.MISC[0] = __hip_atomic_fetch_add(qh, 1u, RLX_AGENT);
        __syncthreads();
        const int t = (int)F.MISC[0];
        __syncthreads();
        if (t >= nunits) break;
        int j = t;
        if (j < UX_DIFF + UX_GQA) {
            const bool diff = j < UX_DIFF; if (!diff) j -= UX_DIFF;
            const int qb = j & 15, hh = j >> 4;
            const size_t qrow = (size_t)b * SEQL + qb * 256;
            if (diff) MIXT(0, attn_body::diff_unit<8>(Z + qrow * ZP + 768 + hh * 64, Z + 1024 + hh * 64, Z + 1280 + hh * 64, b * SEQL, ML + b * NCTX, 64, 68, MIX + qrow * DM + 256 + hh * 64, (char*)lds_generic, lam, subln, sub_scale));
            else MIXT(1, attn_body::attn_unit<0, 8>(Z + qrow * ZP + 1536 + hh * 64, Z + 2048 + (hh >> 2) * 64, Z + 2176 + (hh >> 2) * 64, b * SEQL, ML + b * NCTX, 64, 68, MIX + qrow * DM + 512 + hh * 64, (char*)lds_generic, 0.f, subln, 0.f));
            continue;
        }
        j -= UX_DIFF + UX_GQA;
        if (j < UX_HY) {
            const int c = j * 8 + x;
            MIXT(2, hy::conv_unit<4, 64>(F.lds, (const unsigned short*)(ws + WS_FILT) + ((size_t)l * 256 + c) * 8192, (const unsigned short*)(ws + WS_VVT) + (size_t)c * 512 * 64,
                                 (const unsigned short*)(ws + WS_X0T) + (size_t)c * 512 * 64, (unsigned short*)(ws + WS_YT) + (size_t)c * 512 * 64, KARG(I_HSKIP)[l * 256 + c]));
            continue;
        }
        j -= UX_HY;
        if (j < UX_CDIFF + UX_CGQA) {
            const bool diff = j < UX_CDIFF; if (!diff) j -= UX_CDIFF;
            const int hh = j;
            const size_t qrow = (size_t)ML + (size_t)b * NCTX;
            if (diff) attn_body::diff_unit<8>(Z + qrow * ZP + 768 + hh * 64, Z + 1024 + hh * 64, Z + 1280 + hh * 64, 0, ML + b * NCTX, 0, 4, MIX + qrow * DM + 256 + hh * 64, (char*)lds_generic, lam, subln, sub_scale);
            else attn_body::attn_unit<0, 8>(Z + qrow * ZP + 1536 + hh * 64, Z + 2048 + (hh >> 2) * 64, Z + 2176 + (hh >> 2) * 64, 0, ML + b * NCTX, 0, 4, MIX + qrow * DM + 512 + hh * 64, (char*)lds_generic, 0.f, subln, 0.f);
            continue;
        }
        j -= UX_CDIFF + UX_CGQA;
        { const int c = j * 8 + x; const size_t base = (size_t)256 * 512 * 64;
            hy::conv_unit<1, 4>(F.lds, (const unsigned short*)(ws + WS_FILTC) + ((size_t)l * 256 + c) * 512, (const unsigned short*)(ws + WS_VVT) + base + (size_t)c * 32 * 64,
                                (const unsigned short*)(ws + WS_X0T) + base + (size_t)c * 32 * 64, (unsigned short*)(ws + WS_YT) + base + (size_t)c * 32 * 64, KARG(I_HSKIP)[l * 256 + c]); }
    }
}

#ifndef PROBE_IDLE
#define PROBE_IDLE 0
#endif
#ifndef PROBE_DUP
#define PROBE_DUP (-1)
#endif
#ifndef PROBE_DRY
#define PROBE_DRY 0
#endif
#ifndef PROBE_BAR
#define PROBE_BAR 0
#endif
#define DUP(k, ...) for (int rep_ = 0; rep_ < ((PROBE_DUP == (k)) ? args.nrep : 1); ++rep_) { __VA_ARGS__; if (PROBE_BAR && PROBE_DUP == (k) && rep_ == 0) xcd_barrier(bar); }
#ifndef STAGGER_US
#define STAGGER_US 0
#endif
__device__ __forceinline__ void stagger(int us) { if (us > 0 && (blockIdx.x >> 3) & 1) { const unsigned long long t0 = rt(); while (rt() - t0 < (unsigned long long)us * 100ull) __builtin_amdgcn_s_sleep(16); } }
struct Args { Ptrs p; int ph_lo, ph_hi, use_bar, nrep; };
__global__ void __launch_bounds__(NWAVES * 64, 2) trunk_fwd(Args args) {
    extern __shared__ __attribute__((aligned(16))) unsigned char lds[];
    Frame F;
    F.lds = (LAS unsigned char*)lds; F.MISC = (volatile LAS unsigned*)(F.lds + MISC_OFF);
    F.wave = __builtin_amdgcn_readfirstlane(threadIdx.x >> 6);
    F.G = gridDim.x; { const int bx = blockIdx.x; F.vcu = (F.G % 8 == 0) ? (bx % 8) * (F.G / 8) + bx / 8 : bx; }
    unsigned char* ws = KWS();
    F.ctl = (gu32*)(ws + WS_CTL);
    for (int u = threadIdx.x; u < (LDS_BYTES - LDSCTL_OFF) / 4; u += NWAVES * 64) ((LAS unsigned*)(F.lds + LDSCTL_OFF))[u] = 0u;
    __syncthreads();
    XcdBarrier bar; bar.bar = (unsigned*)(F.ctl + CW_BAR); bar.x = 0; bar.st = nullptr;
    if (args.use_bar) bar = xcd_barrier_post((unsigned*)(F.ctl + CW_BAR), F.MISC + 8);
    if (PROBE_IDLE && blockIdx.x == 0 && threadIdx.x == 0) *(volatile unsigned long long*)(KWS() + WS_ROPE + 32768) = 0ull;
    const int lo = args.ph_lo, hi = args.ph_hi;
#define IN(k) (lo <= (k) && (k) < hi)
#ifndef PROBE_TSEL
#define PROBE_TSEL 0
#endif
#ifndef PROBE_TK
#define PROBE_TK 4
#endif
    unsigned long long tacc_ = 0ull, tprev_ = PROBE_TSEL ? rt() : 0ull;
#define SEAM(k) do { unsigned long long ta_ = 0ull; if (PROBE_IDLE) ta_ = rt(); if ((k) + 1 < hi) xcd_barrier(bar); if (PROBE_IDLE) { const int ty_ = ((k) == 0) ? 12 : (((k) - 1) % NPL); if (((PROBE_IDLE >> ty_) & 1) && threadIdx.x == 0) atomicAdd((unsigned long long*)(ws + WS_ROPE + 32768), rt() - ta_); } if (PROBE_TSEL) { const unsigned long long now_ = rt(); const int ty_ = ((k) == 0) ? 12 : (((k) - 1) % NPL); if ((PROBE_TSEL >> ty_) & 1) tacc_ += now_ - tprev_; tprev_ = now_; } } while (0)

    bf16* Hl = (bf16*)(ws + WS_HB); bf16* Hc = (bf16*)(ws + WS_HC);
    bf16* U = (bf16*)(ws + WS_U);
    const float* mods = (const float*)(ws + WS_MODS);
    unsigned* route = (unsigned*)(ws + WS_ROUTE);

#ifdef PROBE_P0
    unsigned long long p0acc = 0ull;
    if (IN(0)) { p0_prologue(F, &p0acc); SEAM(0); }
#else
    if (IN(0)) { DUP(100, p0_prologue(F)); SEAM(0); }
#endif

    for (int l = 0; l < DEPTH; ++l) {
        const int pb = 1 + l * NPL; const bool moe = (l & 1) != 0; const int li = l >> 1; const bool last = l == DEPTH - 1; const int MR = last ? ML : MT; const int fill_li = (l == 0) ? 0 : ((l == 3) ? -1 : 1);
        const float* mods_l = mods + (size_t)l * 9 * 6144;
        gu32* cnt = F.ctl + CW_CNT + 64 * 8 * li;
        if (IN(pb + PH_NORM1)) {
            Pend pd{};
            if (l >= 2 && !moe) {
                Comb cb; cb.route = route; cb.Y = (const bf16*)(ws + WS_AS); cb.gate = mods + (size_t)(l - 1) * 9 * 6144 + 5 * 1024; moe_tile_base(F.ctl + CW_CNT + 64 * 8 * ((l - 1) >> 1), cb.tb);
                norm_phase<false, true, true, false>(F, Hl, Hc, KARG(I_GMIX) + l * DM, mods_l, 0, U, nullptr, nullptr, nullptr, MT, cb, pd);
            } else { Comb cb{};
                if (l == 0) norm_phase<false, false, false, false>(F, KARG(I_X), KARG(I_CTX), KARG(I_GMIX) + l * DM, mods_l, 0, U, nullptr, nullptr, nullptr, MT, cb, pd);
                else norm_phase<false, false, true, false>(F, Hl, Hc, KARG(I_GMIX) + l * DM, mods_l, 0, U, nullptr, nullptr, nullptr, MT, cb, pd); }
            SEAM(pb + PH_NORM1);
        }
        if (IN(pb + PH_WIN)) {
            pg8::Gemm g{U, (const bf16*)(ws + WS_WIN) + (size_t)l * ZP * DM, MT, ZP, DM, DM}; pg8::Sched2 S; S.init(MT / 256, ZP / 256, F.G, (int)blockIdx.x);
            { const float* rg = (const float*)(ws + WS_ROPE); LAS float* rl = (LAS float*)(F.lds + ROPE_LDS_OFF); int t0_ = threadIdx.x; asm volatile("" : "+v"(t0_)); for (int i = t0_; i < 3072; i += NWAVES * 64) rl[i] = rg[i]; __syncthreads(); }
            pg8::EpiWin E{(bf16*)(ws + WS_Z), (const LAS float*)(F.lds + ROPE_LDS_OFF), KARG(I_QNORM) + l * 64, KARG(I_KNORM) + l * 64};
            DUP(PH_WIN, pg8::gemm_phase<pg8::EpiWin, pg8::Sched2, true, true>(F.lds, g, S, E));
            SEAM(pb + PH_WIN);
        }
        if (IN(pb + PH_HYPRE)) {
            DUP(PH_HYPRE, hypre_phase(F, (const bf16*)(ws + WS_Z), KARG(I_HCW) + l * 3 * 768, KARG(I_HCB) + l * 768, (bf16*)(ws + WS_VVT), (bf16*)(ws + WS_X0T), last ? 2048 : 2048 + 128));
            SEAM(pb + PH_HYPRE);
        }
        if (IN(pb + PH_MIX)) { for (int rep_ = 0; rep_ < ((PROBE_DUP == PH_MIX) ? args.nrep : 1); ++rep_) { if (rep_ && PROBE_BAR) xcd_barrier(bar); mix_phase(F, l, lds, l + 4 * rep_, last ? NUNITS_X_LAST : NUNITS_X); } SEAM(pb + PH_MIX); }
        if (IN(pb + PH_HYPOST)) { DUP(PH_HYPRE, hypost_phase(F, (const bf16*)(ws + WS_YT), (bf16*)(ws + WS_MIX), last ? 2048 : 2048 + 128)); SEAM(pb + PH_HYPOST); }
        if (IN(pb + PH_WOUT)) {
            pg8::Gemm g{(const bf16*)(ws + WS_MIX), (const bf16*)(ws + WS_WOUT) + (size_t)l * DM * DM, MT, DM, DM, DM}; pg8::Sched2 S; S.init(MR / 256, DM / 256, F.G, (int)blockIdx.x);
            if (l == 0) { pg8::EpiRes<true> E{KARG(I_X), KARG(I_CTX), Hl, Hc, mods_l + 2 * 1024, 1.0f}; pg8::gemm_phase<pg8::EpiRes<true>, pg8::Sched2, true, true>(F.lds, g, S, E); }
            else { pg8::EpiRes<false> E{Hl, Hc, Hl, Hc, mods_l + 2 * 1024, 1.0f}; pg8::gemm_phase<pg8::EpiRes<false>, pg8::Sched2, true, true>(F.lds, g, S, E); }
            { const int mine = ((int)blockIdx.x < S.nwg) ? (S.nwg - 1 - (int)blockIdx.x) / F.G + 1 : 0; if (fill_li >= 0 && mine * F.G < S.nwg + F.G - 1 - (S.nwg + F.G - 1) % F.G) moe_filler(F, fill_li, 8); }
            SEAM(pb + PH_WOUT);
        }
        if (IN(pb + PH_NORM2)) {
            Comb cb{}; Pend pd{};
            if (moe) { norm_phase<true, false, true, false, true>(F, Hl, Hc, KARG(I_GFFN) + l * DM, mods_l, 3, U, KARG(I_ROUTER) + (size_t)li * DM * 8, route, cnt, MR, cb, pd); __syncthreads(); moe_filler(F, li, 1 << 30); }
            else if ((DENSE_F8_MASK >> li) & 1) { norm_phase<false, false, true, false, true>(F, Hl, Hc, KARG(I_GFFN) + l * DM, mods_l, 3, U, nullptr, nullptr, nullptr, MR, cb, pd); }
            else { norm_phase<false, false, true, false, false>(F, Hl, Hc, KARG(I_GFFN) + l * DM, mods_l, 3, U, nullptr, nullptr, nullptr, MR, cb, pd); }
            SEAM(pb + PH_NORM2);
        }
        if (moe) {
            int tb[9];
            if (IN(pb + PH_GATHER)) { moe_tile_base(cnt, tb); DUP(PH_GATHER, gather_phase(F, (const unsigned char*)U, route, tb, (unsigned char*)(ws + WS_AS8), MR)); SEAM(pb + PH_GATHER); }
            if (IN(pb + PH_UP)) {
                moe_tile_base(cnt, tb);
                pg8::Gemm g{(const bf16*)(ws + WS_AS8), (const bf16*)(ws + WS_MWGU + (size_t)li * 8 * 2 * DFE * DM), MOE_ROWS, 2 * DFE, DM / 2, DM / 2}; pg8::Sched2 S; S.init(tb[8], 2 * DFE / 256, F.G, (int)blockIdx.x); S.moe = 1; S.wgm = 8;
#pragma unroll
                for (int e = 0; e < 9; ++e) S.tb[e] = tb[e];
                DUP(PH_UP, pg8::EpiSwiGLU8 E{(unsigned char*)(ws + WS_HID), DFE, (PROBE_DRY && rep_) ? 1 : 0}; pg8::gemm_phase<pg8::EpiSwiGLU8, pg8::Sched2, true, true, true>(F.lds, g, S, E));
                SEAM(pb + PH_UP);
            }
            if (IN(pb + PH_DOWN)) {
                moe_tile_base(cnt, tb);
                pg8::Gemm g{(const bf16*)(ws + WS_HID), (const bf16*)(ws + WS_MWD + (size_t)li * 8 * DM * DFE), MOE_ROWS, DM, DFE / 2, DFE / 2}; pg8::Sched2 S; S.init(tb[8], DM / 256, F.G, (int)blockIdx.x); S.moe = 1; S.wgm = 8;
#pragma unroll
                for (int e = 0; e < 9; ++e) S.tb[e] = tb[e];
                pg8::EpiBf E{(bf16*)(ws + WS_AS), DM, 1.0f / (pg8::F8_SH * pg8::F8_SWD)};
                pg8::gemm_phase<pg8::EpiBf, pg8::Sched2, true, true, true>(F.lds, g, S, E);
                { const int mine = ((int)blockIdx.x < S.nwg) ? (S.nwg - 1 - (int)blockIdx.x) / F.G + 1 : 0; if (fill_li >= 0 && mine * F.G < S.nwg + F.G - 1 - (S.nwg + F.G - 1) % F.G) moe_filler(F, fill_li, 7); }
                SEAM(pb + PH_DOWN);
            }
        } else {
            if (IN(pb + PH_UP)) {
                pg8::Sched2 S; S.init(MT / 256, 2 * DFF / 256, F.G, (int)blockIdx.x);
                if ((DENSE_F8_MASK >> li) & 1) { S.wgm = 8; pg8::Gemm g{U, (const bf16*)(ws + WS_WGU) + (size_t)li * 2 * DFF * DM, MT, 2 * DFF, DM / 2, DM / 2};
                    pg8::EpiSwiGLU8 E{(unsigned char*)(ws + WS_HID), DFF, 0}; pg8::gemm_phase<pg8::EpiSwiGLU8, pg8::Sched2, true, true, true>(F.lds, g, S, E); }
                else { pg8::Gemm g{U, (const bf16*)(ws + WS_WGU) + (size_t)li * 2 * DFF * DM, MT, 2 * DFF, DM, DM};
                    pg8::EpiSwiGLU E{(bf16*)(ws + WS_HID), DFF, 0}; pg8::gemm_phase<pg8::EpiSwiGLU, pg8::Sched2, true, true>(F.lds, g, S, E); }
                SEAM(pb + PH_UP);
            }
            if (IN(pb + PH_DOWN)) {
                pg8::Sched2 S; S.init(MT / 256, DM / 256, F.G, (int)blockIdx.x);
                if ((DENSE_F8_MASK >> li) & 1) { S.wgm = 8; pg8::Gemm g{(const bf16*)(ws + WS_HID), (const bf16*)(ws + WS_WD) + (size_t)li * DM * DFF, MT, DM, DFF / 2, DFF / 2};
                    pg8::EpiRes<false> E{Hl, Hc, Hl, Hc, mods_l + 5 * 1024, 1.0f / (pg8::F8_SH * pg8::F8_SWD)}; pg8::gemm_phase<pg8::EpiRes<false>, pg8::Sched2, true, true, true>(F.lds, g, S, E); }
                else { pg8::Gemm g{(const bf16*)(ws + WS_HID), (const bf16*)(ws + WS_WD) + (size_t)li * DM * DFF, MT, DM, DFF, DFF};
                    pg8::EpiRes<false> E{Hl, Hc, Hl, Hc, mods_l + 5 * 1024, 1.0f}; pg8::gemm_phase<pg8::EpiRes<false>, pg8::Sched2, true, true>(F.lds, g, S, E); }
                { const int mine = ((int)blockIdx.x < S.nwg) ? (S.nwg - 1 - (int)blockIdx.x) / F.G + 1 : 0; if (fill_li >= 0 && mine * F.G < S.nwg + F.G - 1 - (S.nwg + F.G - 1) % F.G) moe_filler(F, fill_li, 20); }
                SEAM(pb + PH_DOWN);
            }
        }
    }
    if (IN(NPHASES - 1)) { Comb cb; cb.route = route; cb.Y = (const bf16*)(ws + WS_AS); cb.gate = mods + (size_t)3 * 9 * 6144 + 5 * 1024; moe_tile_base(F.ctl + CW_CNT + 64 * 8, cb.tb); final_phase(F, Hl, KOUT(), KARG(I_GFINAL), cb); }
    if (PROBE_DUP == 101) { for (int rep_ = 0; rep_ < 10 * args.nrep; ++rep_) xcd_barrier(bar); }
#ifdef PROBE_P0
    if (blockIdx.x == 0) { const unsigned long long now0_ = rt(); while (rt() - now0_ < 64ull * p0acc) __builtin_amdgcn_s_sleep(8); }
#endif
    if (PROBE_IDLE) { xcd_barrier(bar); if (blockIdx.x == 0) { const unsigned long long tot_ = *(volatile unsigned long long*)(ws + WS_ROPE + 32768); const unsigned long long now1_ = rt(); while (rt() - now1_ < (unsigned long long)PROBE_TK * tot_ / 256ull) __builtin_amdgcn_s_sleep(8); } }
    if (PROBE_TSEL) { const unsigned long long now_ = rt(); if ((PROBE_TSEL >> 13) & 1) tacc_ += now_ - tprev_; if (blockIdx.x == 0) { while (rt() - now_ < (unsigned long long)PROBE_TK * tacc_) __builtin_amdgcn_s_sleep(8); } }
#undef IN
#undef SEAM
}

#ifndef MK_MULTI
#define MK_MULTI 0
#endif
extern "C" void kernel_launch(void* const* d_in, const int* in_sizes, int n_in, void* d_out, int out_size, void* d_ws, size_t ws_size, hipStream_t stream) {
    static int grid = 0;
    if (grid == 0) {
        if (n_in != 34 || out_size != ML * DM || ws_size < WS_END) { fprintf(stderr, "kernel_launch: unexpected problem (n_in %d, out %d, ws %zu < %zu)\n", n_in, out_size, ws_size, (size_t)WS_END); grid = -1; return; }
        int dev = 0, cus = 0, per_cu = 0;
        if (hipGetDevice(&dev) != hipSuccess || hipDeviceGetAttribute(&cus, hipDeviceAttributeMultiprocessorCount, dev) != hipSuccess) { grid = -1; return; }
        if (hipFuncSetAttribute((const void*)trunk_fwd, hipFuncAttributeMaxDynamicSharedMemorySize, LDS_BYTES) != hipSuccess) { fprintf(stderr, "kernel_launch: hipFuncSetAttribute failed\n"); grid = -1; return; }
        if (hipOccupancyMaxActiveBlocksPerMultiprocessor(&per_cu, (const void*)trunk_fwd, NWAVES * 64, LDS_BYTES) != hipSuccess || per_cu < 1) { fprintf(stderr, "kernel_launch: occupancy query says %d\n", per_cu); (void)hipGetLastError(); per_cu = 1; }
        grid = cus;
    }
    if (grid < 0) return;
    (void)hipMemsetAsync((char*)d_ws + WS_CTL, 0, CTL_ZERO_BYTES, stream);
    Args a{};
    for (int i = 0; i < 34; ++i) a.p.in[i] = (const float*)d_in[i];
    a.p.out = (float*)d_out; a.p.ws = (unsigned char*)d_ws;
#if MK_MULTI
    for (int ph = 0; ph < NPHASES; ++ph) {
        if (ph >= 1 && ph < NPHASES - 1) { const int l = (ph - 1) / NPL, k = (ph - 1) % NPL; if (!(l & 1) && (k == PH_GATHER || k == PH_COMBINE)) continue; }
        a.ph_lo = ph; a.ph_hi = ph + 1; a.use_bar = 0;
        hipLaunchKernelGGL(trunk_fwd, dim3(grid), dim3(NWAVES * 64), LDS_BYTES, stream, a);
    }
#else
    a.ph_lo = 0; a.ph_hi = NPHASES; a.use_bar = 1; a.nrep = 2;
    hipLaunchKernelGGL(trunk_fwd, dim3(grid), dim3(NWAVES * 64), LDS_BYTES, stream, a);
#endif
}
```

```cpp
#include <hip/hip_runtime.h>
#include <hip/hip_bf16.h>
#include <cstdio>
#include <cstdint>
#include <cmath>
__device__ __forceinline__ float shx(float v, int o, int lane) { return __int_as_float(__builtin_amdgcn_ds_bpermute((lane ^ o) << 2, __float_as_int(v))); }
typedef unsigned wt_u32x4 __attribute__((ext_vector_type(4)));
typedef unsigned wt_u32x2 __attribute__((ext_vector_type(2)));
__device__ __forceinline__ void st_wt16(void* p, wt_u32x4 v) { *(wt_u32x4*)p = v; }
__device__ __forceinline__ void st_wt8(void* p, wt_u32x2 v) { *(wt_u32x2*)p = v; }
__device__ __forceinline__ void st_wt4(void* p, unsigned v) { *(unsigned*)p = v; }
#define ATTN_STORE16(p,v) st_wt16((void*)(p), (v))
namespace pg8 {
#define PG8_LAS __attribute__((address_space(3)))
typedef unsigned short bf16_t;
typedef short bf16x8 __attribute__((ext_vector_type(8)));
typedef float f32x4 __attribute__((ext_vector_type(4)));
typedef unsigned u32x4 __attribute__((ext_vector_type(4)));
constexpr int BM = 256, BK = 64, HALF = 128, HTB = HALF * BK * 2  , STAGE_BYTES = 8 * HTB, NXCD = 8, WGM = 4;

__host__ __device__ __forceinline__ int lds_byte(int r, int c) { const int st = (r >> 4) * 2 + (c >> 5), rr = r & 15, cc = c & 31, ob = rr * 64 + cc * 2; return st * 1024 + (ob ^ (((ob >> 9) & 1) << 5)); }
__host__ __device__ __forceinline__ void stage_rc(int b, int& R, int& C) { const int st = b / 1024, sb = b % 1024, swz = sb ^ (((sb >> 9) & 1) << 5); R = (st >> 1) * 16 + swz / 64; C = (st & 1) * 32 + (swz % 64) / 2; }
__host__ __device__ __forceinline__ int perm32(int rho) { const int n = rho >> 4, i = rho & 15; return 8 * (i >> 2) + 4 * n + (i & 3); }

__host__ __device__ __forceinline__ int lds_byte8(int r, int cb) { const int st = (r >> 4) * 2 + (cb >> 6), rr = r & 15, ch = ((cb >> 4) & 3) ^ ((rr >> 3) & 1); return st * 1024 + rr * 64 + ch * 16 + (cb & 15); }
__host__ __device__ __forceinline__ void stage_rc8(int b, int& R, int& C) { const int st = b / 1024, sb = b % 1024, rr = sb / 64, ch = ((sb % 64) / 16) ^ ((rr >> 3) & 1); R = (st >> 1) * 16 + rr; C = ((st & 1) * 64 + ch * 16) / 2; }
typedef int v4i_t __attribute__((ext_vector_type(4)));
typedef int v8i_t __attribute__((ext_vector_type(8)));
__device__ __forceinline__ v8i_t cat8(bf16x8 lo, bf16x8 hi) { return __builtin_shufflevector(__builtin_bit_cast(v4i_t, lo), __builtin_bit_cast(v4i_t, hi), 0, 1, 2, 3, 4, 5, 6, 7); }
__device__ __forceinline__ unsigned pk_fp8x4(float a, float b, float c, float d) {
    a = __builtin_amdgcn_fmed3f(a, -448.f, 448.f); b = __builtin_amdgcn_fmed3f(b, -448.f, 448.f); c = __builtin_amdgcn_fmed3f(c, -448.f, 448.f); d = __builtin_amdgcn_fmed3f(d, -448.f, 448.f);
    unsigned w = 0u; w = __builtin_amdgcn_cvt_pk_fp8_f32(a, b, w, false); w = __builtin_amdgcn_cvt_pk_fp8_f32(c, d, w, true); return w; }
struct Unit { int pm, pn, pnl, e, ko, sl, pa; };
struct Gemm { const bf16_t* A; const bf16_t* Bt; int M, N, K, ld; };

__device__ __forceinline__ unsigned cvt_pk_bf16(float lo, float hi) { unsigned r; asm volatile("v_cvt_pk_bf16_f32 %0, %1, %2" : "=v"(r) : "v"(lo), "v"(hi)); return r; }
constexpr int P_ML = 32768, P_ZP = 2304, P_D = 1024, P_MODS = 6144;
constexpr float P_EPS = 1e-6f;
constexpr float C2D = 0.17677669529663687f * 1.4426950408889634f;
constexpr float C2G = 0.125f * 1.4426950408889634f;

struct Sched2 {
    int nM, nN, nwg, G, c, moe, wgm, rev, capt; int tb[9];
    __device__ __forceinline__ void init(int nM_, int nN_, int G_, int c_) { nM = nM_; nN = nN_; nwg = nM * nN; G = G_; c = c_; moe = 0; wgm = WGM; rev = 0; capt = 0; }
    __device__ __forceinline__ bool next(int i, Unit& u) const {
        const long L = (long)i * G + c; if (L >= nwg) return false;
        int wgid = (int)L; { const int q = nwg / NXCD, r = nwg % NXCD, xcd = wgid % NXCD, off = wgid / NXCD; wgid = (xcd < r ? xcd * (q + 1) : r * (q + 1) + (xcd - r) * q) + off; }
        const int nig = wgm * nN, gid = wgid / nig, fm = gid * wgm, gsz = (nM - fm) < wgm ? (nM - fm) : wgm;
        u.pm = fm + ((wgid % nig) % gsz); u.pnl = (wgid % nig) / gsz; if (rev) u.pm = nM - 1 - u.pm;
        int e = 0, tbe = 0;
        if (moe) {
#pragma unroll
            for (int k = 1; k < 8; ++k) { const bool ge = u.pm >= tb[k]; e += ge ? 1 : 0; tbe = ge ? tb[k] : tbe; }
        }
        u.e = e; u.pn = e * nN + u.pnl; u.ko = 0; u.sl = 0; u.pa = capt ? e * capt + (u.pm - tbe) : u.pm; return true;
    }
    __device__ __forceinline__ void a_ready(const Unit&) const {}
    __device__ __forceinline__ void done(const Unit&) const {}
};

struct SchedTail {
    int S, Kp, G, c;
    __device__ __forceinline__ bool next(int i, Unit& u) const {
        const int q = i * G + c; if (q >= 32 * S) return false;
        const int tu = q / S, sl = q - tu * S;
        u.pm = 128 + (tu >> 2); u.pnl = tu & 3; u.pn = u.pnl; u.e = 0; u.ko = sl * Kp; u.sl = sl; u.pa = u.pm; return true;
    }
    __device__ __forceinline__ void a_ready(const Unit&) const {}
    __device__ __forceinline__ void done(const Unit&) const {}
};
struct EpiPart {
    static constexpr bool PERM = false, AFTER_DRAIN = false;
    float* P; int S;
    __device__ __forceinline__ void operator()(const f32x4 (&acc)[2][2][4][2], const Unit& u, int wr, int wc, int fr, int fq) const {
        float* base = P + (size_t)((((u.pm - 128) << 2) + u.pnl) * S + u.sl) * 65536;
        const int row0 = wr * 64 + fr, col0 = wc * 32 + 4 * fq;
#pragma unroll
        for (int ai = 0; ai < 2; ++ai)
#pragma unroll
            for (int m = 0; m < 4; ++m) { float* rowp = base + (size_t)(row0 + ai * HALF + m * 16) * 256 + col0;
#pragma unroll
                for (int bj = 0; bj < 2; ++bj)
#pragma unroll
                    for (int n = 0; n < 2; ++n) *(f32x4*)(rowp + bj * HALF + n * 16) = acc[ai][bj][m][n]; }
    }
};

struct EpiWin {
    static constexpr bool PERM = true, AFTER_DRAIN = false;
    bf16_t* Z; const PG8_LAS float* rope;
    const float* qn; const float* kn; unsigned* dmax;
    __device__ __forceinline__ void operator()(const f32x4 (&acc)[2][2][4][2], const Unit& u, int wr, int wc, int fr, int fq) const {
        const int pn = u.pnl, pm = u.pm; const bool lat = pm < 128;
        int kind;
        if (pn == 3 || pn == 4) kind = 1; else if (pn == 6 || pn == 7) kind = 2; else if (pn == 8) kind = (wc < 2) ? 2 : 3; else kind = 0;
        const PG8_LAS float* Cd = rope; const PG8_LAS float* Sd = rope + 512; const PG8_LAS float* Cg = rope + 1024; const PG8_LAS float* Sg = rope + 2048;
        float dn = 0.f;
        float gn0[8], gn1[8];
        if (kind == 2) { const float* gp = (pn == 8) ? kn : qn;
#pragma unroll
            for (int j = 0; j < 8; ++j) { gn0[j] = gp[8 * fq + j]; gn1[j] = gp[32 + 8 * fq + j]; } }
#pragma unroll
        for (int ai = 0; ai < 2; ++ai)
#pragma unroll
            for (int m = 0; m < 4; ++m) {
                const int row = pm * BM + ai * HALF + wr * 64 + m * 16 + fr;
                const int grow = (4 * pm + 2 * ai + wr) & 63, gcol = 16 * m + fr;
                float x0[8], x1[8];
#pragma unroll
                for (int j = 0; j < 8; ++j) { x0[j] = acc[ai][0][m][j >> 2][j & 3]; x1[j] = acc[ai][1][m][j >> 2][j & 3]; }
                bf16_t* zr = Z + (size_t)row * P_ZP;
                int col0, col1;
                if (kind == 0) { col0 = pn * 256 + wc * 32 + 8 * fq; col1 = col0 + 128; }
                else if (kind == 3) { col0 = pn * 256 + wc * 64 + 8 * fq; col1 = col0 + 32; }
                else if (kind == 1) {
                    col0 = pn * 256 + wc * 64 + 32 * (fq >> 1) + 8 * (fq & 1); col1 = col0 + 16;
                    const float sc = (pn == 3) ? C2D : 1.0f;
                    if (lat) { const int pos = (fq & 1) ? gcol : grow;
                        const f32x4 c0 = *(const PG8_LAS f32x4*)(Cd + pos * 8), c1 = *(const PG8_LAS f32x4*)(Cd + pos * 8 + 4), s0 = *(const PG8_LAS f32x4*)(Sd + pos * 8), s1 = *(const PG8_LAS f32x4*)(Sd + pos * 8 + 4);
#pragma unroll
                        for (int j = 0; j < 8; ++j) { const float c = j < 4 ? c0[j & 3] : c1[j & 3], s = j < 4 ? s0[j & 3] : s1[j & 3]; const float a = x0[j], b = x1[j]; x0[j] = (a * c - b * s) * sc; x1[j] = (a * s + b * c) * sc; }
                    } else {
#pragma unroll
                        for (int j = 0; j < 8; ++j) { x0[j] *= sc; x1[j] *= sc; }
                    }
                    { float nn = 0.f;
#pragma unroll
                        for (int j = 0; j < 8; ++j) nn += x0[j] * x0[j] + x1[j] * x1[j];
                        nn += shx(nn, 16, fq * 16 + fr); dn = fmaxf(dn, nn); }
                } else {
                    col0 = pn * 256 + wc * 64 + 8 * fq; col1 = col0 + 32;
                    float ss = 0.f;
#pragma unroll
                    for (int j = 0; j < 8; ++j) ss += x0[j] * x0[j] + x1[j] * x1[j];
                    { const int ln = fq * 16 + fr; ss += shx(ss, 16, ln); ss += shx(ss, 32, ln); }
                    const float rn = __builtin_amdgcn_rsqf(ss * (1.0f / 64.0f) + P_EPS);
                    const float sc = (pn == 8) ? 1.0f : C2G;
#pragma unroll
                    for (int j = 0; j < 8; ++j) { x0[j] = x0[j] * rn * gn0[j]; x1[j] = x1[j] * rn * gn1[j]; }
                    if (lat) { const int pos = (fq < 2) ? grow : gcol; const int fo = pos * 16 + 8 * (fq & 1);
                        const f32x4 c0 = *(const PG8_LAS f32x4*)(Cg + fo), c1 = *(const PG8_LAS f32x4*)(Cg + fo + 4), s0 = *(const PG8_LAS f32x4*)(Sg + fo), s1 = *(const PG8_LAS f32x4*)(Sg + fo + 4);
#pragma unroll
                        for (int j = 0; j < 8; ++j) { const float c = j < 4 ? c0[j & 3] : c1[j & 3], s = j < 4 ? s0[j & 3] : s1[j & 3]; const float a = x0[j], b = x1[j]; x0[j] = (a * c - b * s) * sc; x1[j] = (a * s + b * c) * sc; }
                    } else {
#pragma unroll
                        for (int j = 0; j < 8; ++j) { x0[j] *= sc; x1[j] *= sc; }
                    }
                }
                u32x4 w0, w1;
                w0.x = cvt_pk_bf16(x0[0], x0[1]); w0.y = cvt_pk_bf16(x0[2], x0[3]); w0.z = cvt_pk_bf16(x0[4], x0[5]); w0.w = cvt_pk_bf16(x0[6], x0[7]);
                w1.x = cvt_pk_bf16(x1[0], x1[1]); w1.y = cvt_pk_bf16(x1[2], x1[3]); w1.z = cvt_pk_bf16(x1[4], x1[5]); w1.w = cvt_pk_bf16(x1[6], x1[7]);
                st_wt16(zr + col0, w0); st_wt16(zr + col1, w1);
            }
        if (kind == 1) { const int ln = fq * 16 + fr;
            dn = fmaxf(dn, shx(dn, 1, ln)); dn = fmaxf(dn, shx(dn, 2, ln)); dn = fmaxf(dn, shx(dn, 4, ln)); dn = fmaxf(dn, shx(dn, 8, ln));
            if (fr == 0 && (fq & 1) == 0) { const int bb = lat ? (pm >> 4) : (pm - 128);
                (void)__hip_atomic_fetch_max(dmax + ((bb * 4 + wc) * 2 + (fq >> 1)) * 2 + (pn == 4 ? 1 : 0), __float_as_uint(dn), __ATOMIC_RELAXED, __HIP_MEMORY_SCOPE_AGENT); } }
    }
};

template <bool BASE_F32> struct EpiRes {
    static constexpr bool PERM = true, AFTER_DRAIN = false;
    const void* base_l; const void* base_c; bf16_t* out_l; bf16_t* out_c; const float* gate; float gs;
    __device__ __forceinline__ void operator()(const f32x4 (&acc)[2][2][4][2], const Unit& u, int wr, int wc, int fr, int fq) const {
        const bool lat = u.pm < 128; const int mi = lat ? (u.pm >> 4) : 8;
        const int row0 = (lat ? u.pm : (u.pm - 128)) * BM + wr * 64 + fr, col0 = u.pnl * BM + wc * 32 + 8 * fq;
        const void* bp = lat ? base_l : base_c; bf16_t* op = lat ? out_l : out_c;
        f32x4 gv[2][2];
#pragma unroll
        for (int bj = 0; bj < 2; ++bj)
#pragma unroll
            for (int n = 0; n < 2; ++n) gv[bj][n] = *(const f32x4*)(gate + mi * P_MODS + col0 + bj * HALF + n * 4) * gs;
#pragma unroll
        for (int ai = 0; ai < 2; ++ai) {
            f32x4 bq[4][2][2];
#pragma unroll
            for (int m = 0; m < 4; ++m) { const size_t off = (size_t)(row0 + ai * HALF + m * 16) * P_D + col0;
#pragma unroll
                for (int bj = 0; bj < 2; ++bj) {
                    if (BASE_F32) { bq[m][bj][0] = *(const f32x4*)((const float*)bp + off + bj * HALF); bq[m][bj][1] = *(const f32x4*)((const float*)bp + off + bj * HALF + 4); }
                    else { const u32x4 w = *(const u32x4*)((const bf16_t*)bp + off + bj * HALF);
                        bq[m][bj][0] = (f32x4){__uint_as_float(w.x << 16), __uint_as_float(w.x & 0xffff0000u), __uint_as_float(w.y << 16), __uint_as_float(w.y & 0xffff0000u)};
                        bq[m][bj][1] = (f32x4){__uint_as_float(w.z << 16), __uint_as_float(w.z & 0xffff0000u), __uint_as_float(w.w << 16), __uint_as_float(w.w & 0xffff0000u)}; } } }
            asm volatile("" ::: "memory");
#pragma unroll
            for (int m = 0; m < 4; ++m) { const size_t off = (size_t)(row0 + ai * HALF + m * 16) * P_D + col0;
#pragma unroll
                for (int bj = 0; bj < 2; ++bj) { const f32x4 v0 = bq[m][bj][0] + gv[bj][0] * acc[ai][bj][m][0], v1 = bq[m][bj][1] + gv[bj][1] * acc[ai][bj][m][1];
                    u32x4 w; w.x = cvt_pk_bf16(v0[0], v0[1]); w.y = cvt_pk_bf16(v0[2], v0[3]); w.z = cvt_pk_bf16(v1[0], v1[1]); w.w = cvt_pk_bf16(v1[2], v1[3]);
                    st_wt16(op + off + bj * HALF, w); } }
            asm volatile("" ::: "memory");
        }
    }
};

struct EpiSwiGLU {
    static constexpr bool PERM = true, AFTER_DRAIN = false;
    bf16_t* H; int ldh; int dry;
    __device__ __forceinline__ void operator()(const f32x4 (&acc)[2][2][4][2], const Unit& u, int wr, int wc, int fr, int fq) const {
        if (dry) { if (acc[0][0][0][0][0] == 1.2345e-30f) H[0] = 0; return; }
        const int row0 = u.pm * BM + wr * 64 + fr, col0 = u.pnl * HALF + wc * 32 + 8 * fq;
#pragma unroll
        for (int ai = 0; ai < 2; ++ai)
#pragma unroll
            for (int m = 0; m < 4; ++m) {
                typedef float f32x2p __attribute__((ext_vector_type(2)));
                float v[8];
#pragma unroll
                for (int j = 0; j < 8; j += 2) {
                    const f32x2p g = {acc[ai][0][m][j >> 2][j & 3], acc[ai][0][m][j >> 2][(j & 3) + 1]}, up = {acc[ai][1][m][j >> 2][j & 3], acc[ai][1][m][j >> 2][(j & 3) + 1]};
                    const f32x2p a = g * (-1.4426950408889634f);
                    f32x2p e; e.x = __builtin_amdgcn_exp2f(a.x); e.y = __builtin_amdgcn_exp2f(a.y);
                    const f32x2p d = e + 1.0f; f32x2p r; r.x = __builtin_amdgcn_rcpf(d.x); r.y = __builtin_amdgcn_rcpf(d.y);
                    const f32x2p o = (g * up) * r; v[j] = o.x; v[j + 1] = o.y; }
                u32x4 w; w.x = cvt_pk_bf16(v[0], v[1]); w.y = cvt_pk_bf16(v[2], v[3]); w.z = cvt_pk_bf16(v[4], v[5]); w.w = cvt_pk_bf16(v[6], v[7]);
                st_wt16(H + (size_t)(row0 + ai * HALF + m * 16) * ldh + col0, w);
            }
    }
};

constexpr float F8_SA = 4.0f, F8_SW = 32.0f, F8_SH = 4.0f, F8_SWD = 64.0f;
struct EpiSwiGLU8 {
    static constexpr bool PERM = true, AFTER_DRAIN = false;
    unsigned char* H; int ldh; int dry; float inv;
    __device__ __forceinline__ void operator()(const f32x4 (&acc)[2][2][4][2], const Unit& u, int wr, int wc, int fr, int fq) const {
        if (dry) { if (acc[0][0][0][0][0] == 1.2345e-30f) H[0] = 0; return; }
        const int row0 = u.pm * BM + wr * 64 + fr, col0 = u.pnl * HALF + wc * 32 + 8 * fq;
        const float c1 = -1.4426950408889634f * inv, rk = 1.0f / (inv * inv * F8_SH);
#pragma unroll
        for (int ai = 0; ai < 2; ++ai)
#pragma unroll
            for (int m = 0; m < 4; ++m) {
                float v[8];
#pragma unroll
                for (int j = 0; j < 8; j += 2) {
                    typedef float f32x2p __attribute__((ext_vector_type(2)));
                    const f32x2p ag = {acc[ai][0][m][j >> 2][j & 3], acc[ai][0][m][j >> 2][(j & 3) + 1]}, au = {acc[ai][1][m][j >> 2][j & 3], acc[ai][1][m][j >> 2][(j & 3) + 1]};
                    const f32x2p a = ag * c1; f32x2p e; e.x = __builtin_amdgcn_exp2f(a.x); e.y = __builtin_amdgcn_exp2f(a.y);
                    const f32x2p d = e * rk + rk; f32x2p r; r.x = __builtin_amdgcn_rcpf(d.x); r.y = __builtin_amdgcn_rcpf(d.y);
                    const f32x2p o = (ag * au) * r; v[j] = o.x; v[j + 1] = o.y; }
                typedef unsigned u32x2e __attribute__((ext_vector_type(2)));
                u32x2e w; w.x = pk_fp8x4(v[0], v[1], v[2], v[3]); w.y = pk_fp8x4(v[4], v[5], v[6], v[7]);
                st_wt8(H + (size_t)(row0 + ai * HALF + m * 16) * ldh + col0, w);
            }
    }
};
struct EpiBf {
    static constexpr bool PERM = true, AFTER_DRAIN = false;
    bf16_t* O; int ldc; float sc;
    __device__ __forceinline__ void operator()(const f32x4 (&acc)[2][2][4][2], const Unit& u, int wr, int wc, int fr, int fq) const {
        const int row0 = u.pm * BM + wr * 64 + fr, col0 = u.pnl * BM + wc * 32 + 8 * fq;
#pragma unroll
        for (int ai = 0; ai < 2; ++ai)
#pragma unroll
            for (int m = 0; m < 4; ++m) { bf16_t* rowp = O + (size_t)(row0 + ai * HALF + m * 16) * ldc + col0;
#pragma unroll
                for (int bj = 0; bj < 2; ++bj) { const f32x4 v0 = acc[ai][bj][m][0] * sc, v1 = acc[ai][bj][m][1] * sc;
                    u32x4 w; w.x = cvt_pk_bf16(v0[0], v0[1]); w.y = cvt_pk_bf16(v0[2], v0[3]); w.z = cvt_pk_bf16(v1[0], v1[1]); w.w = cvt_pk_bf16(v1[2], v1[3]);
                    st_wt16(rowp + bj * HALF, w); } }
    }
};
template <class Epi, class Sched, bool ALIGN_EPI = false, bool SP2 = false, bool FP8 = false>
__device__ __forceinline__ void gemm_phase(PG8_LAS unsigned char* lds, const Gemm g, const Sched& S, const Epi& E) {
    int tid_ = threadIdx.x; asm volatile("" : "+v"(tid_));
    const int tid = tid_, wid = __builtin_amdgcn_readfirstlane(tid >> 6), lane = tid & 63, wr = wid >> 2, wc = wid & 3, fr = lane & 15, fq = lane >> 4;
    const int K = g.ld, nt = g.K / BK;
    unsigned voffA[2], voffB[2];
#pragma unroll
    for (int i = 0; i < 2; ++i) { int R, C; if constexpr (FP8) stage_rc8(tid * 16 + i * 8192, R, C); else stage_rc(tid * 16 + i * 8192, R, C); const int Rb = Epi::PERM ? ((R & ~31) + perm32(R & 31)) : R;
        voffA[i] = (unsigned)(R * K + C) * 2u; voffB[i] = (unsigned)(Rb * K + C) * 2u; }
    const size_t kstep = (size_t)(BK * 2);
    const size_t hstep = (size_t)HALF * K * 2;
    const size_t tstep = 2 * hstep;
    const unsigned ldsw = (unsigned)wid * 1024u;
    int aoff, boff, aoff1 = 0, boff1 = 0;
    if constexpr (FP8) { aoff = lds_byte8(wr * 64 + fr, 32 * fq); aoff1 = lds_byte8(wr * 64 + fr, 32 * fq + 16); boff = lds_byte8(wc * 32 + fr, 32 * fq); boff1 = lds_byte8(wc * 32 + fr, 32 * fq + 16); }
    else { aoff = lds_byte(wr * 64 + fr, fq * 8); boff = lds_byte(wc * 32 + fr, fq * 8); }
#define PG8_SA(b, h) (((b) * 2 + (h)) * HTB)
#define PG8_SB(b, h) ((4 + (b) * 2 + (h)) * HTB)
#define PG8_STAGE(bufoff, gbase, voff) do { _Pragma("unroll") for (int _i = 0; _i < 2; ++_i) { unsigned _vo = (voff)[_i]; asm volatile("" : "+v"(_vo));     \
        __builtin_amdgcn_global_load_lds((const unsigned*)((const char*)(gbase) + _vo), (PG8_LAS unsigned*)(lds + (bufoff) + ldsw + _i * 8192), 16, 0, 0); } } while (0)
#define PG8_LDA(dst, b, h) do { if constexpr (FP8) { _Pragma("unroll") for (int m = 0; m < 4; ++m) dst##8[m] = __builtin_shufflevector(*(const PG8_LAS v4i_t*)(lds + PG8_SA(b, h) + aoff + m * 2048), *(const PG8_LAS v4i_t*)(lds + PG8_SA(b, h) + aoff1 + m * 2048), 0, 1, 2, 3, 4, 5, 6, 7); } \
    else { _Pragma("unroll") for (int m = 0; m < 4; ++m) _Pragma("unroll") for (int k = 0; k < 2; ++k) dst[m][k] = *(const PG8_LAS bf16x8*)(lds + PG8_SA(b, h) + aoff + m * 2048 + k * 1024); } } while (0)
#define PG8_LDB(dst, b, h) do { if constexpr (FP8) { _Pragma("unroll") for (int n = 0; n < 2; ++n) dst##8[n] = __builtin_shufflevector(*(const PG8_LAS v4i_t*)(lds + PG8_SB(b, h) + boff + n * 2048), *(const PG8_LAS v4i_t*)(lds + PG8_SB(b, h) + boff1 + n * 2048), 0, 1, 2, 3, 4, 5, 6, 7); } \
    else { _Pragma("unroll") for (int n = 0; n < 2; ++n) _Pragma("unroll") for (int k = 0; k < 2; ++k) dst[n][k] = *(const PG8_LAS bf16x8*)(lds + PG8_SB(b, h) + boff + n * 2048 + k * 1024); } } while (0)
#define PG8_MMA(ai, bj, At, Bt) do { if constexpr (FP8) __builtin_amdgcn_sched_barrier(0); __builtin_amdgcn_s_setprio(1); _Pragma("unroll") for (int m = 0; m < 4; ++m) _Pragma("unroll") for (int n = 0; n < 2; ++n) { \
        if constexpr (FP8) { acc[ai][bj][m][n] = __builtin_amdgcn_mfma_scale_f32_16x16x128_f8f6f4(Bt##8[n], At##8[m], acc[ai][bj][m][n], 0, 0, 0, 0x7f7f7f7f, 0, 0x7f7f7f7f); } \
        else { _Pragma("unroll") for (int k = 0; k < 2; ++k) acc[ai][bj][m][n] = __builtin_amdgcn_mfma_f32_16x16x32_bf16(Bt[n][k], At[m][k], acc[ai][bj][m][n], 0, 0, 0); } } __builtin_amdgcn_s_setprio(0); if constexpr (FP8) __builtin_amdgcn_sched_barrier(0); } while (0)
#define PG8_WAIT_V(n) asm volatile("s_waitcnt vmcnt(" #n ")" ::: "memory")
#define PG8_WAIT_L(n) asm volatile("s_waitcnt lgkmcnt(" #n ")" ::: "memory")
#define PG8_BAR __builtin_amdgcn_s_barrier()
#define PG8_SCHED __builtin_amdgcn_sched_barrier(0)
    Unit cur, nxt; int ui = 0;
    if (!S.next(0, cur)) return;
    f32x4 acc[2][2][4][2];
#pragma unroll
    for (int a = 0; a < 2; ++a)
#pragma unroll
        for (int b = 0; b < 2; ++b)
#pragma unroll
            for (int m = 0; m < 4; ++m)
#pragma unroll
                for (int n = 0; n < 2; ++n) acc[a][b][m][n] = (f32x4){0.f, 0.f, 0.f, 0.f};
    bf16x8 At[4][2], B0[2][2], B1[2][2];
    v8i_t At8[4], B08[2], B18[2];
    const char* cA = (const char*)g.A + (size_t)cur.pa * tstep + (size_t)cur.ko * 2; const char* cB = (const char*)g.Bt + (size_t)cur.pn * tstep + (size_t)cur.ko * 2;
    S.a_ready(cur);
    if constexpr (SP2) {
        PG8_STAGE(PG8_SB(0, 0), cB, voffB); PG8_STAGE(PG8_SB(0, 1), cB + hstep, voffB); PG8_STAGE(PG8_SA(0, 0), cA, voffA); PG8_STAGE(PG8_SA(0, 1), cA + hstep, voffA);
        if (wr == 1) PG8_BAR;
        PG8_WAIT_V(2); PG8_BAR;
        PG8_STAGE(PG8_SB(1, 0), cB + kstep, voffB); PG8_STAGE(PG8_SA(1, 0), cA + kstep, voffA); PG8_STAGE(PG8_SB(1, 1), cB + hstep + kstep, voffB);
        PG8_WAIT_V(6); PG8_BAR;
    } else {
        PG8_STAGE(PG8_SB(0, 0), cB, voffB); PG8_STAGE(PG8_SA(0, 0), cA, voffA); PG8_STAGE(PG8_SB(0, 1), cB + hstep, voffB); PG8_STAGE(PG8_SA(0, 1), cA + hstep, voffA);
        if (wr == 1) PG8_BAR;
        PG8_WAIT_V(4); PG8_BAR;
        PG8_STAGE(PG8_SB(1, 0), cB + kstep, voffB); PG8_STAGE(PG8_SA(1, 0), cA + kstep, voffA); PG8_STAGE(PG8_SB(1, 1), cB + hstep + kstep, voffB);
        PG8_WAIT_V(6); PG8_BAR;
    }
    for (;;) {
        const bool has_next = S.next(ui + 1, nxt);
        const char* nA = has_next ? (const char*)g.A + (size_t)nxt.pa * tstep + (size_t)nxt.ko * 2 : cA; const char* nB = has_next ? (const char*)g.Bt + (size_t)nxt.pn * tstep + (size_t)nxt.ko * 2 : cB;
#pragma nounroll
        for (int t = 0; t < nt; t += 2) {
            const bool last = (t == nt - 2);
            const char* a1 = cA + (size_t)(t + 1) * kstep;
            const char* a2 = last ? nA : cA + (size_t)(t + 2) * kstep; const char* b2 = last ? nB : cB + (size_t)(t + 2) * kstep;
            const char* a3 = a2 + kstep; const char* b3 = b2 + kstep;
            if (last && has_next) S.a_ready(nxt);
            if constexpr (SP2) {
            PG8_LDB(B0, 0, 0); PG8_LDB(B1, 0, 1); PG8_SCHED; PG8_LDA(At, 0, 0); PG8_STAGE(PG8_SA(1, 1), a1 + hstep, voffA);
            PG8_WAIT_V(8); PG8_WAIT_L(0); PG8_BAR; PG8_MMA(0, 0, At, B0); PG8_MMA(0, 1, At, B1); PG8_BAR; PG8_SCHED;
            PG8_LDA(At, 0, 1); PG8_STAGE(PG8_SB(0, 0), b2, voffB); PG8_STAGE(PG8_SB(0, 1), b2 + hstep, voffB); PG8_STAGE(PG8_SA(0, 0), a2, voffA);
            PG8_WAIT_V(8); PG8_WAIT_L(0); PG8_BAR; PG8_MMA(1, 0, At, B0); PG8_MMA(1, 1, At, B1); PG8_BAR; PG8_SCHED;
            PG8_LDB(B0, 1, 0); PG8_LDB(B1, 1, 1); PG8_SCHED; PG8_LDA(At, 1, 0); PG8_STAGE(PG8_SA(0, 1), a2 + hstep, voffA);
            PG8_WAIT_V(8); PG8_WAIT_L(0); PG8_BAR; PG8_MMA(0, 0, At, B0); PG8_MMA(0, 1, At, B1); PG8_BAR; PG8_SCHED;
            PG8_LDA(At, 1, 1); PG8_STAGE(PG8_SB(1, 0), b3, voffB); PG8_STAGE(PG8_SB(1, 1), b3 + hstep, voffB); PG8_STAGE(PG8_SA(1, 0), a3, voffA);
            PG8_WAIT_V(8); PG8_WAIT_L(0); PG8_BAR; PG8_MMA(1, 0, At, B0); PG8_MMA(1, 1, At, B1); PG8_BAR; PG8_SCHED;
            } else {
            PG8_LDB(B0, 0, 0); PG8_SCHED; PG8_LDA(At, 0, 0); PG8_STAGE(PG8_SA(1, 1), a1 + hstep, voffA);
            PG8_WAIT_L(8); PG8_BAR; PG8_WAIT_L(0); PG8_MMA(0, 0, At, B0); PG8_BAR; PG8_SCHED;
            PG8_LDB(B1, 0, 1); PG8_STAGE(PG8_SB(0, 0), b2, voffB);
            PG8_BAR; PG8_WAIT_L(0); PG8_MMA(0, 1, At, B1); PG8_BAR;
            PG8_LDA(At, 0, 1); PG8_STAGE(PG8_SA(0, 0), a2, voffA);
            PG8_BAR; PG8_WAIT_L(0); PG8_MMA(1, 0, At, B0); PG8_BAR; PG8_SCHED;
            PG8_STAGE(PG8_SB(0, 1), b2 + hstep, voffB);
            PG8_WAIT_V(6); PG8_BAR; PG8_MMA(1, 1, At, B1); PG8_BAR;
            PG8_LDB(B0, 1, 0); PG8_SCHED; PG8_LDA(At, 1, 0); PG8_STAGE(PG8_SA(0, 1), a2 + hstep, voffA);
            PG8_WAIT_L(8); PG8_BAR; PG8_WAIT_L(0); PG8_MMA(0, 0, At, B0); PG8_BAR; PG8_SCHED;
            PG8_LDB(B1, 1, 1); PG8_STAGE(PG8_SB(1, 0), b3, voffB);
            PG8_BAR; PG8_WAIT_L(0); PG8_MMA(0, 1, At, B1); PG8_BAR;
            PG8_LDA(At, 1, 1); PG8_STAGE(PG8_SA(1, 0), a3, voffA);
            PG8_BAR; PG8_WAIT_L(0); PG8_MMA(1, 0, At, B0); PG8_BAR; PG8_SCHED;
            PG8_STAGE(PG8_SB(1, 1), b3 + hstep, voffB);
            PG8_WAIT_V(6); PG8_BAR; PG8_MMA(1, 1, At, B1); PG8_BAR;
            }
        }
        if constexpr (ALIGN_EPI) { if (wr == 0) PG8_BAR; }
        if constexpr (!Epi::AFTER_DRAIN) { int l2 = lane; asm volatile("" : "+v"(l2));     E(acc, cur, wr, wc, l2 & 15, l2 >> 4); S.done(cur); }
        if (!has_next) break;
#pragma unroll
        for (int a = 0; a < 2; ++a)
#pragma unroll
            for (int b = 0; b < 2; ++b)
#pragma unroll
                for (int m = 0; m < 4; ++m)
#pragma unroll
                    for (int n = 0; n < 2; ++n) acc[a][b][m][n] = (f32x4){0.f, 0.f, 0.f, 0.f};
        cur = nxt; cA = nA; cB = nB; ++ui;
        if constexpr (ALIGN_EPI) { if (wr == 1) PG8_BAR; }
    }
    PG8_WAIT_V(0);
    if constexpr (!ALIGN_EPI) { if (wr == 0) PG8_BAR; }
    PG8_BAR;
    if constexpr (Epi::AFTER_DRAIN) { E.fused(acc, cur, wr, wc, fr, fq, lds, wid, lane); S.done(cur); }
#undef PG8_SA
#undef PG8_SB
#undef PG8_STAGE
#undef PG8_LDA
#undef PG8_LDB
#undef PG8_MMA
#undef PG8_WAIT_V
#undef PG8_WAIT_L
#undef PG8_BAR
#undef PG8_SCHED
}
}
#ifndef ATTN_STORE16
#define ATTN_STORE16(p,v) (*(u32x4*)(p)=(v))
#endif
namespace attn_body {
using bf16=__hip_bfloat16;
using bf16x8=__attribute__((ext_vector_type(8)))short;
using s16x4=__attribute__((ext_vector_type(4)))short;
using f32x16=__attribute__((ext_vector_type(16)))float;
using u32x4=__attribute__((ext_vector_type(4)))unsigned;
constexpr int D=64,ZP=2304,OP=1024;
constexpr int NW=8,QBLK=32,QB=QBLK*NW,KVBLK=64;
__device__ __forceinline__ int crow(int r,int hi){return (r&3)+8*(r>>2)+4*hi;}
#define SBAR() __builtin_amdgcn_sched_barrier(0)
constexpr int NSLOT=3, SLOTB=8192;
constexpr int LDS_K=0, LDS_V=NSLOT*SLOTB, LDS_WS=2*NSLOT*SLOTB, LDS_OST=LDS_WS+NW*64*4, LDS_BYTES=LDS_OST+NW*8192;
__device__ __forceinline__ void glds16(const void*gsrc,unsigned lds_dst){unsigned keep;
  asm volatile("s_mov_b32 %0, m0\n\ts_mov_b32 m0, %2\n\ts_nop 0\n\tglobal_load_lds_dwordx4 %1, off\n\ts_mov_b32 m0, %0":"=&s"(keep):"v"(gsrc),"s"(lds_dst):"memory");}
__device__ __forceinline__ float max3f(float a,float b,float c){float r;asm("v_max3_f32 %0, %1, %2, %3":"=v"(r):"v"(a),"v"(b),"v"(c));return r;}
__device__ __forceinline__ float max2f(float a,float b){float r;asm("v_max_f32_e32 %0, %1, %2":"=v"(r):"v"(a),"v"(b));return r;}
__device__ __forceinline__ float fadd_s(float a,float b){float r;asm("v_add_f32_e32 %0, %1, %2":"=v"(r):"v"(a),"v"(b));return r;}
__device__ __forceinline__ float fsub_s(float a,float b){float r;asm("v_sub_f32_e32 %0, %1, %2":"=v"(r):"v"(a),"v"(b));return r;}
typedef float f32x2_t __attribute__((ext_vector_type(2))); typedef __bf16 bf16x2_t __attribute__((ext_vector_type(2)));
__device__ __forceinline__ unsigned cvtpk_s(float lo,float hi){f32x2_t v={lo,hi};bf16x2_t b=__builtin_convertvector(v,bf16x2_t);return __builtin_bit_cast(unsigned,b);}
#define WAIT_BAR(N) asm volatile("s_waitcnt vmcnt(" #N ") lgkmcnt(0)\n\ts_barrier":::"memory")

__device__ __forceinline__ void qkt(f32x16&p0,f32x16&p1,const char*Kslot,const bf16x8*qr,const f32x16&negm,int r32,int hi){
  const char*kb=Kslot+hi*1024+r32*16;
  #pragma unroll
  for(int d0=0;d0<4;++d0){
    const bf16x8 b0=*reinterpret_cast<const bf16x8*>(kb+d0*2048);
    const bf16x8 b1=*reinterpret_cast<const bf16x8*>(kb+d0*2048+512);
    if(d0==0){p0=__builtin_amdgcn_mfma_f32_32x32x16_bf16(b0,qr[0],negm,0,0,0);p1=__builtin_amdgcn_mfma_f32_32x32x16_bf16(b1,qr[0],negm,0,0,0);}
    else{p0=__builtin_amdgcn_mfma_f32_32x32x16_bf16(b0,qr[d0],p0,0,0,0);p1=__builtin_amdgcn_mfma_f32_32x32x16_bf16(b1,qr[d0],p1,0,0,0);}}
}
typedef __attribute__((address_space(3))) const char* lds_cptr;
typedef short v4i16_t __attribute__((ext_vector_type(4)));
__device__ __forceinline__ void kload8(bf16x8*kf,lds_cptr kp){
  kf[0]=*(const __attribute__((address_space(3))) bf16x8*)(kp);      kf[1]=*(const __attribute__((address_space(3))) bf16x8*)(kp+512);
  kf[2]=*(const __attribute__((address_space(3))) bf16x8*)(kp+2048); kf[3]=*(const __attribute__((address_space(3))) bf16x8*)(kp+2560);
  kf[4]=*(const __attribute__((address_space(3))) bf16x8*)(kp+4096); kf[5]=*(const __attribute__((address_space(3))) bf16x8*)(kp+4608);
  kf[6]=*(const __attribute__((address_space(3))) bf16x8*)(kp+6144); kf[7]=*(const __attribute__((address_space(3))) bf16x8*)(kp+6656);
}
__device__ __forceinline__ void kload2(bf16x8*kf,lds_cptr kp,int j){ kf[2*j]=*(const __attribute__((address_space(3))) bf16x8*)(kp+j*2048); kf[2*j+1]=*(const __attribute__((address_space(3))) bf16x8*)(kp+j*2048+512); }
__device__ __forceinline__ s16x4 vtr(lds_cptr p){ return __builtin_bit_cast(s16x4,__builtin_amdgcn_ds_read_tr16_b64_v4i16((__attribute__((address_space(3))) v4i16_t*)p)); }
__device__ __forceinline__ float rowmax(const f32x16&p0,const f32x16&p1){
  float a=max3f(p0[0],p0[1],p1[0]),b=max3f(p0[2],p0[3],p1[1]);a=max3f(a,p1[2],p1[3]);
  #pragma unroll
  for(int r=4;r<16;r+=4){a=max3f(a,p0[r],p0[r+1]);b=max3f(b,p0[r+2],p0[r+3]);a=max3f(a,p1[r],p1[r+1]);b=max3f(b,p1[r+2],p1[r+3]);}
  const float m=max2f(a,b);
  auto rr=__builtin_amdgcn_permlane32_swap(__float_as_uint(m),__float_as_uint(m),false,false);
  return max2f(__uint_as_float(rr[0]),__uint_as_float(rr[1]));
}
__device__ __forceinline__ void pv(f32x16*o,int vb,bf16x8 pa0,bf16x8 pa1,bf16x8 pa2,bf16x8 pa3){
  #pragma unroll
  for(int d0=0;d0<2;++d0){s16x4 lo[4],hi[4];
    #pragma unroll
    for(int ks=0;ks<4;++ks){
      asm volatile("ds_read_b64_tr_b16 %0,%1 offset:%c2":"=&v"(lo[ks]):"v"(vb),"i"(d0*4096+ks*1024):"memory");
      asm volatile("ds_read_b64_tr_b16 %0,%1 offset:%c2":"=&v"(hi[ks]):"v"(vb),"i"(d0*4096+ks*1024+512):"memory");}
    asm volatile("s_waitcnt lgkmcnt(0)":::"memory");SBAR();
    #define PK(k) (bf16x8){lo[k][0],lo[k][1],lo[k][2],lo[k][3],hi[k][0],hi[k][1],hi[k][2],hi[k][3]}
    o[d0]=__builtin_amdgcn_mfma_f32_32x32x16_bf16(pa0,PK(0),o[d0],0,0,0);
    o[d0]=__builtin_amdgcn_mfma_f32_32x32x16_bf16(pa1,PK(1),o[d0],0,0,0);
    o[d0]=__builtin_amdgcn_mfma_f32_32x32x16_bf16(pa2,PK(2),o[d0],0,0,0);
    o[d0]=__builtin_amdgcn_mfma_f32_32x32x16_bf16(pa3,PK(3),o[d0],0,0,0);
    #undef PK
  }
}

template<int MODE,int THRL> __device__ __forceinline__ void attn_unit(const bf16*Zq,const bf16*__restrict__ Zk,const bf16*__restrict__ Zv,int krow_lat,int krow_ctx,int nlat,int NT,bf16*Oblk,char*shm,float lam,const float*subln,float sub_scale,const bool FIX=false){
  int tid_=threadIdx.x; asm volatile("":"+v"(tid_));
  const int tid=tid_,lane=tid&63,r32=lane&31,hi=lane>>5; const int wid=__builtin_amdgcn_readfirstlane(tid>>6);
  const bf16*Qw=Zq+(long)(wid*QBLK)*ZP;
  const unsigned lds0=(unsigned)(uintptr_t)shm;
  float*wsf=(float*)(shm+LDS_WS)+wid*64;
  const bf16*ksrc=Zk+(long)lane*ZP+wid*8;
  const bf16*vsrc=Zv+(long)(16*(wid&3)+(lane>>2))*ZP+(wid>>2)*32+(lane&3)*8;
  const unsigned kdst=lds0+LDS_K+wid*1024, vdst=lds0+LDS_V+wid*1024;
  #define KROW(t) ((long)(((t)<nlat)?(krow_lat+64*(t)):(krow_ctx+64*((t)-nlat)))*ZP)
  #define DMA_K(t,slot) glds16(ksrc+KROW(t),(unsigned)__builtin_amdgcn_readfirstlane(kdst+(slot)))
  #define DMA_V(t,slot) glds16(vsrc+KROW(t),(unsigned)__builtin_amdgcn_readfirstlane(vdst+(slot)))
  const int vb0=(int)(lds0+LDS_V)+((lane>>4)&1)*32+(lane&3)*8+(4*hi+((lane&15)>>2))*64;
  const char*Kbase=shm+LDS_K; bf16x8 kf[8];
  const lds_cptr shm3=(lds_cptr)shm; const lds_cptr kp0=shm3+LDS_K+hi*1024+r32*16; const lds_cptr vp0=shm3+LDS_V+((lane>>4)&1)*32+(lane&3)*8+(4*hi+((lane&15)>>2))*64;
  float*o1s=(float*)(shm+LDS_OST+wid*8192);
  for(int pass=0;pass<(MODE?2:1);++pass){
  DMA_K(0,0);DMA_V(0,0);DMA_K(1,SLOTB);
  bf16x8 qr[4];
  #pragma unroll
  for(int d0=0;d0<4;++d0)qr[d0]=*reinterpret_cast<const bf16x8*>(&Qw[(long)r32*ZP+d0*16+hi*8]);
  if(MODE==1){ const bf16x8 zz={0,0,0,0,0,0,0,0}; if(pass==0){qr[2]=zz;qr[3]=zz;} else {qr[0]=zz;qr[1]=zz;} }
  float mhat=0.f,l_reg=0.f;f32x16 o[2];o[0]=f32x16{};o[1]=f32x16{};f32x16 negm=f32x16{};
  if(FIX){ float ref_=lam; asm volatile("":"+v"(ref_));     mhat=ref_; _Pragma("unroll") for(int r=0;r<16;++r)negm[r]=-ref_; }
  asm volatile("":"+v"(negm));
  #define CMASK(P0,P1,t) do{}while(0)
  bool resc=false;
  #define START(P0,P1) do{ resc=false; \
    if(!FIX){ const float rm=rowmax(P0,P1); const float dl=rm; mhat=fadd_s(mhat,dl); \
      _Pragma("unroll") for(int r=0;r<16;++r){P0[r]=fsub_s(P0[r],dl);P1[r]=fsub_s(P1[r],dl);} \
      _Pragma("unroll") for(int r=0;r<16;++r)negm[r]=-mhat; asm volatile("":"+v"(negm)); } \
    _Pragma("unroll") for(int r=0;r<16;++r)P0[r]=__builtin_amdgcn_exp2f(P0[r]); }while(0)
  #define RESC() do{ if(!FIX&&resc){ asm volatile("s_waitcnt lgkmcnt(0)":::"memory"); \
      _Pragma("unroll") for(int d_=0;d_<2;++d_) _Pragma("unroll") for(int r=0;r<16;++r)o[d_][r]*=wsf[crow(r,hi)]; } }while(0)
  f32x16 pA0,pA1,pB0,pB1;
  int sl_prev=0,sl_cur=0,sl_next=SLOTB;
  #define ROT() do{sl_prev=sl_cur;sl_cur=sl_next;sl_next=(sl_next==(NSLOT-1)*SLOTB)?0:sl_next+SLOTB;}while(0)
  DMA_K(2,2*SLOTB);
  WAIT_BAR(3);
  qkt(pA0,pA1,Kbase,qr,negm,r32,hi);asm volatile("s_nop 15\n\ts_nop 7":"+v"(pA0),"+v"(pA1));CMASK(pA0,pA1,0);
  START(pA0,pA1);
  _Pragma("unroll") for(int r=0;r<16;++r)pA1[r]=__builtin_amdgcn_exp2f(pA1[r]);
  WAIT_BAR(0);
  DMA_K(3,0);DMA_V(1,SLOTB);
  ROT();
  kload8(kf,kp0+sl_cur);
  WAIT_BAR(2);
  s16x4 vlo[8],vhi[8]; u32x4 pw0,pw1,pw2,pw3;
  #define PKW(P,B) cvtpk_s(P[B],P[B+1])
  #define PAF(k) __builtin_bit_cast(bf16x8,pw##k)
  #define VFR(i) (bf16x8){vlo[i][0],vlo[i][1],vlo[i][2],vlo[i][3],vhi[i][0],vhi[i][1],vhi[i][2],vhi[i][3]}
  #define PIN(x) asm volatile("":"+v"(x))
  #define MX3(a,b,c) __builtin_fmaxf(__builtin_fmaxf((a),(b)),(c))
  #define GAPA(MF,A0,A1,A2,A3,W0,W1,PW) do{ MF; sacc+=A0; sacc+=A1; sacc+=A2; sacc+=A3; PIN(sacc); W0; W1; PIN(PW); SBAR(); }while(0)
  #define EX(v) __builtin_amdgcn_exp2f(v)
  #define GAPB(MF,X,B) do{ MF; X[B]=EX(X[B]); X[B+1]=EX(X[B+1]); X[B+2]=EX(X[B+2]); X[B+3]=EX(X[B+3]); PIN(X); SBAR(); }while(0)
  #define VRD(i) do{ vlo[i]=vtr(vp_+(((i)>>2)*4096+((i)&3)*1024)); vhi[i]=vtr(vp_+(((i)>>2)*4096+((i)&3)*1024+512)); }while(0)
  #define KRD(G,j) do{ if(G){ kload2(kf,kp0+sl_next,j); SBAR(); } }while(0)
  #define STEP(C0,C1,P0,P1,t,GK,GV,GL) do{ SBAR(); \
    const lds_cptr vp_=vp0+sl_prev; \
    VRD(0); SBAR(); float sacc=(P0[0]+P0[1]); \
    GAPA(C0=__builtin_amdgcn_mfma_f32_32x32x16_bf16(kf[0],qr[0],negm,0,0,0), P0[2],P0[3],P0[4],P0[5],     pw0[0]=PKW(P0,0), pw0[1]=PKW(P0,2), pw0); \
    VRD(4); SBAR(); GAPA(C1=__builtin_amdgcn_mfma_f32_32x32x16_bf16(kf[1],qr[0],negm,0,0,0), P0[6],P0[7],P0[8],P0[9],     pw0[2]=PKW(P0,4), pw0[3]=PKW(P0,6), pw0); \
    VRD(1); SBAR(); GAPA(C0=__builtin_amdgcn_mfma_f32_32x32x16_bf16(kf[2],qr[1],C0,0,0,0),   P0[10],P0[11],P0[12],P0[13], pw1[0]=PKW(P0,8), pw1[1]=PKW(P0,10), pw1); \
    VRD(5); SBAR(); GAPA(C1=__builtin_amdgcn_mfma_f32_32x32x16_bf16(kf[3],qr[1],C1,0,0,0),   P0[14],P0[15],P1[0],P1[1],   pw1[2]=PKW(P0,12),pw1[3]=PKW(P0,14), pw1); \
    VRD(2); SBAR(); GAPA(C0=__builtin_amdgcn_mfma_f32_32x32x16_bf16(kf[4],qr[2],C0,0,0,0),   P1[2],P1[3],P1[4],P1[5],     pw2[0]=PKW(P1,0), pw2[1]=PKW(P1,2), pw2); \
    VRD(6); SBAR(); GAPA(C1=__builtin_amdgcn_mfma_f32_32x32x16_bf16(kf[5],qr[2],C1,0,0,0),   P1[6],P1[7],P1[8],P1[9],     pw2[2]=PKW(P1,4), pw2[3]=PKW(P1,6), pw2); \
    VRD(3); SBAR(); GAPA(C0=__builtin_amdgcn_mfma_f32_32x32x16_bf16(kf[6],qr[3],C0,0,0,0),   P1[10],P1[11],P1[12],P1[13], pw3[0]=PKW(P1,8), pw3[1]=PKW(P1,10), pw3); \
    VRD(7); SBAR(); GAPA(C1=__builtin_amdgcn_mfma_f32_32x32x16_bf16(kf[7],qr[3],C1,0,0,0),   P1[14],P1[15],0.f,0.f,       pw3[2]=PKW(P1,12),pw3[3]=PKW(P1,14), pw3); \
    l_reg+=sacc; \
    if(GK){DMA_K((t)+3,sl_cur);} if(GV){DMA_V((t)+1,sl_next);} \
    CMASK(C0,C1,t); \
    resc=false; \
    if(!FIX){ float a=MX3(C0[0],C0[1],C1[0]),b=MX3(C0[2],C0[3],C1[1]); a=MX3(a,C1[2],C1[3]); \
      _Pragma("unroll") for(int r=4;r<16;r+=4){a=MX3(a,C0[r],C0[r+1]);b=MX3(b,C0[r+2],C0[r+3]);a=MX3(a,C1[r],C1[r+1]);b=MX3(b,C1[r+2],C1[r+3]);} \
      float rm=__builtin_fmaxf(a,b); { auto rr=__builtin_amdgcn_permlane32_swap(__float_as_uint(rm),__float_as_uint(rm),false,false); rm=__builtin_fmaxf(__uint_as_float(rr[0]),__uint_as_float(rr[1])); } \
      resc=false; \
      if(__builtin_expect(__any(rm>(float)THRL),0)){ const float dl=__builtin_fmaxf(rm,0.f); mhat+=dl; \
        _Pragma("unroll") for(int r=0;r<16;++r){C0[r]-=dl;C1[r]-=dl;} \
        _Pragma("unroll") for(int r=0;r<16;++r)negm[r]=-mhat; asm volatile("":"+v"(negm)); \
        const float f=__builtin_amdgcn_exp2f(-dl); l_reg*=f; if(hi==0)wsf[r32]=f; resc=true; } } \
    SBAR(); \
    GAPB(o[0]=__builtin_amdgcn_mfma_f32_32x32x16_bf16(PAF(0),VFR(0),o[0],0,0,0), C0,0); \
    GAPB(o[1]=__builtin_amdgcn_mfma_f32_32x32x16_bf16(PAF(0),VFR(4),o[1],0,0,0), C0,4); \
    KRD(GL,0); GAPB(o[0]=__builtin_amdgcn_mfma_f32_32x32x16_bf16(PAF(1),VFR(1),o[0],0,0,0), C0,8); \
    KRD(GL,1); GAPB(o[1]=__builtin_amdgcn_mfma_f32_32x32x16_bf16(PAF(1),VFR(5),o[1],0,0,0), C0,12); \
    KRD(GL,2); GAPB(o[0]=__builtin_amdgcn_mfma_f32_32x32x16_bf16(PAF(2),VFR(2),o[0],0,0,0), C1,0); \
    KRD(GL,3); GAPB(o[1]=__builtin_amdgcn_mfma_f32_32x32x16_bf16(PAF(2),VFR(6),o[1],0,0,0), C1,4); \
    GAPB(o[0]=__builtin_amdgcn_mfma_f32_32x32x16_bf16(PAF(3),VFR(3),o[0],0,0,0), C1,8); \
    GAPB(o[1]=__builtin_amdgcn_mfma_f32_32x32x16_bf16(PAF(3),VFR(7),o[1],0,0,0), C1,12); \
    }while(0)
  int t=1;
  #undef CMASK
  #define CMASK(P0,P1,t) do{}while(0)
  for(;t+5<NT;t+=2){
    STEP(pB0,pB1,pA0,pA1,t,true,true,true);     WAIT_BAR(2); RESC(); ROT();
    STEP(pA0,pA1,pB0,pB1,t+1,true,true,true);   WAIT_BAR(2); RESC(); ROT();
  }
  #undef CMASK
  #define CMASK(P0,P1,t) do{}while(0)
  #define ENDW(tt) do{ if((tt)+3<NT){WAIT_BAR(2);} else if((tt)+2<NT){WAIT_BAR(1);} else {WAIT_BAR(0);} }while(0)
  for(;t+1<NT;t+=2){
    STEP(pB0,pB1,pA0,pA1,t,(t+3<NT),(t+1<NT),(t+1<NT));       ENDW(t);   RESC(); ROT();
    STEP(pA0,pA1,pB0,pB1,t+1,(t+4<NT),(t+2<NT),(t+2<NT));     ENDW(t+1); RESC(); ROT();
  }
  STEP(pB0,pB1,pA0,pA1,NT-1,false,false,false); RESC();
  { float sacc=pB0[0]+pB0[1]; _Pragma("unroll") for(int r=2;r<16;++r)sacc+=pB0[r]; _Pragma("unroll") for(int r=0;r<16;++r)sacc+=pB1[r]; l_reg+=sacc;
    pw0=(u32x4){PKW(pB0,0),PKW(pB0,2),PKW(pB0,4),PKW(pB0,6)};pw1=(u32x4){PKW(pB0,8),PKW(pB0,10),PKW(pB0,12),PKW(pB0,14)};pw2=(u32x4){PKW(pB1,0),PKW(pB1,2),PKW(pB1,4),PKW(pB1,6)};pw3=(u32x4){PKW(pB1,8),PKW(pB1,10),PKW(pB1,12),PKW(pB1,14)};
    SBAR(); pv(o,vb0+sl_cur,PAF(0),PAF(1),PAF(2),PAF(3)); }
  #undef PKW
  #undef PAF
  #undef VFR
  #undef PIN
  #undef MX3
  #undef GAPA
  #undef GAPB
  #undef EX
  #undef VRD
  #undef KRD
  #undef STEP
  #undef ENDW
  {auto rr=__builtin_amdgcn_permlane32_swap(__float_as_uint(l_reg),__float_as_uint(l_reg),false,false);l_reg=__uint_as_float(rr[0])+__uint_as_float(rr[1]);}
  if(hi==0)wsf[32+r32]=l_reg;asm volatile("s_waitcnt lgkmcnt(0)":::"memory");
  float rli[16];
  #pragma unroll
  for(int r=0;r<16;++r)rli[r]=__builtin_amdgcn_rcpf(wsf[32+crow(r,hi)]);
  if(MODE==1&&pass==0){
    #pragma unroll
    for(int d0=0;d0<2;++d0){
      #pragma unroll
      for(int r=0;r<16;++r)o1s[(d0*16+r)*64+lane]=o[d0][r]*rli[r];}
  } else {
    bf16*stg=(bf16*)o1s;
    if(MODE==1){
      float g0=subln[r32]*sub_scale,g1=subln[32+r32]*sub_scale;
      #pragma unroll
      for(int d0=0;d0<2;++d0){
        #pragma unroll
        for(int r=0;r<16;++r)o[d0][r]=o1s[(d0*16+r)*64+lane]-lam*(o[d0][r]*rli[r]);}
      asm volatile("s_waitcnt lgkmcnt(0)":::"memory");
      #pragma unroll
      for(int r=0;r<16;++r){float ss=o[0][r]*o[0][r]+o[1][r]*o[1][r];
        ss+=shx(ss,1,lane);ss+=shx(ss,2,lane);ss+=shx(ss,4,lane);ss+=shx(ss,8,lane);ss+=shx(ss,16,lane);
        const float rn=__builtin_amdgcn_rsqf(ss*(1.0f/64.0f)+1e-6f); const int orow=crow(r,hi);
        stg[orow*64+r32]=__float2bfloat16(o[0][r]*rn*g0); stg[orow*64+32+r32]=__float2bfloat16(o[1][r]*rn*g1);}
    } else {
      #pragma unroll
      for(int r=0;r<16;++r){const int orow=crow(r,hi);
        #pragma unroll
        for(int d0=0;d0<2;++d0)stg[orow*64+d0*32+r32]=__float2bfloat16(o[d0][r]*rli[r]);}
    }
    asm volatile("s_waitcnt lgkmcnt(0)":::"memory");
    bf16*Ow=Oblk+(long)(wid*QBLK)*OP;
    #pragma unroll
    for(int i=0;i<4;++i){const int row=i*8+(lane>>3),ch=lane&7; const u32x4 v=*(const u32x4*)(stg+row*64+ch*8); ATTN_STORE16(Ow+(long)row*OP+ch*8,v);}
  }
  asm volatile("s_waitcnt lgkmcnt(0)\n\ts_barrier":::"memory");
  }
  #undef KROW
  #undef DMA_K
  #undef DMA_V
  #undef CMASK
  #undef START
  #undef RESC
  #undef ROT
}
template<int THRL> __device__ __forceinline__ void diff_unit(const bf16*Zq,const bf16*__restrict__ Zk,const bf16*__restrict__ Zv,int krow_lat,int krow_ctx,int nlat,int NT,bf16*Oblk,char*shm,float lam,const float*subln,float sub_scale,const bool FIX=false,float ref1=0.f,float ref2=0.f){
  int tid_=threadIdx.x; asm volatile("":"+v"(tid_));
  const int tid=tid_,lane=tid&63,r32=lane&31,hi=lane>>5; const int wid=__builtin_amdgcn_readfirstlane(tid>>6);
  const bf16*Qw=Zq+(long)(wid*QBLK)*ZP;
  const unsigned lds0=(unsigned)(uintptr_t)shm;
  float*wsf=(float*)(shm+LDS_WS)+wid*64;
  const bf16*ksrc=Zk+(long)lane*ZP+wid*8;
  const bf16*vsrc=Zv+(long)(16*(wid&3)+(lane>>2))*ZP+(wid>>2)*32+(lane&3)*8;
  const unsigned kdst=lds0+LDS_K+wid*1024, vdst=lds0+LDS_V+wid*1024;
  #define KROW(t) ((long)(((t)<nlat)?(krow_lat+64*(t)):(krow_ctx+64*((t)-nlat)))*ZP)
  #define DMA_K(t,slot) glds16(ksrc+KROW(t),(unsigned)__builtin_amdgcn_readfirstlane(kdst+(slot)))
  #define DMA_V(t,slot) glds16(vsrc+KROW(t),(unsigned)__builtin_amdgcn_readfirstlane(vdst+(slot)))
  const int vb0=(int)(lds0+LDS_V)+((lane>>4)&1)*32+(lane&3)*8+(4*hi+((lane&15)>>2))*64;
  const char*kb0=shm+LDS_K+hi*1024+r32*16;
  bf16x8 qr[4];
  #pragma unroll
  for(int d0=0;d0<4;++d0)qr[d0]=*reinterpret_cast<const bf16x8*>(&Qw[(long)r32*ZP+d0*16+hi*8]);
  asm volatile("":"+v"(qr[0]),"+v"(qr[1]),"+v"(qr[2]),"+v"(qr[3]));
  DMA_K(0,0);DMA_V(0,0);DMA_K(1,SLOTB);DMA_V(1,SLOTB);
  f32x16 o1[2],o2[2]; o1[0]=f32x16{};o1[1]=f32x16{};o2[0]=f32x16{};o2[1]=f32x16{};
  f32x16 negm1=f32x16{},negm2=f32x16{};
  if(FIX){ float ra_=ref1,rb_=ref2; asm volatile("":"+v"(ra_),"+v"(rb_)); _Pragma("unroll") for(int r=0;r<16;++r){negm1[r]=-ra_;negm2[r]=-rb_;} }
  asm volatile("":"+v"(negm1),"+v"(negm2));
  float mh1=0.f,mh2=0.f,l1=0.f,l2=0.f;
  int sl=0,sl2=2*SLOTB;
  #define PKW(P,B) cvtpk_s(P[B],P[B+1])
  #define SOFTMAX(SA,SB,NEGM,MH,LS,WOFF,RESCF,PW0,PW1,PW2,PW3) do{ RESCF=false; if(!FIX){ \
    float a_=__builtin_fmaxf(__builtin_fmaxf(SA[0],SA[1]),SB[0]),b_=__builtin_fmaxf(__builtin_fmaxf(SA[2],SA[3]),SB[1]); a_=__builtin_fmaxf(__builtin_fmaxf(a_,SB[2]),SB[3]); \
    _Pragma("unroll") for(int r=4;r<16;r+=4){a_=__builtin_fmaxf(__builtin_fmaxf(a_,SA[r]),SA[r+1]);b_=__builtin_fmaxf(__builtin_fmaxf(b_,SA[r+2]),SA[r+3]);a_=__builtin_fmaxf(__builtin_fmaxf(a_,SB[r]),SB[r+1]);b_=__builtin_fmaxf(__builtin_fmaxf(b_,SB[r+2]),SB[r+3]);} \
    float rm_=__builtin_fmaxf(a_,b_); { auto rr_=__builtin_amdgcn_permlane32_swap(__float_as_uint(rm_),__float_as_uint(rm_),false,false); rm_=__builtin_fmaxf(__uint_as_float(rr_[0]),__uint_as_float(rr_[1])); } \
    RESCF=false; \
    if(t==0||__any(rm_>(float)THRL)){ const float dl_=(t==0)?rm_:__builtin_fmaxf(rm_,0.f); MH+=dl_; \
      _Pragma("unroll") for(int r=0;r<16;++r){SA[r]-=dl_;SB[r]-=dl_;} \
      _Pragma("unroll") for(int r=0;r<16;++r)NEGM[r]=-MH; asm volatile("":"+v"(NEGM)); \
      const float f_=__builtin_amdgcn_exp2f(-dl_); LS*=f_; if(hi==0)wsf[(WOFF)+r32]=f_; RESCF=(t!=0); } } \
    _Pragma("unroll") for(int r=0;r<16;++r){SA[r]=__builtin_amdgcn_exp2f(SA[r]);SB[r]=__builtin_amdgcn_exp2f(SB[r]);} \
    { float s0_=SA[0]+SA[1],s1_=SB[0]+SB[1]; _Pragma("unroll") for(int r=2;r<16;r+=2){s0_+=SA[r]+SA[r+1];s1_+=SB[r]+SB[r+1];} LS+=s0_+s1_; } \
    PW0=(u32x4){PKW(SA,0),PKW(SA,2),PKW(SA,4),PKW(SA,6)};PW1=(u32x4){PKW(SA,8),PKW(SA,10),PKW(SA,12),PKW(SA,14)};PW2=(u32x4){PKW(SB,0),PKW(SB,2),PKW(SB,4),PKW(SB,6)};PW3=(u32x4){PKW(SB,8),PKW(SB,10),PKW(SB,12),PKW(SB,14)}; \
  }while(0)
  for(int t=0;t<NT;++t){
    if(t+1<NT){WAIT_BAR(2);}else{WAIT_BAR(0);}
    if(t+2<NT){DMA_K(t+2,sl2);DMA_V(t+2,sl2);}
    const char*kb=kb0+sl;
    f32x16 s1a,s1b,s2a,s2b;
    { const bf16x8 a0=*reinterpret_cast<const bf16x8*>(kb),b0=*reinterpret_cast<const bf16x8*>(kb+512),a1=*reinterpret_cast<const bf16x8*>(kb+2048),b1=*reinterpret_cast<const bf16x8*>(kb+2048+512);
      s1a=__builtin_amdgcn_mfma_f32_32x32x16_bf16(a0,qr[0],negm1,0,0,0); s1b=__builtin_amdgcn_mfma_f32_32x32x16_bf16(b0,qr[0],negm1,0,0,0);
      s1a=__builtin_amdgcn_mfma_f32_32x32x16_bf16(a1,qr[1],s1a,0,0,0);   s1b=__builtin_amdgcn_mfma_f32_32x32x16_bf16(b1,qr[1],s1b,0,0,0); }
    { const bf16x8 a0=*reinterpret_cast<const bf16x8*>(kb+4096),b0=*reinterpret_cast<const bf16x8*>(kb+4096+512),a1=*reinterpret_cast<const bf16x8*>(kb+6144),b1=*reinterpret_cast<const bf16x8*>(kb+6144+512);
      s2a=__builtin_amdgcn_mfma_f32_32x32x16_bf16(a0,qr[2],negm2,0,0,0); s2b=__builtin_amdgcn_mfma_f32_32x32x16_bf16(b0,qr[2],negm2,0,0,0);
      s2a=__builtin_amdgcn_mfma_f32_32x32x16_bf16(a1,qr[3],s2a,0,0,0);   s2b=__builtin_amdgcn_mfma_f32_32x32x16_bf16(b1,qr[3],s2b,0,0,0); }
    bool rs1,rs2; u32x4 p10,p11,p12,p13,p20,p21,p22,p23;
    SOFTMAX(s1a,s1b,negm1,mh1,l1,0,rs1,p10,p11,p12,p13);
    SOFTMAX(s2a,s2b,negm2,mh2,l2,32,rs2,p20,p21,p22,p23);
    if(rs1||rs2){ asm volatile("s_waitcnt lgkmcnt(0)":::"memory");
      if(rs1){ _Pragma("unroll") for(int d_=0;d_<2;++d_) _Pragma("unroll") for(int r=0;r<16;++r)o1[d_][r]*=wsf[crow(r,hi)]; }
      if(rs2){ _Pragma("unroll") for(int d_=0;d_<2;++d_) _Pragma("unroll") for(int r=0;r<16;++r)o2[d_][r]*=wsf[32+crow(r,hi)]; } }
    { const int vb=vb0+sl;
      #pragma unroll
      for(int d0=0;d0<2;++d0){ s16x4 lo[4],hv[4];
        #pragma unroll
        for(int ks=0;ks<4;++ks){
          asm volatile("ds_read_b64_tr_b16 %0,%1 offset:%c2":"=&v"(lo[ks]):"v"(vb),"i"(d0*4096+ks*1024):"memory");
          asm volatile("ds_read_b64_tr_b16 %0,%1 offset:%c2":"=&v"(hv[ks]):"v"(vb),"i"(d0*4096+ks*1024+512):"memory");}
        asm volatile("s_waitcnt lgkmcnt(0)":::"memory");SBAR();
        #define PK(k) (bf16x8){lo[k][0],lo[k][1],lo[k][2],lo[k][3],hv[k][0],hv[k][1],hv[k][2],hv[k][3]}
        o1[d0]=__builtin_amdgcn_mfma_f32_32x32x16_bf16(__builtin_bit_cast(bf16x8,p10),PK(0),o1[d0],0,0,0);
        o2[d0]=__builtin_amdgcn_mfma_f32_32x32x16_bf16(__builtin_bit_cast(bf16x8,p20),PK(0),o2[d0],0,0,0);
        o1[d0]=__builtin_amdgcn_mfma_f32_32x32x16_bf16(__builtin_bit_cast(bf16x8,p11),PK(1),o1[d0],0,0,0);
        o2[d0]=__builtin_amdgcn_mfma_f32_32x32x16_bf16(__builtin_bit_cast(bf16x8,p21),PK(1),o2[d0],0,0,0);
        o1[d0]=__builtin_amdgcn_mfma_f32_32x32x16_bf16(__builtin_bit_cast(bf16x8,p12),PK(2),o1[d0],0,0,0);
        o2[d0]=__builtin_amdgcn_mfma_f32_32x32x16_bf16(__builtin_bit_cast(bf16x8,p22),PK(2),o2[d0],0,0,0);
        o1[d0]=__builtin_amdgcn_mfma_f32_32x32x16_bf16(__builtin_bit_cast(bf16x8,p13),PK(3),o1[d0],0,0,0);
        o2[d0]=__builtin_amdgcn_mfma_f32_32x32x16_bf16(__builtin_bit_cast(bf16x8,p23),PK(3),o2[d0],0,0,0);
        #undef PK
      } }
    sl2=sl; sl=(sl==(NSLOT-1)*SLOTB)?0:sl+SLOTB;
  }
  #undef SOFTMAX
  #undef PKW
  {auto rr=__builtin_amdgcn_permlane32_swap(__float_as_uint(l1),__float_as_uint(l1),false,false);l1=__uint_as_float(rr[0])+__uint_as_float(rr[1]);}
  {auto rr=__builtin_amdgcn_permlane32_swap(__float_as_uint(l2),__float_as_uint(l2),false,false);l2=__uint_as_float(rr[0])+__uint_as_float(rr[1]);}
  if(hi==0){wsf[r32]=l1;wsf[32+r32]=l2;} asm volatile("s_waitcnt lgkmcnt(0)":::"memory");
  bf16*stg=(bf16*)(shm+LDS_OST+wid*8192);
  { const float g0=subln[r32]*sub_scale,g1=subln[32+r32]*sub_scale;
    #pragma unroll
    for(int r=0;r<16;++r){ const int orow=crow(r,hi); const float i1=__builtin_amdgcn_rcpf(wsf[orow]),i2=lam*__builtin_amdgcn_rcpf(wsf[32+orow]);
      const float v0=o1[0][r]*i1-o2[0][r]*i2,v1=o1[1][r]*i1-o2[1][r]*i2; float ss=v0*v0+v1*v1;
      ss+=shx(ss,1,lane);ss+=shx(ss,2,lane);ss+=shx(ss,4,lane);ss+=shx(ss,8,lane);ss+=shx(ss,16,lane);
      const float rn=__builtin_amdgcn_rsqf(ss*(1.0f/64.0f)+1e-6f);
      stg[orow*64+r32]=__float2bfloat16(v0*rn*g0); stg[orow*64+32+r32]=__float2bfloat16(v1*rn*g1);} }
  asm volatile("s_waitcnt lgkmcnt(0)":::"memory");
  bf16*Ow=Oblk+(long)(wid*QBLK)*OP;
  #pragma unroll
  for(int i=0;i<4;++i){const int row=i*8+(lane>>3),ch=lane&7; const u32x4 v=*(const u32x4*)(stg+row*64+ch*8); ATTN_STORE16(Ow+(long)row*OP+ch*8,v);}
  asm volatile("s_waitcnt lgkmcnt(0)\n\ts_barrier":::"memory");
  #undef KROW
  #undef DMA_K
  #undef DMA_V
}
#undef SBAR
#undef WAIT_BAR
}
namespace hy {
#define HY_LAS __attribute__((address_space(3)))
typedef short bf16x8 __attribute__((ext_vector_type(8)));
typedef short bf16x4 __attribute__((ext_vector_type(4)));
typedef float f32x4 __attribute__((ext_vector_type(4)));
typedef unsigned u32x4 __attribute__((ext_vector_type(4)));
typedef unsigned u32x2 __attribute__((ext_vector_type(2)));
__device__ __forceinline__ float bf2f(unsigned short h) { return __uint_as_float((unsigned)h << 16); }
__device__ __forceinline__ unsigned pk2(float lo, float hi) { unsigned r; asm volatile("v_cvt_pk_bf16_f32 %0, %1, %2" : "=v"(r) : "v"(lo), "v"(hi)); return r; }

template <int NP, int NBLK>
__device__ __forceinline__ void conv_unit(HY_LAS unsigned char* lds, const unsigned short* __restrict__ Rg, const unsigned short* __restrict__ vvT, const unsigned short* __restrict__ x0T, unsigned short* __restrict__ yT, float skip) {
    constexpr int L = 64 * NBLK, VBYTES = 16 * L, CSB = 4 * L + 64, NWORDS = L / 2 + 1, RC = VBYTES;
    int tid_ = threadIdx.x; asm volatile("" : "+v"(tid_));
    const int tid = tid_, lane = tid & 63, wid = __builtin_amdgcn_readfirstlane(tid >> 6);
    for (int g = tid; g < L; g += 512) *(HY_LAS u32x4*)(lds + g * 16) = *(const u32x4*)(vvT + (size_t)g * 8);
    const unsigned long long* G = (const unsigned long long*)Rg;
#pragma unroll
    for (int s = 0; s < 4; ++s)
        for (int w = tid; w < NWORDS; w += 512) {
            unsigned long long lo = G[w >= 1 ? w - 1 : 0], hi = G[w < L / 2 ? w : L / 2 - 1];
            lo = (w >= 1) ? lo : 0ull; hi = (w < L / 2) ? hi : 0ull;
            const unsigned long long v = (s == 0) ? hi : ((hi << (16 * s)) | (lo >> (64 - 16 * s)));
            *(HY_LAS unsigned long long*)(lds + RC + s * CSB + w * 8) = v;
        }
    __syncthreads();
    const int fr = lane & 15, fq = lane >> 4, sh = fr & 3, ql = fr >> 3, bb = fr & 7;
    if (wid < NBLK / (2 * NP)) {
        f32x4 acc[NP][4];
#pragma unroll
        for (int p = 0; p < NP; ++p)
#pragma unroll
            for (int ic = 0; ic < 4; ++ic) acc[p][ic] = (f32x4){0.f, 0.f, 0.f, 0.f};
        const int tb0 = 2 * NP * wid;
        const int abase = RC + sh * CSB + 2 * (L - fr + 8 * fq + sh) - 96;
        for (int d = tb0 - (NBLK - 1); d <= tb0 + 2 * NP - 1; ++d) {
            bf16x8 A[4][2];
            const int ad = abase - 128 * d;
#pragma unroll
            for (int ic = 0; ic < 4; ++ic)
#pragma unroll
                for (int kc = 0; kc < 2; ++kc) {
                    const bf16x4 lo = *(const HY_LAS bf16x4*)(lds + ad + 2 * (48 - 16 * ic + 32 * kc));
                    const bf16x4 hi = *(const HY_LAS bf16x4*)(lds + ad + 2 * (48 - 16 * ic + 32 * kc) + 8);
                    A[ic][kc] = (bf16x8){lo[0], lo[1], lo[2], lo[3], hi[0], hi[1], hi[2], hi[3]};
                }
#pragma unroll
            for (int p = 0; p < NP; ++p) {
                const int sb0 = tb0 + 2 * p - d, sb1 = sb0 + 1;
                const bool v0 = (sb0 >= 0) && (sb0 < NBLK), v1 = (sb1 >= 0) && (sb1 < NBLK);
                if (!(v0 || v1)) continue;
                const int sbl = ql ? sb1 : sb0; const bool vl = ql ? v1 : v0;
                const int sbc = sbl < 0 ? 0 : (sbl >= NBLK ? NBLK - 1 : sbl);
                bf16x8 B[2];
#pragma unroll
                for (int kc = 0; kc < 2; ++kc) {
                    bf16x8 t = *(const HY_LAS bf16x8*)(lds + ((8 * sbc + 4 * kc + fq) * 8 + bb) * 16);
                    if (!vl) t = (bf16x8){0, 0, 0, 0, 0, 0, 0, 0};
                    B[kc] = t;
                }
#pragma unroll
                for (int ic = 0; ic < 4; ++ic)
#pragma unroll
                    for (int kc = 0; kc < 2; ++kc) acc[p][ic] = __builtin_amdgcn_mfma_f32_16x16x32_bf16(A[ic][kc], B[kc], acc[p][ic], 0, 0, 0);
            }
        }
#pragma unroll
        for (int p = 0; p < NP; ++p)
#pragma unroll
            for (int ic = 0; ic < 4; ++ic) {
                const int tb = tb0 + 2 * p + ql;
                const int gofs = ((8 * tb + 2 * ic + (fq >> 1)) * 8 + bb) * 16 + 8 * (fq & 1);
                const bf16x4 vv = *(const HY_LAS bf16x4*)(lds + gofs);
                const u32x2 xx = *(const u32x2*)((const unsigned char*)x0T + gofs);
                float o[4];
#pragma unroll
                for (int r = 0; r < 4; ++r) {
                    const float x0 = __uint_as_float(((r & 1) ? (xx[r >> 1] & 0xffff0000u) : (xx[r >> 1] << 16)));
                    o[r] = (acc[p][ic][r] + bf2f((unsigned short)vv[r]) * skip) * x0;
                }
                u32x2 w; w.x = pk2(o[0], o[1]); w.y = pk2(o[2], o[3]);
                st_wt8((unsigned char*)yT + gofs, w);
            }
    }
    __syncthreads();
}
#undef HY_LAS
}
constexpr int DM = 1024, NBATCH = 8, SEQL = 4096, NCTX = 256, DEPTH = 4;
constexpr int ML = NBATCH * SEQL, MC = NBATCH * NCTX, MT = ML + MC;
constexpr int ZP = 2304, DFF = 2816, DFE = 3584, NEXP = 8;
constexpr int MOE_CAP = 34816;
constexpr int MOE_TILES = 280, MOE_ROWS = MOE_TILES * 256;
constexpr float NORM_EPS = 1e-6f;
constexpr int NWAVES = 8;
constexpr size_t MiB = 1u << 20;
constexpr size_t WS_CTL = 0, CTL_ZERO_BYTES = 2 * MiB;
constexpr size_t WS_MODS = 1 * MiB;
constexpr size_t WS_ROPE = 2 * MiB;
constexpr size_t WS_ROUTE = 22 * MiB;
constexpr size_t WS_FILT = 4 * MiB;
constexpr size_t WS_FILTC = 21 * MiB;
constexpr size_t WS_WIN = 24 * MiB, WS_WOUT = 42 * MiB, WS_WGU = 50 * MiB, WS_WD = 72 * MiB, WS_MWGU = 83 * MiB, WS_MWD = 195 * MiB;
constexpr size_t WS_HC = 251 * MiB, WS_U = 259 * MiB;
constexpr size_t WS_R = 327 * MiB;
constexpr size_t WS_Z = WS_R, WS_MIX = WS_R + 153 * MiB, WS_VVT = WS_MIX + 68 * MiB, WS_X0T = WS_VVT + 18 * MiB, WS_YT = WS_X0T + 18 * MiB;
constexpr size_t GS_LAT = 512 * 64 + 128, GS_CTX = 32 * 64 + 128, G_CBASE = 256 * GS_LAT;
#ifndef DENSE_F8_UP
#define DENSE_F8_UP 3
#endif
#ifndef DENSE_F8_DOWN
#define DENSE_F8_DOWN 3
#endif
static_assert((DENSE_F8_UP & ~DENSE_F8_DOWN) == 0, "an fp8 up projection writes an fp8 hidden tensor");
constexpr size_t WS_AS8 = WS_R  , WS_AS = WS_R, WS_HID = WS_R + 273 * MiB, WS_HB = WS_R + 630 * MiB, WS_END = WS_HB + 64 * MiB;
static_assert(WS_YT + 18 * MiB <= WS_HB && (G_CBASE + 256 * GS_CTX) * 2 <= 18 * MiB && (size_t)MT * ZP * 2 <= 153 * MiB && (size_t)MOE_ROWS * DM * 2 <= 273 * MiB && (size_t)8 * MOE_CAP * DM <= 273 * MiB && (size_t)MOE_ROWS * DFE <= 357 * MiB && (size_t)MT * DFF * 2 <= 357 * MiB, "ws map");
constexpr int CW_TMO = 0;
constexpr int CW_BAR = 4096;
constexpr int CW_QMIX = 16384;
constexpr int CW_DMAX = 24576;
constexpr int CW_CNT = 9216;
constexpr int RING_BYTES = 139264;
constexpr int LDSCTL_OFF = RING_BYTES, MISC_OFF = LDSCTL_OFF + 320;
constexpr int ROPE_LDS_OFF = RING_BYTES + 1024, LDS_BYTES = ROPE_LDS_OFF + 12288;
constexpr int NPL = 11, NPHASES = 1 + DEPTH * NPL + 1;
enum { PH_NORM1 = 0, PH_WIN, PH_HYPRE, PH_MIX, PH_HYPOST, PH_WOUT, PH_NORM2, PH_GATHER, PH_UP, PH_DOWN, PH_COMBINE };
#define GAS __attribute__((address_space(1)))
#define LAS __attribute__((address_space(3)))
typedef unsigned short bf16;
typedef unsigned v4u __attribute__((ext_vector_type(4)));
typedef float f32x4 __attribute__((ext_vector_type(4)));
typedef short bf16x8 __attribute__((ext_vector_type(8)));
typedef GAS unsigned gu32;
typedef GAS unsigned long long gu64;
#define RLX_AGENT __ATOMIC_RELAXED, __HIP_MEMORY_SCOPE_AGENT
#define LDS_WAIT() asm volatile("s_waitcnt lgkmcnt(0)" ::: "memory")
#define VM_WAIT() asm volatile("s_waitcnt vmcnt(0)" ::: "memory")
__device__ __forceinline__ unsigned long long rt() { return __builtin_amdgcn_s_memrealtime(); }
__device__ __forceinline__ unsigned f2bf(float f) { unsigned u = __builtin_bit_cast(unsigned, f); return (u + 0x7fffu + ((u >> 16) & 1u)) >> 16; }
__device__ __forceinline__ unsigned pk2(float lo, float hi) {
    typedef float pk2f_ __attribute__((ext_vector_type(2))); typedef __bf16 pk2b_ __attribute__((ext_vector_type(2)));
    const pk2f_ v = {lo, hi}; return __builtin_bit_cast(unsigned, __builtin_convertvector(v, pk2b_)); }

#define XB_TMO      128
#define XB_XCNT(j)  (256  + 64 * (j))
#define XB_XSUB(j)  (1280 + 64 * (j))
#define XB_XGEN(j)  (2304 + 64 * (j))
#define XB_TOP      3328
#define XB_TOPGEN   3392
#define XCD_BAR_WORDS 3456
#define XB_SPIN_CAP (1u << 18)

__device__ __forceinline__ unsigned xb_ld(unsigned* p)              { return __hip_atomic_load(p, __ATOMIC_RELAXED, __HIP_MEMORY_SCOPE_AGENT); }
__device__ __forceinline__ unsigned xb_add(unsigned* p, unsigned v) { return __hip_atomic_fetch_add(p, v, __ATOMIC_RELAXED, __HIP_MEMORY_SCOPE_AGENT); }
__device__ __forceinline__ unsigned xb_xcc_id() { return (unsigned)__builtin_amdgcn_s_getreg((3 << 11) | 20) & 0xFu; }
#define XB_SPIN(cond, bar) do { unsigned _sp = 0; while (cond) { __builtin_amdgcn_s_sleep(1); \
    if ((++_sp & 255u) == 0u) { if (xb_ld(&(bar)[XB_TMO])) break; if (_sp > XB_SPIN_CAP) { atomicAdd(&(bar)[XB_TMO], 1u); break; } } } } while (0)

struct XcdBarrier {
    unsigned* bar; unsigned x;
    volatile LAS unsigned* st;
};

__device__ __forceinline__ XcdBarrier xcd_barrier_post(unsigned* bar, volatile LAS unsigned* st) {
    XcdBarrier b; b.bar = bar; b.x = xb_xcc_id(); b.st = st;
    if (threadIdx.x == 0) (void)xb_add(&bar[XB_XCNT(b.x)], 1u);
    return b;
}
__device__ __forceinline__ void xcd_barrier_complete(unsigned* bar, unsigned x, unsigned& nloc, unsigned& nx) {
    const unsigned G = gridDim.x * gridDim.y * gridDim.z;
    unsigned sum, cnt, mine, sp = 0u;
    for (;;) {
        sum = 0u; cnt = 0u; mine = 0u;
#pragma unroll
        for (unsigned j = 0; j < 16; ++j) { const unsigned c = xb_ld(&bar[XB_XCNT(j)]); sum += c; cnt += (c > 0u) ? 1u : 0u; mine = (j == x) ? c : mine; }
        if (sum == G) break;
        __builtin_amdgcn_s_sleep(1);
        if ((++sp & 255u) == 0u) { if (xb_ld(&bar[XB_TMO])) break; if (sp > XB_SPIN_CAP) { atomicAdd(&bar[XB_TMO], 1u); break; } }
    }
    nloc = mine > 0u ? mine : 1u; nx = cnt > 0u ? cnt : 1u;
}

__device__ __forceinline__ void xcd_barrier(const XcdBarrier& b) {
    asm volatile("s_waitcnt vmcnt(0)" ::: "memory");
    __syncthreads();
    if (threadIdx.x == 0) {
        unsigned* bar = b.bar;
        __builtin_amdgcn_s_waitcnt(0);
        unsigned nloc = b.st[0], nx = b.st[1];
        if (nloc == 0u) { xcd_barrier_complete(bar, b.x, nloc, nx); b.st[0] = nloc; b.st[1] = nx; }
        const unsigned old = xb_add(&bar[XB_XSUB(b.x)], 1u);
        const unsigned gen = old / nloc;
        if (old + 1u == (gen + 1u) * nloc) {
            __builtin_amdgcn_fence(__ATOMIC_RELEASE, "agent");
            asm volatile("s_waitcnt vmcnt(0)" ::: "memory");
            const unsigned og = xb_add(&bar[XB_TOP], 1u);
            const unsigned tg = og / nx;
            if (og + 1u == (tg + 1u) * nx) xb_add(&bar[XB_TOPGEN], 1u);
            else XB_SPIN(xb_ld(&bar[XB_TOPGEN]) == tg, bar);
            __builtin_amdgcn_fence(__ATOMIC_ACQUIRE, "agent");
            xb_add(&bar[XB_XGEN(b.x)], 1u);
            asm volatile("s_waitcnt vmcnt(0)" ::: "memory");
        } else {
            XB_SPIN(xb_ld(&bar[XB_XGEN(b.x)]) == gen, bar);
            __builtin_amdgcn_fence(__ATOMIC_ACQUIRE, "agent");
            asm volatile("s_waitcnt vmcnt(0)" ::: "memory");
        }
    }
    __syncthreads();
}
typedef float f32x2 __attribute__((ext_vector_type(2)));
typedef unsigned v2u __attribute__((ext_vector_type(2)));
__device__ __forceinline__ float bf2f(unsigned short h) { return __uint_as_float((unsigned)h << 16); }
__device__ __forceinline__ float bflo(unsigned w) { return __uint_as_float(w << 16); }
__device__ __forceinline__ float bfhi(unsigned w) { return __uint_as_float(w & 0xffff0000u); }
__device__ __forceinline__ float wave_sum(float v) {
    int ln = (int)__builtin_amdgcn_mbcnt_hi(~0u, __builtin_amdgcn_mbcnt_lo(~0u, 0u)); asm volatile("" : "+v"(ln));
#pragma unroll
    for (int o = 1; o < 64; o <<= 1) v += shx(v, o, ln);
    return v;
}
__device__ __forceinline__ float cos_rev(float r) { r = r - floorf(r); return __builtin_amdgcn_cosf(r); }
__device__ __forceinline__ float sin_rev(float r) { r = r - floorf(r); return __builtin_amdgcn_sinf(r); }
__device__ __forceinline__ float sin_rad(float x) { return sin_rev(x * 0.15915494309189535f); }
__device__ __forceinline__ const void* karg_ptr(int i) {
    const unsigned long long __attribute__((address_space(4)))* kp = (const unsigned long long __attribute__((address_space(4)))*)__builtin_amdgcn_kernarg_segment_ptr();
    asm volatile("" : "+s"(kp));
    return (const void*)(const __attribute__((address_space(1))) void*)kp[i];
}
#define KARG(i) ((const float*)karg_ptr(i))
#define KOUT() ((float*)karg_ptr(34))
#define KWS() ((unsigned char*)karg_ptr(35))
#define FRESH_TID() int tid_ = threadIdx.x; asm volatile("" : "+v"(tid_)); const int tid = tid_, lane = tid & 63; (void)lane
struct Frame {
    LAS unsigned char* lds; volatile LAS unsigned* MISC; gu32* ctl;
    int wave, vcu, G;
};

struct RmId { __device__ __forceinline__ int operator()(int n) const { return n; } };
struct RmGate { int off; __device__ __forceinline__ int operator()(int n) const { return ((n >> 7) << 8) + (n & 127) + off; } };
struct RmWin { __device__ __forceinline__ int operator()(int n) const {
    const int pn = n >> 8, c = n & 255; int p;
    if (pn == 3 || pn == 4) p = 128 * ((c >> 4) & 1) + 32 * (c >> 6) + 16 * ((c >> 5) & 1) + (c & 15);
    else if (pn >= 6) p = 128 * ((c >> 5) & 1) + 32 * (c >> 6) + (c & 31);
    else p = c;
    return (pn << 8) + p; } };
template <class RM>
__device__ __forceinline__ void transpose_item(const float* __restrict__ W, int K, int N, bf16* WT, LAS float* scr, int item, int lane, RM rm) {
    const int nblk = N / 32, kb = item / nblk, nb = item % nblk, k0 = 64 * kb, n0 = 32 * nb;
    float wv[32];
#pragma unroll
    for (int i = 0; i < 32; ++i) wv[i] = W[(size_t)(k0 + 2 * i + (lane >> 5)) * N + n0 + (lane & 31)];
#pragma unroll
    for (int i = 0; i < 32; ++i) scr[(2 * i + (lane >> 5)) * 33 + (lane & 31)] = wv[i];
    LDS_WAIT(); asm volatile("" ::: "memory");
    const int c = lane & 7;
#pragma unroll
    for (int j = 0; j < 4; ++j) { const int n = (lane >> 3) + 8 * j; const LAS float* s = scr + (8 * c) * 33 + n;
        v4u o; o.x = pk2(s[0 * 33], s[1 * 33]); o.y = pk2(s[2 * 33], s[3 * 33]); o.z = pk2(s[4 * 33], s[5 * 33]); o.w = pk2(s[6 * 33], s[7 * 33]);
        *(GAS v4u*)(WT + (size_t)rm(n0 + n) * K + k0 + 8 * c) = o; }
    LDS_WAIT(); asm volatile("" ::: "memory");
}
template <class RM>
__device__ __forceinline__ void transpose_item8(const float* __restrict__ W, int K, int N, unsigned char* WT, LAS float* scr, int item, int lane, RM rm, float scale) {
    const int nblk = N / 32, kb = item / nblk, nb = item % nblk, k0 = 64 * kb, n0 = 32 * nb;
    float wv[32];
#pragma unroll
    for (int i = 0; i < 32; ++i) wv[i] = W[(size_t)(k0 + 2 * i + (lane >> 5)) * N + n0 + (lane & 31)];
#pragma unroll
    for (int i = 0; i < 32; ++i) scr[(2 * i + (lane >> 5)) * 33 + (lane & 31)] = wv[i] * scale;
    LDS_WAIT(); asm volatile("" ::: "memory");
    const int c = lane & 7;
#pragma unroll
    for (int j = 0; j < 4; ++j) { const int n = (lane >> 3) + 8 * j; const LAS float* s = scr + (8 * c) * 33 + n;
        v2u o; o.x = pg8::pk_fp8x4(s[0 * 33], s[1 * 33], s[2 * 33], s[3 * 33]); o.y = pg8::pk_fp8x4(s[4 * 33], s[5 * 33], s[6 * 33], s[7 * 33]);
        *(GAS v2u*)(WT + (size_t)rm(n0 + n) * K + k0 + 8 * c) = o; }
    LDS_WAIT(); asm volatile("" ::: "memory");
}

struct Ptrs {
    const float* in[34]; float* out; unsigned char* ws;
};
enum { I_X = 0, I_C, I_CTX, I_CCTX, I_WADA, I_BADA, I_GMIX, I_GFFN, I_WIN, I_WOUT, I_HCW, I_HCB, I_HW1, I_HB1, I_HW2, I_HB2, I_HW3, I_HFREQ, I_HSKIP,
       I_LQ1, I_LK1, I_LQ2, I_LK2, I_SUBLN, I_QNORM, I_KNORM, I_FWG, I_FWU, I_FWD, I_ROUTER, I_MWG, I_MWU, I_MWD, I_GFINAL };

constexpr int TW_IN = 16 * 72, TW_OUT = 16 * 32, TW_G = 16 * 88, TW_D = 44 * 32;
constexpr int TW_BOUT = 4 * TW_IN, TW_BG = TW_BOUT + 4 * TW_OUT, TW_BD = TW_BG + 4 * TW_G;
__device__ __forceinline__ void transpose_wave_item(int r, int lane, LAS float* scr) {
    unsigned char* ws = KWS();
    if (r < TW_BOUT) { const int l = r / TW_IN; transpose_item(KARG(I_WIN) + (size_t)l * DM * ZP, DM, ZP, (bf16*)(ws + WS_WIN) + (size_t)l * ZP * DM, scr, r % TW_IN, lane, RmWin{}); return; }
    r -= TW_BOUT;
    if (r < 4 * TW_OUT) { const int l = r / TW_OUT; transpose_item(KARG(I_WOUT) + (size_t)l * DM * DM, DM, DM, (bf16*)(ws + WS_WOUT) + (size_t)l * DM * DM, scr, r % TW_OUT, lane, RmId{}); return; }
    r -= 4 * TW_OUT;
    if (r < 4 * TW_G) { const int q = r / TW_G, j = q >> 1, up = q & 1;
        if ((DENSE_F8_UP >> j) & 1) transpose_item8(KARG(up ? I_FWU : I_FWG) + (size_t)j * DM * DFF, DM, DFF, (unsigned char*)(ws + WS_WGU) + (size_t)j * 4 * DFF * DM, scr, r % TW_G, lane, RmGate{up * 128}, pg8::F8_SW);
        else transpose_item(KARG(up ? I_FWU : I_FWG) + (size_t)j * DM * DFF, DM, DFF, (bf16*)(ws + WS_WGU) + (size_t)j * 2 * DFF * DM, scr, r % TW_G, lane, RmGate{up * 128});
        return; }
    r -= 4 * TW_G;
    { const int j = r / TW_D;
        if ((DENSE_F8_DOWN >> j) & 1) transpose_item8(KARG(I_FWD) + (size_t)j * DFF * DM, DFF, DM, (unsigned char*)(ws + WS_WD) + (size_t)j * 2 * DM * DFF, scr, r % TW_D, lane, RmId{}, pg8::F8_SWD);
        else transpose_item(KARG(I_FWD) + (size_t)j * DFF * DM, DFF, DM, (bf16*)(ws + WS_WD) + (size_t)j * DM * DFF, scr, r % TW_D, lane, RmId{}); }
}
constexpr int TWG_CNT[4] = {(TW_IN + TW_OUT) / 8, (TW_IN + TW_OUT + 2 * TW_G + TW_D) / 8, (TW_IN + TW_OUT) / 8, (TW_IN + TW_OUT + 2 * TW_G + TW_D) / 8};
__device__ __forceinline__ int tw_map(int g, int w) {
    const int l = (g == 3) ? 0 : g + 1, jd = (g == 1) ? 1 : 0;
    if (w < TW_IN) return l * TW_IN + w;
    w -= TW_IN;
    if (w < TW_OUT) return TW_BOUT + l * TW_OUT + w;
    w -= TW_OUT;
    if (w < 2 * TW_G) return TW_BG + 2 * jd * TW_G + w;
    w -= 2 * TW_G;
    return TW_BD + jd * TW_D + w;
}
constexpr int CW_P0D = 12288 + 64;
__device__ __forceinline__ bool p0_take(Frame& F, int g, int tid, int lane) {
    if (tid == 0) F.MISC[3] = __hip_atomic_fetch_add(F.ctl + CW_P0D + 64 * g, 1u, RLX_AGENT);
    __syncthreads();
    const int t = (int)F.MISC[3];
    __syncthreads();
    const int cnt = g == 1 ? TWG_CNT[1] : TWG_CNT[0];
    if (t >= cnt) return false;
    transpose_wave_item(tw_map(g, t * 8 + F.wave), lane, (LAS float*)(F.lds + F.wave * 8704));
    return true;
}
__device__ __forceinline__ void p0_defer(Frame& F, int g0, int quota) {
    FRESH_TID();
    int g = g0;
    for (int n = 0; n < quota && g < 3; ) { if (p0_take(F, g, tid, lane)) ++n; else ++g; }
}
__device__ __forceinline__ void p0_drain(Frame& F, int g) {
    FRESH_TID();
    while (p0_take(F, g, tid, lane)) { }
}
#ifdef PROBE_P0
#define g_p0acc (*p0acc_)
__device__ __forceinline__ void p0_prologue(Frame& F, unsigned long long* p0acc_) {
#else
__device__ __forceinline__ void p0_prologue(Frame& F) {
#endif
    FRESH_TID();
    unsigned char* ws = KWS();
    LAS float* scr = (LAS float*)(F.lds + F.wave * 8704);
    constexpr int NT_B = 96, NT_A = TWG_CNT[3], NT_TOT = 272 + NT_B + NT_A;
    LAS float* sct = (LAS float*)(F.lds + 90112);
    for (int i = tid; i < 9 * 1024; i += NWAVES * 64) { const int mi = i >> 10, k = i & 1023; const float c = mi < 8 ? KARG(I_C)[mi * 1024 + k] : KARG(I_CCTX)[k];
        sct[k * 12 + mi] = c / (1.0f + __expf(-c)); }
    gu32* qh = F.ctl + 12288;
#ifdef PROBE_P0
    unsigned long long tprev0_ = 0ull; int typrev_ = -1;
#endif
    for (;;) {
#ifdef PROBE_P0
        if (typrev_ == PROBE_P0) g_p0acc += rt() - tprev0_;
#endif
        if (tid == 0) F.MISC[2] = __hip_atomic_fetch_add(qh, 1u, RLX_AGENT);
        __syncthreads();
        const int tk_ = (int)F.MISC[2];
        __syncthreads();
        if (tk_ >= NT_TOT) break;
        const int t = tk_ >= 544 ? tk_ : ((tk_ & 1) ? (tk_ >> 1) : 272 + (tk_ >> 1));
#ifdef PROBE_P0
        tprev0_ = rt(); typrev_ = t < 272 ? 0 : (t < 272 + NT_B ? 1 : 2);
#endif
        if (t < 272) { int tq_ = tid; asm volatile("" : "+v"(tq_)); const int tid = tq_, lane = tid & 63; (void)lane;
        {
        LAS unsigned short* tile = (LAS unsigned short*)(F.lds + 16896);
        { const int it = t;
            const int l = it / 68, r = it % 68; const bool ctx = r >= 64; const int L = ctx ? 256 : 4096, t0 = 64 * (ctx ? r - 64 : r);
            const float* w1 = KARG(I_HW1) + l * 33 * 64; const float* b1 = KARG(I_HB1) + l * 64; const float* w2 = KARG(I_HW2) + l * 4096; const float* b2 = KARG(I_HB2) + l * 64;
            const float* w3 = KARG(I_HW3) + l * 64 * 512; const float fr_ = KARG(I_HFREQ)[l * 64 + lane];
            float a2r[8], feat[8], z1[8], z2[8];
#pragma unroll
            for (int i = 0; i < 8; ++i) {
                const int t = t0 + F.wave * 8 + i; const float tn = (float)t / (float)(L - 1);
                float f = 0.f;
                if (lane == 0) f = tn;
                else if (lane < 33) { const int kb = (lane - 1) & 15; const float band = 1e-4f + (float)kb * ((15.0f - 1e-4f) / 15.0f); const float rev = ((float)t * band) / (float)L;
                    f = (lane <= 16) ? cos_rev(rev) : -sin_rev(rev); }
                feat[i] = f; z1[i] = b1[lane]; }
#pragma unroll
            for (int k = 0; k < 33; ++k) { const float wk = w1[k * 64 + lane];
#pragma unroll
                for (int i = 0; i < 8; ++i) z1[i] += __int_as_float(__builtin_amdgcn_readlane(__float_as_int(feat[i]), k)) * wk; }
#pragma unroll
            for (int i = 0; i < 8; ++i) { feat[i] = sin_rad(fr_ * z1[i]); z2[i] = b2[lane]; }
#pragma unroll
            for (int k = 0; k < 64; ++k) { const float wk = w2[k * 64 + lane];
#pragma unroll
                for (int i = 0; i < 8; ++i) z2[i] += __int_as_float(__builtin_amdgcn_readlane(__float_as_int(feat[i]), k)) * wk; }
#pragma unroll
            for (int i = 0; i < 8; ++i) a2r[i] = sin_rad(fr_ * z2[i]);
            const float dmin = -3.0701134573253945f, dmax = -15.350567286626972f;
            LAS float* A2 = (LAS float*)F.lds;
#pragma unroll
            for (int i = 0; i < 8; ++i) A2[(F.wave * 8 + i) * 65 + lane] = a2r[i];
            __syncthreads();
            {
                typedef float f32x16 __attribute__((ext_vector_type(16)));
                const int l32 = lane & 31, hi = lane >> 5, col0 = F.wave * 64;
                float bw[2][32];
#pragma unroll
                for (int cb = 0; cb < 2; ++cb)
#pragma unroll
                    for (int sk = 0; sk < 32; ++sk) bw[cb][sk] = w3[(2 * sk + hi) * 512 + col0 + 32 * cb + l32];
                f32x16 acc[2][2];
#pragma unroll
                for (int rb = 0; rb < 2; ++rb)
#pragma unroll
                    for (int cb = 0; cb < 2; ++cb) acc[rb][cb] = (f32x16){0.f,0.f,0.f,0.f,0.f,0.f,0.f,0.f,0.f,0.f,0.f,0.f,0.f,0.f,0.f,0.f};
#pragma unroll
                for (int sk = 0; sk < 32; ++sk) {
#pragma unroll
                    for (int rb = 0; rb < 2; ++rb) { const float a = A2[(rb * 32 + l32) * 65 + 2 * sk + hi];
#pragma unroll
                        for (int cb = 0; cb < 2; ++cb) acc[rb][cb] = __builtin_amdgcn_mfma_f32_32x32x2f32(a, bw[cb][sk], acc[rb][cb], 0, 0, 0); }
                }
#pragma unroll
                for (int cb = 0; cb < 2; ++cb) { const int col = col0 + 32 * cb + l32, ch = col & 255; const float delta = fabsf(dmin + (float)ch * ((dmax - dmin) / 255.0f));
#pragma unroll
                    for (int rb = 0; rb < 2; ++rb)
#pragma unroll
                        for (int r = 0; r < 16; ++r) { const int tl = rb * 32 + (r & 3) + 8 * (r >> 2) + 4 * hi; const float tn = (float)(t0 + tl) / (float)(L - 1);
                            const float v = acc[rb][cb][r] * __expf(-tn * delta); tile[col * 66 + tl] = (unsigned short)(pk2(v, 0.f) & 0xffffu); } }
            }
            __syncthreads();
            unsigned short* R = ctx ? (unsigned short*)(ws + WS_FILTC) + ((size_t)l * 256) * 512 : (unsigned short*)(ws + WS_FILT) + ((size_t)l * 256) * 8192;
            const int RL = 2 * L;
            for (int r = 0; r < 64; ++r) { const int row = F.wave * 64 + r, ch = row & 255; unsigned short* Rc = R + (size_t)ch * RL;
                if (row < 256) Rc[L - t0 - 63 + lane] = tile[ch * 66 + 63 - lane];
                else if (t0 + lane > 0) Rc[L + t0 + lane] = tile[(256 + ch) * 66 + lane]; }
            if (t0 == 0 && tid < 256) R[(size_t)tid * RL] = 0;
            __syncthreads();
        }
    }
        } else if (t < 272 + NT_B) { int tq_ = tid; asm volatile("" : "+v"(tq_)); const int tid = tq_, lane = tid & 63; (void)lane;
    {
        float* mods = (float*)(ws + WS_MODS);
        LAS float* part = (LAS float*)F.lds;
        { const int it = t - 272;
            const int l = it / 24, jb = it % 24, ks = F.wave, j = jb * 256 + 4 * lane;
            const float* wp = KARG(I_WADA) + ((size_t)l * 1024 + ks * 128) * 6144 + j;
            f32x4 acc[9];
#pragma unroll
            for (int mi = 0; mi < 9; ++mi) acc[mi] = (f32x4){0.f, 0.f, 0.f, 0.f};
#pragma unroll 1
            for (int kb = 0; kb < 128; kb += 16) {
                f32x4 wv[16];
#pragma unroll
                for (int k = 0; k < 16; ++k) wv[k] = *(const f32x4*)(wp + (size_t)(kb + k) * 6144);
                asm volatile("" ::: "memory");
#pragma unroll
                for (int k = 0; k < 16; ++k) { const f32x4 w = wv[k]; const LAS float* sp = sct + (ks * 128 + kb + k) * 12;
                    const f32x4 s0 = *(const LAS f32x4*)sp, s1 = *(const LAS f32x4*)(sp + 4); const float s8 = sp[8];
                    acc[0] += w * s0[0]; acc[1] += w * s0[1]; acc[2] += w * s0[2]; acc[3] += w * s0[3]; acc[4] += w * s1[0]; acc[5] += w * s1[1]; acc[6] += w * s1[2]; acc[7] += w * s1[3]; acc[8] += w * s8; }
            }
#pragma unroll
            for (int mi = 0; mi < 9; ++mi) *(LAS f32x4*)(part + (ks * 9 + mi) * 256 + 4 * lane) = acc[mi];
            __syncthreads();
            for (int o = tid; o < 9 * 256; o += NWAVES * 64) { const int mi = o >> 8, jl = o & 255; float sum = KARG(I_BADA)[l * 6144 + jb * 256 + jl];
#pragma unroll
                for (int w8 = 0; w8 < 8; ++w8) sum += part[(w8 * 9 + mi) * 256 + jl];
                mods[((size_t)l * 9 + mi) * 6144 + jb * 256 + jl] = sum; }
            __syncthreads();
        }
    }
        } else { int tq_ = tid; asm volatile("" : "+v"(tq_)); const int tid = tq_, lane = tid & 63; (void)lane;
    {
        { const int w = (t - (272 + NT_B)) * 8 + F.wave;
            transpose_wave_item(tw_map(3, w), lane, scr); }
    }
        }
    }
    if (F.vcu == 0) {
        float* rope = (float*)(ws + WS_ROPE);
        for (int i = tid; i < 512 + 1024; i += NWAVES * 64) {
            const bool g = i >= 512; const int j = g ? i - 512 : i; const int n = g ? 16 : 8, pos = j / n, f = j % n;
            const float inv = exp2f(-13.287712379549449f * (float)f / (float)n);
            const float rev = (float)pos * inv * 0.15915494309189535f;
            if (g) { rope[1024 + j] = cos_rev(rev); rope[2048 + j] = sin_rev(rev); } else { rope[j] = cos_rev(rev); rope[512 + j] = sin_rev(rev); }
        }
        if (tid < 4) { const int l = tid; float s1 = 0.f, s2 = 0.f;
            for (int k = 0; k < 32; ++k) { s1 += KARG(I_LQ1)[l * 32 + k] * KARG(I_LK1)[l * 32 + k]; s2 += KARG(I_LQ2)[l * 32 + k] * KARG(I_LK2)[l * 32 + k]; }
            const float li = 0.8f - 0.6f * __expf(-0.3f * (float)l);
            float mq = 0.f, mk = 0.f;
            for (int k = 0; k < 64; ++k) { mq = fmaxf(mq, fabsf(KARG(I_QNORM)[l * 64 + k])); mk = fmaxf(mk, fabsf(KARG(I_KNORM)[l * 64 + k])); }
            float* sc = (float*)(ws + WS_ROPE + 16384) + l * 4; sc[0] = __expf(s1) - __expf(s2) + li; sc[1] = 1.0f - li;
            sc[2] = 64.0f * mq * mk * pg8::C2G * 1.02f; }
    }
}

struct Comb { const unsigned* route; const bf16* Y; const float* gate; int tb[9]; };
struct Pend { const float* part; const float* gate; int S; const float* ctx32; };
template <bool ROUTE, bool COMB, bool SRC16, bool PEND, bool OUT8 = false>
__device__ __forceinline__ void norm_phase(Frame& F, const void* Hl, const void* Hc, const float* g, const float* mods_l, int sh_chunk, bf16* U, const float* router, unsigned* route, gu32* cnt, int MR, const Comb& cb, const Pend& pd, unsigned char* AS8 = nullptr) {
    FRESH_TID();
    int gw_ = F.vcu * NWAVES + F.wave; asm volatile("" : "+s"(gw_)); const int gw = gw_, NGW = F.G * NWAVES;
    if (ROUTE) { if (tid < 16) ((LAS unsigned*)(F.lds + 64))[tid] = 0u; __syncthreads(); }
    f32x4 gg[4];
#pragma unroll
    for (int j = 0; j < 4; ++j) gg[j] = *(const f32x4*)(g + 256 * j + 4 * lane);
    for (int q = gw; q < MR / 4; q += NGW) {
        const int m0 = 4 * q; const bool lat = m0 < ML; const size_t roff = lat ? (size_t)m0 * DM : (size_t)(m0 - ML) * DM; const void* srcv = lat ? Hl : Hc; const int mi = lat ? (m0 >> 12) : 8;
        const float* shp = mods_l + mi * 6144 + sh_chunk * 1024; const float* scp = shp + 1024;
        f32x4 v[4][4], sc[4], sh[4];
#pragma unroll
        for (int k = 0; k < 4; ++k)
#pragma unroll
            for (int j = 0; j < 4; ++j) {
                if (SRC16) { const v2u w = *(const v2u*)((const bf16*)srcv + roff + (size_t)k * DM + 256 * j + 4 * lane); v[k][j] = (f32x4){bflo(w.x), bfhi(w.x), bflo(w.y), bfhi(w.y)}; }
                else v[k][j] = *(const f32x4*)((const float*)srcv + roff + (size_t)k * DM + 256 * j + 4 * lane); }
#pragma unroll
        for (int j = 0; j < 4; ++j) { sc[j] = *(const f32x4*)(scp + 256 * j + 4 * lane); sh[j] = *(const f32x4*)(shp + 256 * j + 4 * lane); }
        if (PEND && !lat) {
            const int mc = m0 - ML, tile = mc >> 8, rin = mc & 255;
            if (pd.ctx32) {
#pragma unroll
                for (int k = 0; k < 4; ++k)
#pragma unroll
                    for (int j = 0; j < 4; ++j) v[k][j] = *(const f32x4*)(pd.ctx32 + roff + (size_t)k * DM + 256 * j + 4 * lane); }
#pragma unroll
            for (int j = 0; j < 4; ++j) { const f32x4 gt = *(const f32x4*)(pd.gate + 8 * 6144 + 256 * j + 4 * lane);
#pragma unroll
                for (int k = 0; k < 4; ++k) { f32x4 acc = (f32x4){0.f, 0.f, 0.f, 0.f};
                    for (int sidx = 0; sidx < pd.S; ++sidx) acc += *(const f32x4*)(pd.part + ((size_t)((tile * 4 + j) * pd.S + sidx) * 65536) + (size_t)(rin + k) * 256 + 4 * lane);
                    v[k][j] += gt * acc;
                    v2u o; o.x = pk2(v[k][j][0], v[k][j][1]); o.y = pk2(v[k][j][2], v[k][j][3]); *(v2u*)((bf16*)Hc + roff + (size_t)k * DM + 256 * j + 4 * lane) = o;
                    v[k][j] = (f32x4){bflo(o.x), bfhi(o.x), bflo(o.y), bfhi(o.y)}; } }
        }
        if (COMB) {
            v4u ra[4];
#pragma unroll
            for (int k = 0; k < 4; ++k) ra[k] = *(const v4u*)(cb.route + (size_t)(m0 + k) * 4);
            f32x4 gt[4];
#pragma unroll
            for (int j = 0; j < 4; ++j) gt[j] = *(const f32x4*)(cb.gate + mi * 6144 + 256 * j + 4 * lane);
#pragma unroll
            for (int k = 0; k < 4; ++k) {
                int b1 = 0, b2 = 0;
#pragma unroll
                for (int e = 0; e < 8; ++e) { b1 = ((int)(ra[k].x & 255u) == e) ? cb.tb[e] : b1; b2 = ((int)(ra[k].x >> 8) == e) ? cb.tb[e] : b2; }
                const bf16* y1 = cb.Y + ((size_t)b1 * 256 + ra[k].y) * DM; const bf16* y2 = cb.Y + ((size_t)b2 * 256 + ra[k].z) * DM;
                const float w1 = __uint_as_float(ra[k].w), w2 = 1.0f - w1;
                v2u p1[4], p2[4];
#pragma unroll
                for (int j = 0; j < 4; ++j) { p1[j] = *(const v2u*)(y1 + 256 * j + 4 * lane); p2[j] = *(const v2u*)(y2 + 256 * j + 4 * lane); }
#pragma unroll
                for (int j = 0; j < 4; ++j) {
                    v[k][j][0] += gt[j][0] * (w1 * bflo(p1[j].x) + w2 * bflo(p2[j].x)); v[k][j][1] += gt[j][1] * (w1 * bfhi(p1[j].x) + w2 * bfhi(p2[j].x));
                    v[k][j][2] += gt[j][2] * (w1 * bflo(p1[j].y) + w2 * bflo(p2[j].y)); v[k][j][3] += gt[j][3] * (w1 * bfhi(p1[j].y) + w2 * bfhi(p2[j].y));
                    { v2u o; o.x = pk2(v[k][j][0], v[k][j][1]); o.y = pk2(v[k][j][2], v[k][j][3]); *(v2u*)((bf16*)srcv + roff + (size_t)k * DM + 256 * j + 4 * lane) = o;
                      v[k][j] = (f32x4){bflo(o.x), bfhi(o.x), bflo(o.y), bfhi(o.y)}; } }
            }
        }
        float rstd[4];
#pragma unroll
        for (int k = 0; k < 4; ++k) { float s = 0.f;
#pragma unroll
            for (int j = 0; j < 4; ++j) s += (v[k][j][0] * v[k][j][0] + v[k][j][1] * v[k][j][1]) + (v[k][j][2] * v[k][j][2] + v[k][j][3] * v[k][j][3]);
            rstd[k] = s; }
#pragma unroll
        for (int o = 1; o < 64; o <<= 1) {
#pragma unroll
            for (int k = 0; k < 4; ++k) rstd[k] += shx(rstd[k], o, lane); }
#pragma unroll
        for (int k = 0; k < 4; ++k) rstd[k] = __builtin_amdgcn_rsqf(rstd[k] * (1.0f / DM) + NORM_EPS);
        float lg[4][8];
        if (ROUTE) {
#pragma unroll
            for (int k = 0; k < 4; ++k)
#pragma unroll
                for (int e = 0; e < 8; ++e) lg[k][e] = 0.f; }
#pragma unroll
        for (int j = 0; j < 4; ++j) { const int c0 = 256 * j + 4 * lane;
#pragma unroll
            for (int k = 0; k < 4; ++k) {
                v[k][j] = (v[k][j] * rstd[k]) * gg[j] * (sc[j] + 1.0f) + sh[j];
                if (OUT8) { constexpr float sa = pg8::F8_SA; st_wt4((unsigned char*)U + (size_t)(m0 + k) * DM + c0, pg8::pk_fp8x4(v[k][j][0] * sa, v[k][j][1] * sa, v[k][j][2] * sa, v[k][j][3] * sa)); }
                else { v2u o; o.x = pk2(v[k][j][0], v[k][j][1]); o.y = pk2(v[k][j][2], v[k][j][3]);
                st_wt8(U + (size_t)(m0 + k) * DM + c0, o); } }
            if (ROUTE) {
#pragma unroll
                for (int i = 0; i < 4; ++i) { const f32x4 r0 = *(const f32x4*)(router + (size_t)(c0 + i) * 8), r1 = *(const f32x4*)(router + (size_t)(c0 + i) * 8 + 4);
#pragma unroll
                    for (int k = 0; k < 4; ++k) { const float x = v[k][j][i];
                        lg[k][0] += x * r0[0]; lg[k][1] += x * r0[1]; lg[k][2] += x * r0[2]; lg[k][3] += x * r0[3]; lg[k][4] += x * r1[0]; lg[k][5] += x * r1[1]; lg[k][6] += x * r1[2]; lg[k][7] += x * r1[3]; } } }
        }
        if (ROUTE) {
#pragma unroll
            for (int o = 1; o < 64; o <<= 1) {
#pragma unroll
                for (int k = 0; k < 4; ++k)
#pragma unroll
                    for (int e = 0; e < 8; ++e) lg[k][e] += shx(lg[k][e], o, lane); }
            if (lane < 4) {
                float l8[8];
#pragma unroll
                for (int e = 0; e < 8; ++e) l8[e] = lane == 0 ? lg[0][e] : (lane == 1 ? lg[1][e] : (lane == 2 ? lg[2][e] : lg[3][e]));
                int i1 = 0; float v1 = l8[0];
#pragma unroll
                for (int e = 1; e < 8; ++e) if (l8[e] > v1) { v1 = l8[e]; i1 = e; }
                int i2 = -1; float v2 = 0.f;
#pragma unroll
                for (int e = 0; e < 8; ++e) if (e != i1 && (i2 < 0 || l8[e] > v2)) { v2 = l8[e]; i2 = e; }
                const float w1 = 1.0f / (1.0f + __expf(v2 - v1)), w2 = 1.0f - w1;
                const unsigned s1 = __hip_atomic_fetch_add((LAS unsigned*)(F.lds + 64) + i1, 1u, __ATOMIC_RELAXED, __HIP_MEMORY_SCOPE_WORKGROUP);
                const unsigned s2 = __hip_atomic_fetch_add((LAS unsigned*)(F.lds + 64) + i2, 1u, __ATOMIC_RELAXED, __HIP_MEMORY_SCOPE_WORKGROUP);
                (void)w2; v4u a; a.x = (unsigned)i1 | ((unsigned)i2 << 8); a.y = s1; a.z = s2; a.w = __float_as_uint(w1);
                *(v4u*)(route + (size_t)(m0 + lane) * 4) = a;
            }
        }
    }
    if (ROUTE) {
        LAS unsigned* lc = (LAS unsigned*)(F.lds + 64);
        __syncthreads();
        if (tid < 8) lc[8 + tid] = __hip_atomic_fetch_add(cnt + 64 * tid, lc[tid], RLX_AGENT);
        __syncthreads();
        asm volatile("s_waitcnt vmcnt(0)" ::: "memory");
        for (int q = gw; q < MR / 4; q += NGW) {
            v4u a = {0u, 0u, 0u, 0u}; v4u rowv[4];
#pragma unroll
            for (int k = 0; k < 4; ++k) rowv[k] = *(const v4u*)((const unsigned char*)U + (size_t)(4 * q + k) * DM + 16 * lane);
            if (lane < 4) { const int m = 4 * q + lane; a = *(v4u*)(route + (size_t)m * 4); a.y += lc[8 + (a.x & 255u)]; a.z += lc[8 + (a.x >> 8)]; *(v4u*)(route + (size_t)m * 4) = a; }
#pragma unroll
            for (int k = 0; k < 4; ++k) {
                const unsigned ex = (unsigned)__builtin_amdgcn_readlane((int)a.x, k), s1 = (unsigned)__builtin_amdgcn_readlane((int)a.y, k), s2 = (unsigned)__builtin_amdgcn_readlane((int)a.z, k);
                st_wt16(AS8 + ((size_t)(ex & 255u) * MOE_CAP + s1) * DM + 16 * lane, rowv[k]); st_wt16(AS8 + ((size_t)(ex >> 8) * MOE_CAP + s2) * DM + 16 * lane, rowv[k]); }
        }
        __syncthreads();
    }
}
constexpr int CW_FILL = 10240;
__device__ __forceinline__ void moe_filler(Frame& F, int li, int quota) {
    FRESH_TID();
    LAS float* scr = (LAS float*)(F.lds + F.wave * 8704);
    constexpr int I_G = 16 * 112, I_D = 56 * 32, NIT = 16 * I_G + 8 * I_D;
    static_assert(NIT % 8 == 0, "block items");
    gu32* qh = F.ctl + CW_FILL + 64 * li;
    for (int n = 0; n < quota; ++n) {
        if (tid == 0) F.MISC[1] = __hip_atomic_fetch_add(qh, 1u, RLX_AGENT);
        __syncthreads();
        const int t = (int)F.MISC[1];
        __syncthreads();
        if (t >= NIT / 8) break;
        int r = t * 8 + F.wave;
        if (r < 16 * I_G) { const int q = r / I_G, e = q >> 1, up = q & 1;
            transpose_item8(KARG(up ? I_MWU : I_MWG) + ((size_t)li * 8 + e) * DM * DFE, DM, DFE, (unsigned char*)(KWS() + WS_MWGU) + ((size_t)li * 8 + e) * 2 * DFE * DM, scr, r % I_G, lane, RmGate{up * 128}, pg8::F8_SW); }
        else { r -= 16 * I_G; const int e = r / I_D; transpose_item8(KARG(I_MWD) + ((size_t)li * 8 + e) * DFE * DM, DFE, DM, (unsigned char*)(KWS() + WS_MWD) + ((size_t)li * 8 + e) * DM * DFE, scr, r % I_D, lane, RmId{}, pg8::F8_SWD); }
    }
}
__device__ __forceinline__ void moe_tile_base(const gu32* cnt, int (&tb)[9]) {
    tb[0] = 0;
#pragma unroll
    for (int e = 0; e < 8; ++e) { const unsigned c = __hip_atomic_load(cnt + 64 * e, RLX_AGENT); tb[e + 1] = tb[e] + (int)((c + 255u) >> 8); }
}
__device__ __forceinline__ void gather_phase(Frame& F, const unsigned char* U8, const unsigned* route, const int (&tb)[9], unsigned char* AS, int MR) {
    FRESH_TID();
    int gw_ = F.vcu * NWAVES + F.wave; asm volatile("" : "+s"(gw_)); const int gw = gw_, NGW = F.G * NWAVES;
    for (int m0 = gw; m0 < MR; m0 += 8 * NGW) {
        v4u x0[8]; size_t r1[8], r2[8];
#pragma unroll
        for (int k = 0; k < 8; ++k) { const int m = m0 + k * NGW; const int mc = m < MR ? m : m0;
            const v4u a = *(const v4u*)(route + (size_t)mc * 4); const int e1 = (int)(a.x & 255u), e2 = (int)(a.x >> 8);
            int b1 = 0, b2 = 0;
#pragma unroll
            for (int e = 0; e < 8; ++e) { b1 = (e1 == e) ? tb[e] : b1; b2 = (e2 == e) ? tb[e] : b2; }
            r1[k] = (size_t)b1 * 256 + a.y; r2[k] = (size_t)b2 * 256 + a.z;
            x0[k] = *(const v4u*)(U8 + (size_t)mc * DM + 16 * lane); }
#pragma unroll
        for (int k = 0; k < 8; ++k) { if (m0 + k * NGW < MR) { st_wt16(AS + r1[k] * DM + 16 * lane, x0[k]); st_wt16(AS + r2[k] * DM + 16 * lane, x0[k]); } }
    }
}
__device__ __forceinline__ void final_phase(Frame& F, const bf16* H, float* OUT, const float* g, const Comb& cb) {
    FRESH_TID();
    int gw_ = F.vcu * NWAVES + F.wave; asm volatile("" : "+s"(gw_)); const int gw = gw_, NGW = F.G * NWAVES;
    f32x4 gg[4];
#pragma unroll
    for (int j = 0; j < 4; ++j) gg[j] = *(const f32x4*)(g + 256 * j + 4 * lane);
    for (int q = gw; q < ML / 4; q += NGW) { const int m0 = 4 * q; const bf16* hp = H + (size_t)m0 * DM; float* op = OUT + (size_t)m0 * DM; const int mi = m0 >> 12;
        f32x4 v[4][4]; v4u ra[4]; f32x4 gt[4];
#pragma unroll
        for (int k = 0; k < 4; ++k) {
#pragma unroll
            for (int j = 0; j < 4; ++j) { const v2u w = *(const v2u*)(hp + (size_t)k * DM + 256 * j + 4 * lane); v[k][j] = (f32x4){bflo(w.x), bfhi(w.x), bflo(w.y), bfhi(w.y)}; }
            ra[k] = *(const v4u*)(cb.route + (size_t)(m0 + k) * 4); }
#pragma unroll
        for (int j = 0; j < 4; ++j) gt[j] = *(const f32x4*)(cb.gate + mi * 6144 + 256 * j + 4 * lane);
#pragma unroll
        for (int k = 0; k < 4; ++k) {
            int b1 = 0, b2 = 0;
#pragma unroll
            for (int e = 0; e < 8; ++e) { b1 = ((int)(ra[k].x & 255u) == e) ? cb.tb[e] : b1; b2 = ((int)(ra[k].x >> 8) == e) ? cb.tb[e] : b2; }
            const bf16* y1 = cb.Y + ((size_t)b1 * 256 + ra[k].y) * DM; const bf16* y2 = cb.Y + ((size_t)b2 * 256 + ra[k].z) * DM;
            const float w1 = __uint_as_float(ra[k].w), w2 = 1.0f - w1;
            v2u p1[4], p2[4];
#pragma unroll
            for (int j = 0; j < 4; ++j) { p1[j] = *(const v2u*)(y1 + 256 * j + 4 * lane); p2[j] = *(const v2u*)(y2 + 256 * j + 4 * lane); }
#pragma unroll
            for (int j = 0; j < 4; ++j) {
                v[k][j][0] += gt[j][0] * (w1 * bflo(p1[j].x) + w2 * bflo(p2[j].x)); v[k][j][1] += gt[j][1] * (w1 * bfhi(p1[j].x) + w2 * bfhi(p2[j].x));
                v[k][j][2] += gt[j][2] * (w1 * bflo(p1[j].y) + w2 * bflo(p2[j].y)); v[k][j][3] += gt[j][3] * (w1 * bfhi(p1[j].y) + w2 * bfhi(p2[j].y)); }
        }
        float rstd[4];
#pragma unroll
        for (int k = 0; k < 4; ++k) { float s = 0.f;
#pragma unroll
            for (int j = 0; j < 4; ++j) s += (v[k][j][0] * v[k][j][0] + v[k][j][1] * v[k][j][1]) + (v[k][j][2] * v[k][j][2] + v[k][j][3] * v[k][j][3]);
            rstd[k] = s; }
#pragma unroll
        for (int o = 1; o < 64; o <<= 1) {
#pragma unroll
            for (int k = 0; k < 4; ++k) rstd[k] += shx(rstd[k], o, lane); }
#pragma unroll
        for (int k = 0; k < 4; ++k) { const float r = __builtin_amdgcn_rsqf(rstd[k] * (1.0f / DM) + NORM_EPS);
#pragma unroll
            for (int j = 0; j < 4; ++j) *(f32x4*)(op + (size_t)k * DM + 256 * j + 4 * lane) = (v[k][j] * r) * gg[j]; }
    }
}

__device__ __forceinline__ void hypre_phase(Frame& F, const bf16* Z, const float* cw, const float* cb, bf16* VVT, bf16* X0T, int nitems, const bool wr = true) {
    FRESH_TID();
    int gw_ = F.vcu * NWAVES + F.wave; asm volatile("" : "+s"(gw_)); const int gw = gw_, NGW = F.G * NWAVES;
    const int b = lane & 7, cl = lane >> 3;
    LAS unsigned char* st = F.lds + F.wave * 8192;
    LAS float* wl = (LAS float*)(F.lds + 65536);
    for (int i = tid; i < 256 * 12; i += NWAVES * 64) { const int c = i / 12, k = i - 12 * c; wl[i] = (k < 3) ? cb[k * 256 + c] : cw[((k - 3) % 3) * 768 + ((k - 3) / 3) * 256 + c]; }
    __syncthreads();
    const int NI = 8 * nitems;
    const v4u z4 = {0u, 0u, 0u, 0u};
    for (int it0 = gw; it0 < NI; it0 += 2 * NGW) {
        v4u la[2][3], lb[2][3]; size_t off[2]; int cch[2]; bool oka[2], okb[2];
#pragma unroll
        for (int u = 0; u < 2; ++u) {
            const int itu = it0 + u * NGW, it = itu < NI ? itu : it0;
            const int r0 = it >> 3, co = it & 7;
            const bool ctx = r0 >= 2048; const int r = ctx ? r0 - 2048 : r0, tch = r >> 2, L = ctx ? NCTX : SEQL, t0 = 8 * tch, c0 = (r & 3) * 64 + co * 8, c = c0 + cl;
            const size_t rowb = ctx ? (size_t)ML + (size_t)b * NCTX : (size_t)b * SEQL;
            const int ta = t0 - 1 + cl, tb2 = t0 + 7 + (cl & 1);
            oka[u] = ta >= 0; okb[u] = tb2 < L;
            const bf16* pa = Z + (rowb + (oka[u] ? ta : 0)) * ZP + c0; const bf16* pb = Z + (rowb + (okb[u] ? tb2 : 0)) * ZP + c0;
#pragma unroll
            for (int s3 = 0; s3 < 3; ++s3) { la[u][s3] = *(const v4u*)(pa + s3 * 256); lb[u][s3] = *(const v4u*)(pb + s3 * 256); }
            cch[u] = c;
            off[u] = (ctx ? G_CBASE + (size_t)c * GS_CTX : (size_t)c * GS_LAT) + (size_t)tch * 64 + b * 8;
        }
#pragma unroll
        for (int u = 0; u < 2; ++u)
#pragma unroll
            for (int s3 = 0; s3 < 3; ++s3) {
                *(LAS v4u*)(st + u * 4096 + ((s3 * 10 + cl) * 8 + b) * 16) = oka[u] ? la[u][s3] : z4;
                if (cl < 2) *(LAS v4u*)(st + u * 4096 + ((s3 * 10 + 8 + cl) * 8 + b) * 16) = okb[u] ? lb[u][s3] : z4;
            }
        LDS_WAIT(); asm volatile("" ::: "memory");
#pragma unroll
        for (int u = 0; u < 2; ++u) {
            if (it0 + u * NGW >= NI) break;
            float wv[12];
#pragma unroll
            for (int q = 0; q < 3; ++q) { const f32x4 t4 = *(const LAS f32x4*)(wl + cch[u] * 12 + 4 * q); wv[4 * q] = t4[0]; wv[4 * q + 1] = t4[1]; wv[4 * q + 2] = t4[2]; wv[4 * q + 3] = t4[3]; }
            float zz[3][10];
#pragma unroll
            for (int s3 = 0; s3 < 3; ++s3)
#pragma unroll
                for (int i = 0; i < 10; ++i) zz[s3][i] = bf2f(*(const LAS unsigned short*)(st + u * 4096 + ((s3 * 10 + i) * 8 + b) * 16 + cl * 2));
            float vv[8], x0[8];
#pragma unroll
            for (int i = 0; i < 8; ++i) { float y[3];
#pragma unroll
                for (int s3 = 0; s3 < 3; ++s3) y[s3] = wv[s3] + zz[s3][i] * wv[3 + 3 * s3] + zz[s3][i + 1] * wv[4 + 3 * s3] + zz[s3][i + 2] * wv[5 + 3 * s3];
                x0[i] = y[0]; vv[i] = y[2] * y[1]; }
            v4u gv, gx; gv.x = pk2(vv[0], vv[1]); gv.y = pk2(vv[2], vv[3]); gv.z = pk2(vv[4], vv[5]); gv.w = pk2(vv[6], vv[7]);
            gx.x = pk2(x0[0], x0[1]); gx.y = pk2(x0[2], x0[3]); gx.z = pk2(x0[4], x0[5]); gx.w = pk2(x0[6], x0[7]);
            if (wr || gv.x == 0x12345678u) { st_wt16(VVT + off[u], gv); st_wt16(X0T + off[u], gx); }
        }
        LDS_WAIT(); asm volatile("" ::: "memory");
    }
    __syncthreads();
}
__device__ __forceinline__ void hypost_phase(Frame& F, const bf16* YT, bf16* MIX, int nitems) {
    FRESH_TID();
    int gw_ = F.vcu * NWAVES + F.wave; asm volatile("" : "+s"(gw_)); const int gw = gw_, NGW = F.G * NWAVES;
    for (int it4 = gw; it4 < 4 * nitems; it4 += NGW) {
        const int it = it4 >> 2, b0 = 2 * (it4 & 3);
        const bool ctx = it >= 2048; const int r = ctx ? it - 2048 : it, tch = r >> 2, cg = r & 3, t0 = 8 * tch, c = cg * 64 + lane;
        const bf16* gp = YT + (ctx ? G_CBASE + (size_t)c * GS_CTX : (size_t)c * GS_LAT) + (size_t)tch * 64;
        v4u g[2];
#pragma unroll
        for (int bb = 0; bb < 2; ++bb) g[bb] = *(const v4u*)(gp + (b0 + bb) * 8);
#pragma unroll
        for (int bb = 0; bb < 2; ++bb) { const int b = b0 + bb;
            const size_t row = ctx ? (size_t)ML + (size_t)b * NCTX + t0 : (size_t)b * SEQL + t0;
            bf16* mp = MIX + row * DM + c;
            const unsigned wv[4] = {g[bb].x, g[bb].y, g[bb].z, g[bb].w};
#pragma unroll
            for (int i = 0; i < 8; ++i) mp[(size_t)i * DM] = (bf16)((i & 1) ? (wv[i >> 1] >> 16) : (wv[i >> 1] & 0xffffu));
        }
    }
}
constexpr int UX_DIFF = 64, UX_GQA = 128, UX_HY = 32, UX_CDIFF = 4, UX_CGQA = 8, UX_CHY = 32;
constexpr int NUNITS_X = UX_DIFF + UX_GQA + UX_HY + UX_CDIFF + UX_CGQA + UX_CHY, NUNITS_X_LAST = UX_DIFF + UX_GQA + UX_HY;
__device__ __forceinline__ void diff_refs(Frame& F, int l, int b, int hh, float& r1, float& r2) {
    const gu32* d = F.ctl + CW_DMAX + 128 * l + (b * 4 + hh) * 4;
    const float q0 = __uint_as_float(__hip_atomic_load(d + 0, RLX_AGENT)), k0 = __uint_as_float(__hip_atomic_load(d + 1, RLX_AGENT));
    const float q1 = __uint_as_float(__hip_atomic_load(d + 2, RLX_AGENT)), k1 = __uint_as_float(__hip_atomic_load(d + 3, RLX_AGENT));
    r1 = __builtin_bit_cast(float, __builtin_amdgcn_readfirstlane(__builtin_bit_cast(int, sqrtf(q0 * k0) * 1.02f))); r2 = __builtin_bit_cast(float, __builtin_amdgcn_readfirstlane(__builtin_bit_cast(int, sqrtf(q1 * k1) * 1.02f)));
}
#ifndef MIX_INTERLEAVE
#define MIX_INTERLEAVE 0
#endif
#ifndef PROBE_MIXT
#define PROBE_MIXT 0
#endif
#define MIXT(ty, ...) do { unsigned long long t0_ = 0ull; if ((PROBE_MIXT >> (ty)) & 1) t0_ = rt(); __VA_ARGS__; if (((PROBE_MIXT >> (ty)) & 1) && threadIdx.x == 0) atomicAdd((unsigned long long*)(KWS() + WS_ROPE + 32768), rt() - t0_); } while (0)
__device__ __forceinline__ void mix_phase(Frame& F, int l, unsigned char* lds_generic, int qslot, int nunits) {
    FRESH_TID();
    unsigned char* ws = KWS();
    const attn_body::bf16* Z = (const attn_body::bf16*)(ws + WS_Z); attn_body::bf16* MIX = (attn_body::bf16*)(ws + WS_MIX);
    const float* scal = (const float*)(ws + WS_ROPE + 16384) + l * 4;
    #define RFL_F(x) __builtin_bit_cast(float, __builtin_amdgcn_readfirstlane(__builtin_bit_cast(int, (float)(x))))
    const float lam = RFL_F(scal[0]), sub_scale = RFL_F(scal[1]), gqa_ref = RFL_F(scal[2]);
    const float* subln = KARG(I_SUBLN) + l * 64;
    const int x = (int)blockIdx.x & 7, b = x;
    gu32* qh = F.ctl + CW_QMIX + 64 * (qslot * 8 + x);
    for (;;) {
        if (tid == 0) F.MISC[0] = __hip_atomic_fetch_add(qh, 1u, RLX_AGENT);
        __syncthreads();
        const int t = (int)F.MISC[0];
        __syncthreads();
        if (t >= nunits) break;
        int j = t;
        if (MIX_INTERLEAVE && j < UX_DIFF + UX_GQA + UX_HY) {
            if (j < 160) { const int q = j / 5, r = j - 5 * q; j = (r == 0 || r == 3) ? 2 * q + (r == 3) : UX_DIFF + 3 * q + (r == 1 ? 0 : (r == 2 ? 1 : 2)); }
            else { const int q = (j - 160) >> 1; j = ((j - 160) & 1) ? UX_DIFF + UX_GQA + q : UX_DIFF + 96 + q; }
        }
        if (j < UX_DIFF + UX_GQA) {
            const bool diff = j < UX_DIFF; if (!diff) j -= UX_DIFF;
            const int qb = j & 15, hh = j >> 4;
            const size_t qrow = (size_t)b * SEQL + qb * 256;
            if (diff) { float r1, r2; diff_refs(F, l, b, hh, r1, r2);
                MIXT(0, attn_body::diff_unit<8>(Z + qrow * ZP + 768 + hh * 64, Z + 1024 + hh * 64, Z + 1280 + hh * 64, b * SEQL, ML + b * NCTX, 64, 68, MIX + qrow * DM + 256 + hh * 64, (char*)lds_generic, lam, subln, sub_scale, r1 < 48.f && r2 < 48.f, r1, r2)); }
            else MIXT(1, attn_body::attn_unit<0, 8>(Z + qrow * ZP + 1536 + hh * 64, Z + 2048 + (hh >> 2) * 64, Z + 2176 + (hh >> 2) * 64, b * SEQL, ML + b * NCTX, 64, 68, MIX + qrow * DM + 512 + hh * 64, (char*)lds_generic, gqa_ref, subln, 0.f, gqa_ref < 48.f));
            continue;
        }
        j -= UX_DIFF + UX_GQA;
        if (j < UX_HY) {
            const int c = j * 8 + x;
            MIXT(2, hy::conv_unit<4, 64>(F.lds, (const unsigned short*)(ws + WS_FILT) + ((size_t)l * 256 + c) * 8192, (const unsigned short*)(ws + WS_VVT) + (size_t)c * GS_LAT,
                                 (const unsigned short*)(ws + WS_X0T) + (size_t)c * GS_LAT, (unsigned short*)(ws + WS_YT) + (size_t)c * GS_LAT, KARG(I_HSKIP)[l * 256 + c]));
            continue;
        }
        j -= UX_HY;
        if (j < UX_CDIFF + UX_CGQA) {
            const bool diff = j < UX_CDIFF; if (!diff) j -= UX_CDIFF;
            const int hh = j;
            const size_t qrow = (size_t)ML + (size_t)b * NCTX;
            if (diff) { float r1, r2; diff_refs(F, l, b, hh, r1, r2);
                attn_body::diff_unit<8>(Z + qrow * ZP + 768 + hh * 64, Z + 1024 + hh * 64, Z + 1280 + hh * 64, 0, ML + b * NCTX, 0, 4, MIX + qrow * DM + 256 + hh * 64, (char*)lds_generic, lam, subln, sub_scale, r1 < 48.f && r2 < 48.f, r1, r2); }
            else attn_body::attn_unit<0, 8>(Z + qrow * ZP + 1536 + hh * 64, Z + 2048 + (hh >> 2) * 64, Z + 2176 + (hh >> 2) * 64, 0, ML + b * NCTX, 0, 4, MIX + qrow * DM + 512 + hh * 64, (char*)lds_generic, gqa_ref, subln, 0.f, gqa_ref < 48.f);
            continue;
        }
        j -= UX_CDIFF + UX_CGQA;
        { const int c = j * 8 + x; const size_t base = G_CBASE;
            hy::conv_unit<1, 4>(F.lds, (const unsigned short*)(ws + WS_FILTC) + ((size_t)l * 256 + c) * 512, (const unsigned short*)(ws + WS_VVT) + base + (size_t)c * GS_CTX,
                                (const unsigned short*)(ws + WS_X0T) + base + (size_t)c * GS_CTX, (unsigned short*)(ws + WS_YT) + base + (size_t)c * GS_CTX, KARG(I_HSKIP)[l * 256 + c]); }
    }
}

#ifndef PROBE_IDLE
#define PROBE_IDLE 0
#endif
#ifndef PROBE_DUP
#define PROBE_DUP (-1)
#endif
#ifndef PROBE_DRY
#define PROBE_DRY 0
#endif
#ifndef PROBE_BAR
#define PROBE_BAR 0
#endif
#define DUP(k, ...) for (int rep_ = 0; rep_ < ((PROBE_DUP == (k)) ? args.nrep : 1); ++rep_) { __VA_ARGS__; if (PROBE_BAR && PROBE_DUP == (k) && rep_ == 0) xcd_barrier(bar); }
#ifndef STAGGER_US
#define STAGGER_US 0
#endif
__device__ __forceinline__ void stagger(int us) { if (us > 0 && (blockIdx.x >> 3) & 1) { const unsigned long long t0 = rt(); while (rt() - t0 < (unsigned long long)us * 100ull) __builtin_amdgcn_s_sleep(16); } }
struct Args { Ptrs p; int ph_lo, ph_hi, use_bar, nrep; };
__global__ void __launch_bounds__(NWAVES * 64, 2) trunk_fwd(Args args) {
    extern __shared__ __attribute__((aligned(16))) unsigned char lds[];
    Frame F;
    F.lds = (LAS unsigned char*)lds; F.MISC = (volatile LAS unsigned*)(F.lds + MISC_OFF);
    F.wave = __builtin_amdgcn_readfirstlane(threadIdx.x >> 6);
    F.G = gridDim.x; { const int bx = blockIdx.x; F.vcu = (F.G % 8 == 0) ? (bx % 8) * (F.G / 8) + bx / 8 : bx; }
    unsigned char* ws = KWS();
    F.ctl = (gu32*)(ws + WS_CTL);
    for (int u = threadIdx.x; u < (LDS_BYTES - LDSCTL_OFF) / 4; u += NWAVES * 64) ((LAS unsigned*)(F.lds + LDSCTL_OFF))[u] = 0u;
    __syncthreads();
    XcdBarrier bar; bar.bar = (unsigned*)(F.ctl + CW_BAR); bar.x = 0; bar.st = nullptr;
    if (args.use_bar) bar = xcd_barrier_post((unsigned*)(F.ctl + CW_BAR), F.MISC + 8);
    if (PROBE_IDLE && blockIdx.x == 0 && threadIdx.x == 0) *(volatile unsigned long long*)(KWS() + WS_ROPE + 32768) = 0ull;
    const int lo = args.ph_lo, hi = args.ph_hi;
#define IN(k) (lo <= (k) && (k) < hi)
#ifndef PROBE_TSEL
#define PROBE_TSEL 0
#endif
#ifndef PROBE_TK
#define PROBE_TK 4
#endif
    unsigned long long tacc_ = 0ull, tprev_ = PROBE_TSEL ? rt() : 0ull;
#define SEAM(k) do { unsigned long long ta_ = 0ull; if (PROBE_IDLE) ta_ = rt(); if ((k) + 1 < hi) xcd_barrier(bar); if (PROBE_IDLE) { const int ty_ = ((k) == 0) ? 12 : (((k) - 1) % NPL); if (((PROBE_IDLE >> ty_) & 1) && threadIdx.x == 0) atomicAdd((unsigned long long*)(ws + WS_ROPE + 32768), rt() - ta_); } if (PROBE_TSEL) { const unsigned long long now_ = rt(); const int ty_ = ((k) == 0) ? 12 : (((k) - 1) % NPL); if ((PROBE_TSEL >> ty_) & 1) tacc_ += now_ - tprev_; tprev_ = now_; } } while (0)

    bf16* Hl = (bf16*)(ws + WS_HB); bf16* Hc = (bf16*)(ws + WS_HC);
    bf16* U = (bf16*)(ws + WS_U);
    const float* mods = (const float*)(ws + WS_MODS);
    unsigned* route = (unsigned*)(ws + WS_ROUTE);

#ifdef PROBE_P0
    unsigned long long p0acc = 0ull;
    if (IN(0)) { p0_prologue(F, &p0acc); SEAM(0); }
#else
    if (IN(0)) { DUP(100, p0_prologue(F)); SEAM(0); }
#endif

    for (int l = 0; l < DEPTH; ++l) {
        const int pb = 1 + l * NPL; const bool moe = (l & 1) != 0; const int li = l >> 1; const bool last = l == DEPTH - 1; const int MR = last ? ML : MT; const int fill_li = (l == 0) ? 0 : ((l == 3) ? -1 : 1);
        const float* mods_l = mods + (size_t)l * 9 * 6144;
        gu32* cnt = F.ctl + CW_CNT + 64 * 8 * li;
        if (IN(pb + PH_NORM1)) {
            Pend pd{};
            if (l >= 2 && !moe) {
                Comb cb; cb.route = route; cb.Y = (const bf16*)(ws + WS_AS); cb.gate = mods + (size_t)(l - 1) * 9 * 6144 + 5 * 1024; moe_tile_base(F.ctl + CW_CNT + 64 * 8 * ((l - 1) >> 1), cb.tb);
                norm_phase<false, true, true, false>(F, Hl, Hc, KARG(I_GMIX) + l * DM, mods_l, 0, U, nullptr, nullptr, nullptr, MT, cb, pd);
            } else { Comb cb{};
                if (l == 0) norm_phase<false, false, false, false>(F, KARG(I_X), KARG(I_CTX), KARG(I_GMIX) + l * DM, mods_l, 0, U, nullptr, nullptr, nullptr, MT, cb, pd);
                else norm_phase<false, false, true, false>(F, Hl, Hc, KARG(I_GMIX) + l * DM, mods_l, 0, U, nullptr, nullptr, nullptr, MT, cb, pd); }
            if (l >= 1) { __syncthreads(); p0_drain(F, l - 1); }
            SEAM(pb + PH_NORM1);
        }
        if (IN(pb + PH_WIN)) {
            pg8::Gemm g{U, (const bf16*)(ws + WS_WIN) + (size_t)l * ZP * DM, MT, ZP, DM, DM}; pg8::Sched2 S; S.init(MT / 256, ZP / 256, F.G, (int)blockIdx.x);
            { const float* rg = (const float*)(ws + WS_ROPE); LAS float* rl = (LAS float*)(F.lds + ROPE_LDS_OFF); int t0_ = threadIdx.x; asm volatile("" : "+v"(t0_)); for (int i = t0_; i < 3072; i += NWAVES * 64) rl[i] = rg[i]; __syncthreads(); }
            pg8::EpiWin E{(bf16*)(ws + WS_Z), (const LAS float*)(F.lds + ROPE_LDS_OFF), KARG(I_QNORM) + l * 64, KARG(I_KNORM) + l * 64, (unsigned*)(F.ctl + CW_DMAX + 128 * l)};
            DUP(PH_WIN, pg8::gemm_phase<pg8::EpiWin, pg8::Sched2, true, true>(F.lds, g, S, E));
            { const int mine = ((int)blockIdx.x < S.nwg) ? (S.nwg - 1 - (int)blockIdx.x) / F.G + 1 : 0; if (mine * F.G < S.nwg + F.G - 1 - (S.nwg + F.G - 1) % F.G) p0_defer(F, l, 8); }
            SEAM(pb + PH_WIN);
        }
        if (IN(pb + PH_HYPRE)) {
            DUP(PH_HYPRE, hypre_phase(F, (const bf16*)(ws + WS_Z), KARG(I_HCW) + l * 3 * 768, KARG(I_HCB) + l * 768, (bf16*)(ws + WS_VVT), (bf16*)(ws + WS_X0T), last ? 2048 : 2048 + 128, !(PROBE_DRY && rep_)));
            SEAM(pb + PH_HYPRE);
        }
        if (IN(pb + PH_MIX)) { for (int rep_ = 0; rep_ < ((PROBE_DUP == PH_MIX) ? args.nrep : 1); ++rep_) { if (rep_ && PROBE_BAR) xcd_barrier(bar); mix_phase(F, l, lds, l + 4 * rep_, last ? NUNITS_X_LAST : NUNITS_X); } SEAM(pb + PH_MIX); }
        if (IN(pb + PH_HYPOST)) { DUP(-77, hypost_phase(F, (const bf16*)(ws + WS_YT), (bf16*)(ws + WS_MIX), last ? 2048 : 2048 + 128)); SEAM(pb + PH_HYPOST); }
        if (IN(pb + PH_WOUT)) {
            pg8::Gemm g{(const bf16*)(ws + WS_MIX), (const bf16*)(ws + WS_WOUT) + (size_t)l * DM * DM, MT, DM, DM, DM}; pg8::Sched2 S; S.init(MR / 256, DM / 256, F.G, (int)blockIdx.x);
            if (l == 0) { pg8::EpiRes<true> E{KARG(I_X), KARG(I_CTX), Hl, Hc, mods_l + 2 * 1024, 1.0f}; pg8::gemm_phase<pg8::EpiRes<true>, pg8::Sched2, true, true>(F.lds, g, S, E); }
            else { pg8::EpiRes<false> E{Hl, Hc, Hl, Hc, mods_l + 2 * 1024, 1.0f}; pg8::gemm_phase<pg8::EpiRes<false>, pg8::Sched2, true, true>(F.lds, g, S, E); }
            { const int mine = ((int)blockIdx.x < S.nwg) ? (S.nwg - 1 - (int)blockIdx.x) / F.G + 1 : 0; if (fill_li >= 0 && mine * F.G < S.nwg + F.G - 1 - (S.nwg + F.G - 1) % F.G) moe_filler(F, fill_li, 8); }
            SEAM(pb + PH_WOUT);
        }
        if (IN(pb + PH_NORM2)) {
            Comb cb{}; Pend pd{};
            if (moe) { norm_phase<true, false, true, false, true>(F, Hl, Hc, KARG(I_GFFN) + l * DM, mods_l, 3, U, KARG(I_ROUTER) + (size_t)li * DM * 8, route, cnt, MR, cb, pd, (unsigned char*)(ws + WS_AS8)); __syncthreads(); moe_filler(F, li, 1 << 30); }
            else if ((DENSE_F8_UP >> li) & 1) { norm_phase<false, false, true, false, true>(F, Hl, Hc, KARG(I_GFFN) + l * DM, mods_l, 3, U, nullptr, nullptr, nullptr, MR, cb, pd); }
            else { norm_phase<false, false, true, false, false>(F, Hl, Hc, KARG(I_GFFN) + l * DM, mods_l, 3, U, nullptr, nullptr, nullptr, MR, cb, pd); }
            SEAM(pb + PH_NORM2);
        }
        if (moe) {
            int tb[9];
            if (IN(pb + PH_UP)) {
                moe_tile_base(cnt, tb);
                pg8::Gemm g{(const bf16*)(ws + WS_AS8), (const bf16*)(ws + WS_MWGU + (size_t)li * 8 * 2 * DFE * DM), MOE_ROWS, 2 * DFE, DM / 2, DM / 2}; pg8::Sched2 S; S.init(tb[8], 2 * DFE / 256, F.G, (int)blockIdx.x); S.moe = 1; S.wgm = 8; S.capt = MOE_CAP / 256;
#pragma unroll
                for (int e = 0; e < 9; ++e) S.tb[e] = tb[e];
                DUP(PH_UP, pg8::EpiSwiGLU8 E{(unsigned char*)(ws + WS_HID), DFE, (PROBE_DRY && rep_) ? 1 : 0, 1.0f / (pg8::F8_SA * pg8::F8_SW)}; pg8::gemm_phase<pg8::EpiSwiGLU8, pg8::Sched2, true, true, true>(F.lds, g, S, E));
                { const int mine = ((int)blockIdx.x < S.nwg) ? (S.nwg - 1 - (int)blockIdx.x) / F.G + 1 : 0; if (mine * F.G < S.nwg + F.G - 1 - (S.nwg + F.G - 1) % F.G) p0_defer(F, l, 4); }
                SEAM(pb + PH_UP);
            }
            if (IN(pb + PH_DOWN)) {
                moe_tile_base(cnt, tb);
                pg8::Gemm g{(const bf16*)(ws + WS_HID), (const bf16*)(ws + WS_MWD + (size_t)li * 8 * DM * DFE), MOE_ROWS, DM, DFE / 2, DFE / 2}; pg8::Sched2 S; S.init(tb[8], DM / 256, F.G, (int)blockIdx.x); S.moe = 1; S.wgm = 8;
#pragma unroll
                for (int e = 0; e < 9; ++e) S.tb[e] = tb[e];
                pg8::EpiBf E{(bf16*)(ws + WS_AS), DM, 1.0f / (pg8::F8_SH * pg8::F8_SWD)};
                pg8::gemm_phase<pg8::EpiBf, pg8::Sched2, true, true, true>(F.lds, g, S, E);
                { const int mine = ((int)blockIdx.x < S.nwg) ? (S.nwg - 1 - (int)blockIdx.x) / F.G + 1 : 0; if (fill_li >= 0 && mine * F.G < S.nwg + F.G - 1 - (S.nwg + F.G - 1) % F.G) moe_filler(F, fill_li, 7); }
                SEAM(pb + PH_DOWN);
            }
        } else {
            if (IN(pb + PH_UP)) {
                pg8::Sched2 S; S.init(MT / 256, 2 * DFF / 256, F.G, (int)blockIdx.x);
                if ((DENSE_F8_UP >> li) & 1) { S.wgm = 8; pg8::Gemm g{U, (const bf16*)(ws + WS_WGU) + (size_t)li * 2 * DFF * DM, MT, 2 * DFF, DM / 2, DM / 2};
                    pg8::EpiSwiGLU8 E{(unsigned char*)(ws + WS_HID), DFF, 0, 1.0f / (pg8::F8_SA * pg8::F8_SW)}; pg8::gemm_phase<pg8::EpiSwiGLU8, pg8::Sched2, true, true, true>(F.lds, g, S, E); }
                else if ((DENSE_F8_DOWN >> li) & 1) { pg8::Gemm g{U, (const bf16*)(ws + WS_WGU) + (size_t)li * 2 * DFF * DM, MT, 2 * DFF, DM, DM};
                    pg8::EpiSwiGLU8 E{(unsigned char*)(ws + WS_HID), DFF, 0, 1.0f}; pg8::gemm_phase<pg8::EpiSwiGLU8, pg8::Sched2, true, true>(F.lds, g, S, E); }
                else { pg8::Gemm g{U, (const bf16*)(ws + WS_WGU) + (size_t)li * 2 * DFF * DM, MT, 2 * DFF, DM, DM};
                    pg8::EpiSwiGLU E{(bf16*)(ws + WS_HID), DFF, 0}; pg8::gemm_phase<pg8::EpiSwiGLU, pg8::Sched2, true, true>(F.lds, g, S, E); }
                { const int mine = ((int)blockIdx.x < S.nwg) ? (S.nwg - 1 - (int)blockIdx.x) / F.G + 1 : 0; if (mine * F.G < S.nwg + F.G - 1 - (S.nwg + F.G - 1) % F.G) p0_defer(F, l, 5); }
                SEAM(pb + PH_UP);
            }
            if (IN(pb + PH_DOWN)) {
                pg8::Sched2 S; S.init(MT / 256, DM / 256, F.G, (int)blockIdx.x);
                if ((DENSE_F8_DOWN >> li) & 1) { S.wgm = 8; pg8::Gemm g{(const bf16*)(ws + WS_HID), (const bf16*)(ws + WS_WD) + (size_t)li * DM * DFF, MT, DM, DFF / 2, DFF / 2};
                    pg8::EpiRes<false> E{Hl, Hc, Hl, Hc, mods_l + 5 * 1024, 1.0f / (pg8::F8_SH * pg8::F8_SWD)}; pg8::gemm_phase<pg8::EpiRes<false>, pg8::Sched2, true, true, true>(F.lds, g, S, E); }
                else { pg8::Gemm g{(const bf16*)(ws + WS_HID), (const bf16*)(ws + WS_WD) + (size_t)li * DM * DFF, MT, DM, DFF, DFF};
                    pg8::EpiRes<false> E{Hl, Hc, Hl, Hc, mods_l + 5 * 1024, 1.0f}; pg8::gemm_phase<pg8::EpiRes<false>, pg8::Sched2, true, true>(F.lds, g, S, E); }
                { const int mine = ((int)blockIdx.x < S.nwg) ? (S.nwg - 1 - (int)blockIdx.x) / F.G + 1 : 0; if (fill_li >= 0 && mine * F.G < S.nwg + F.G - 1 - (S.nwg + F.G - 1) % F.G) moe_filler(F, fill_li, 20); }
                SEAM(pb + PH_DOWN);
            }
        }
    }
    if (IN(NPHASES - 1)) { Comb cb; cb.route = route; cb.Y = (const bf16*)(ws + WS_AS); cb.gate = mods + (size_t)3 * 9 * 6144 + 5 * 1024; moe_tile_base(F.ctl + CW_CNT + 64 * 8, cb.tb); final_phase(F, Hl, KOUT(), KARG(I_GFINAL), cb); }
    if (PROBE_DUP == 101) { for (int rep_ = 0; rep_ < 10 * args.nrep; ++rep_) xcd_barrier(bar); }
#ifdef PROBE_P0
    if (blockIdx.x == 0) { const unsigned long long now0_ = rt(); while (rt() - now0_ < 64ull * p0acc) __builtin_amdgcn_s_sleep(8); }
#endif
    if (PROBE_IDLE) { xcd_barrier(bar); if (blockIdx.x == 0) { const unsigned long long tot_ = *(volatile unsigned long long*)(ws + WS_ROPE + 32768); const unsigned long long now1_ = rt(); while (rt() - now1_ < (unsigned long long)PROBE_TK * tot_ / 256ull) __builtin_amdgcn_s_sleep(8); } }
    if (PROBE_TSEL) { const unsigned long long now_ = rt(); if ((PROBE_TSEL >> 13) & 1) tacc_ += now_ - tprev_; if (blockIdx.x == 0) { while (rt() - now_ < (unsigned long long)PROBE_TK * tacc_) __builtin_amdgcn_s_sleep(8); } }
#undef IN
#undef SEAM
}

#ifndef MK_MULTI
#define MK_MULTI 0
#endif
extern "C" void kernel_launch(void* const* d_in, const int* in_sizes, int n_in, void* d_out, int out_size, void* d_ws, size_t ws_size, hipStream_t stream) {
    static int grid = 0;
    if (grid == 0) {
        if (n_in != 34 || out_size != ML * DM || ws_size < WS_END) { fprintf(stderr, "kernel_launch: unexpected problem (n_in %d, out %d, ws %zu < %zu)\n", n_in, out_size, ws_size, (size_t)WS_END); grid = -1; return; }
        int dev = 0, cus = 0, per_cu = 0;
        if (hipGetDevice(&dev) != hipSuccess || hipDeviceGetAttribute(&cus, hipDeviceAttributeMultiprocessorCount, dev) != hipSuccess) { grid = -1; return; }
        if (hipFuncSetAttribute((const void*)trunk_fwd, hipFuncAttributeMaxDynamicSharedMemorySize, LDS_BYTES) != hipSuccess) { fprintf(stderr, "kernel_launch: hipFuncSetAttribute failed\n"); grid = -1; return; }
        if (hipOccupancyMaxActiveBlocksPerMultiprocessor(&per_cu, (const void*)trunk_fwd, NWAVES * 64, LDS_BYTES) != hipSuccess || per_cu < 1) { fprintf(stderr, "kernel_launch: occupancy query says %d\n", per_cu); (void)hipGetLastError(); per_cu = 1; }
        grid = cus;
    }
    if (grid < 0) return;
    (void)hipMemsetAsync((char*)d_ws + WS_CTL, 0, CTL_ZERO_BYTES, stream);
    Args a{};
    for (int i = 0; i < 34; ++i) a.p.in[i] = (const float*)d_in[i];
    a.p.out = (float*)d_out; a.p.ws = (unsigned char*)d_ws;
#if MK_MULTI
    for (int ph = 0; ph < NPHASES; ++ph) {
        if (ph >= 1 && ph < NPHASES - 1) { const int l = (ph - 1) / NPL, k = (ph - 1) % NPL; if (!(l & 1) && (k == PH_GATHER || k == PH_COMBINE)) continue; }
        a.ph_lo = ph; a.ph_hi = ph + 1; a.use_bar = 0;
        hipLaunchKernelGGL(trunk_fwd, dim3(grid), dim3(NWAVES * 64), LDS_BYTES, stream, a);
    }
#else
    a.ph_lo = 0; a.ph_hi = NPHASES; a.use_bar = 1; a.nrep = 2;
    hipLaunchKernelGGL(trunk_fwd, dim3(grid), dim3(NWAVES * 64), LDS_BYTES, stream, a);
#endif
}
```
